# Optimizing an MI355X kernel written in HIP

```python
import jax, jax.numpy as jnp
from jax import lax
import numpy as np

D_MODEL = 2048
BATCH = 4
SEQ = 2048
DEPTH = 1

CHUNK = 64
MIX_WIDTH = D_MODEL
POOL_WIDTH = MIX_WIDTH // 2
POOL_WINDOWS = (2, 4, 8, 16)
N_POOL_GROUPS = len(POOL_WINDOWS)
POOL_GROUP = POOL_WIDTH // N_POOL_GROUPS
ATTN_WIDTH = MIX_WIDTH - POOL_WIDTH
HEAD_DIM = 128
N_HEADS = ATTN_WIDTH // HEAD_DIM
Q_BLOCK = 128
D_FF = 4 * D_MODEL
PLE_DIM = 256
IN_WIDTH = POOL_WIDTH + 3 * ATTN_WIDTH + N_HEADS
EPS = 1e-6

kernel_name = "hymba_pool_fox_sandwich_block"


def rms_norm(x, g):
    xf = x.astype(jnp.float32)
    var = jnp.mean(jnp.square(xf), axis=-1, keepdims=True)
    return (xf * lax.rsqrt(var + EPS) * g.astype(jnp.float32)).astype(x.dtype)


def multiscale_pool(u, w_pool, pool_scale):
    B, S, _ = u.shape
    ug = u.reshape(B, S, N_POOL_GROUPS, POOL_GROUP)
    pos = jnp.arange(S, dtype=jnp.float32)
    outs = []
    for gi, w in enumerate(POOL_WINDOWS):
        x_g = ug[:, :, gi].astype(jnp.float32)
        cs = jnp.cumsum(x_g, axis=1)
        lag = jnp.concatenate([jnp.zeros((B, w, POOL_GROUP), jnp.float32), cs[:, :S - w]], axis=1)
        count = jnp.minimum(pos + 1.0, float(w))[None, :, None]
        outs.append((cs - lag) / count - x_g)
    y = jnp.stack(outs, axis=2).astype(u.dtype)
    y = jnp.einsum('bsgc,gcd->bsgd', y, w_pool)
    return y.reshape(B, S, POOL_WIDTH) * pool_scale


def forgetting_attention(q, k, v, log_f):
    S = q.shape[2]
    F = jnp.cumsum(log_f, axis=-1)
    scale = HEAD_DIM ** -0.5
    outs = []
    for start in range(0, S, Q_BLOCK):
        end = start + Q_BLOCK
        qb = q[:, :, start:end]
        kb = k[:, :, :end]
        vb = v[:, :, :end]
        s = jnp.einsum('bhqd,bhkd->bhqk', qb, kb).astype(jnp.float32) * scale
        s = s + F[:, :, start:end, None] - F[:, :, None, :end]
        qpos = start + jnp.arange(Q_BLOCK)
        kpos = jnp.arange(end)
        s = jnp.where(kpos[None, :] <= qpos[:, None], s, -jnp.inf)
        pr = jax.nn.softmax(s, axis=-1).astype(v.dtype)
        outs.append(jnp.einsum('bhqk,bhkd->bhqd', pr, vb))
    return jnp.concatenate(outs, axis=2)


def setup_inputs(seed: int = 0) -> dict:
    key = jax.random.key(seed)
    ks = jax.random.split(key, 24)
    f32 = jnp.float32

    def nrm(k, shape, fan_in):
        return jax.random.normal(k, shape, f32) * (fan_in ** -0.5)

    def gain(k, shape):
        return 1.0 + 0.05 * jax.random.normal(k, shape, f32)

    return {
        "x": jax.random.normal(ks[0], (BATCH, SEQ, D_MODEL), f32),
        "p": jax.random.normal(ks[1], (DEPTH, BATCH, SEQ, PLE_DIM), f32),
        "g_pre_mix": gain(ks[2], (DEPTH, D_MODEL)),
        "w_in": nrm(ks[3], (DEPTH, D_MODEL, IN_WIDTH), D_MODEL),
        "b_f": 3.0 + 0.5 * jax.random.normal(ks[4], (DEPTH, N_HEADS), f32),
        "w_pool": nrm(ks[5], (DEPTH, N_POOL_GROUPS, POOL_GROUP, POOL_GROUP), POOL_GROUP),
        "pool_scale": gain(ks[6], (DEPTH, POOL_WIDTH)),
        "g_pool_out": gain(ks[7], (DEPTH, POOL_WIDTH)),
        "g_attn_out": gain(ks[8], (DEPTH, ATTN_WIDTH)),
        "w_out": nrm(ks[9], (DEPTH, MIX_WIDTH, D_MODEL), MIX_WIDTH),
        "g_post_mix": gain(ks[10], (DEPTH, D_MODEL)),
        "g_pre_mlp": gain(ks[11], (DEPTH, D_MODEL)),
        "w_up": nrm(ks[12], (DEPTH, D_MODEL, D_FF), D_MODEL),
        "w_down": nrm(ks[13], (DEPTH, D_FF, D_MODEL), D_FF),
        "g_post_mlp": gain(ks[14], (DEPTH, D_MODEL)),
        "g_ple_gate": gain(ks[15], (DEPTH, D_MODEL)),
        "w_gate": nrm(ks[16], (DEPTH, D_MODEL, D_MODEL), D_MODEL),
        "w_ple": nrm(ks[17], (DEPTH, PLE_DIM, D_MODEL), PLE_DIM),
        "g_post_ple": gain(ks[18], (DEPTH, D_MODEL)),
    }


def reference(x, p, g_pre_mix, w_in, b_f, w_pool, pool_scale, g_pool_out, g_attn_out,
              w_out, g_post_mix, g_pre_mlp, w_up, w_down, g_post_mlp, g_ple_gate,
              w_gate, w_ple, g_post_ple):
    B, S, _ = x.shape
    h = x
    for i in range(DEPTH):
        hn = rms_norm(h, g_pre_mix[i])
        z = hn @ w_in[i]
        o = 0
        u = z[..., o:o + POOL_WIDTH]; o += POOL_WIDTH
        q = z[..., o:o + ATTN_WIDTH]; o += ATTN_WIDTH
        k = z[..., o:o + ATTN_WIDTH]; o += ATTN_WIDTH
        v = z[..., o:o + ATTN_WIDTH]; o += ATTN_WIDTH
        f_logit = z[..., o:o + N_HEADS] + b_f[i]

        y_pool = multiscale_pool(u, w_pool[i], pool_scale[i])

        to_heads = lambda t: t.reshape(B, S, N_HEADS, HEAD_DIM).transpose(0, 2, 1, 3)
        log_f = jax.nn.log_sigmoid(f_logit.astype(jnp.float32)).transpose(0, 2, 1)
        y_attn = forgetting_attention(to_heads(q), to_heads(k), to_heads(v), log_f)
        y_attn = y_attn.transpose(0, 2, 1, 3).reshape(B, S, ATTN_WIDTH)

        y = jnp.concatenate([rms_norm(y_pool, g_pool_out[i]),
                             rms_norm(y_attn, g_attn_out[i])], axis=-1)
        h = h + rms_norm(y @ w_out[i], g_post_mix[i])

        hn = rms_norm(h, g_pre_mlp[i])
        m = jnp.square(jax.nn.relu(hn @ w_up[i])) @ w_down[i]
        h = h + rms_norm(m, g_post_mlp[i])

        gate = jax.nn.sigmoid(rms_norm(h, g_ple_gate[i]) @ w_gate[i])
        e = p[i].astype(h.dtype) @ w_ple[i]
        h = h + rms_norm(gate * e, g_post_ple[i])
    return h
```

```cpp
#include <hip/hip_runtime.h>
#include <hip/hip_bf16.h>
#include <hip/hip_cooperative_groups.h>
#include <cstdio>
#include <cstdint>
namespace cg = cooperative_groups;

#define LAS __attribute__((address_space(3)))
typedef unsigned short bf16_t;
typedef short bf16x8 __attribute__((ext_vector_type(8)));
typedef short s16x4 __attribute__((ext_vector_type(4)));
typedef float f32x4 __attribute__((ext_vector_type(4)));
typedef float f32x2 __attribute__((ext_vector_type(2)));
typedef float f32x16 __attribute__((ext_vector_type(16)));
typedef unsigned u32x4 __attribute__((ext_vector_type(4)));
typedef unsigned u32x2 __attribute__((ext_vector_type(2)));

constexpr int DM = 2048, SEQ = 2048, NB = 4, M = NB * SEQ, POOLW = 1024, ATTW = 1024, NH = 8, HD = 128, DFF = 8192, PLE = 256, INW = 4104;
constexpr float EPS = 1e-6f;

constexpr size_t MiB = 1u << 20;
constexpr size_t WS_FLOG = 1 * MiB;
constexpr size_t WS_FB = 1 * MiB + 512 * 1024;
constexpr size_t WS_WIN = 2 * MiB, WS_WOUT = 18 * MiB, WS_WUP = 26 * MiB, WS_WDOWN = 58 * MiB, WS_WGATE = 90 * MiB, WS_WPLE = 98 * MiB, WS_WPOOL = 99 * MiB;
constexpr size_t WS_HN = 100 * MiB;
constexpr size_t WS_ARENA = 132 * MiB;
constexpr size_t AR_U = WS_ARENA, AR_Q = WS_ARENA + 16 * MiB, AR_K = WS_ARENA + 32 * MiB, AR_V = WS_ARENA + 48 * MiB;
constexpr size_t AR_YP = WS_ARENA + 64 * MiB, AR_YA = WS_ARENA + 80 * MiB, AR_DP = WS_ARENA + 96 * MiB;
constexpr size_t AR_Y = WS_ARENA;
constexpr size_t AR_RAW1 = WS_ARENA + 32 * MiB;
constexpr size_t AR_HID = WS_ARENA;
constexpr size_t AR_E = WS_ARENA;
constexpr size_t WS_RAW2 = WS_WUP;
constexpr size_t WS_PBF = 260 * MiB;
constexpr size_t WS_END = 264 * MiB;

__device__ __forceinline__ unsigned cvt_pk_bf16(float lo, float hi) { unsigned r; asm volatile("v_cvt_pk_bf16_f32 %0, %1, %2" : "=v"(r) : "v"(lo), "v"(hi)); return r; }
__device__ __forceinline__ int fresh_tid() { int t = threadIdx.x; asm volatile("" : "+v"(t)); return t; }
__device__ __forceinline__ float bf_lo(unsigned w) { return __uint_as_float(w << 16); }
__device__ __forceinline__ float bf_hi(unsigned w) { return __uint_as_float(w & 0xffff0000u); }
__device__ __forceinline__ float wave_sum(float v) {
#pragma unroll
    for (int o = 1; o < 64; o <<= 1) v += __shfl_xor(v, o);
    return v;
}

namespace pg8 {
constexpr int BM = 256, BK = 64, HALF = 128, HTB = HALF * BK * 2, STAGE_BYTES = 8 * HTB, NXCD = 8, WGM = 8;
__host__ __device__ __forceinline__ int lds_byte(int r, int c) { const int st = (r >> 4) * 2 + (c >> 5), rr = r & 15, cc = c & 31, ob = rr * 64 + cc * 2; return st * 1024 + (ob ^ (((ob >> 9) & 1) << 5)); }
__host__ __device__ __forceinline__ void stage_rc(int b, int& R, int& C) { const int st = b / 1024, sb = b % 1024, swz = sb ^ (((sb >> 9) & 1) << 5); R = (st >> 1) * 16 + swz / 64; C = (st & 1) * 32 + (swz % 64) / 2; }
__host__ __device__ __forceinline__ int perm32(int rho) { const int n = rho >> 4, i = rho & 15; return 8 * (i >> 2) + 4 * n + (i & 3); }

struct Unit { int pm, pn; };
struct Gemm { const bf16_t* A; const bf16_t* Bt; int lda, ldb, K, a_pn_koff; };

struct StaticOrder {
    int nM, nN, nwg, G, c;
    __device__ void init(int M_, int N_, int G_, int c_) { nM = M_ / BM; nN = N_ / BM; nwg = nM * nN; G = G_; c = c_; }
    __device__ bool next(int i, Unit& u) const {
        const long L = (long)i * G + c; if (L >= nwg) return false;
        int wgid = (int)L; { const int q = nwg / NXCD, r = nwg % NXCD, xcd = wgid % NXCD, off = wgid / NXCD; wgid = (xcd < r ? xcd * (q + 1) : r * (q + 1) + (xcd - r) * q) + off; }
        const int nig = WGM * nN, gid = wgid / nig, fm = gid * WGM, gsz = (nM - fm) < WGM ? (nM - fm) : WGM;
        u.pm = fm + ((wgid % nig) % gsz); u.pn = (wgid % nig) / gsz; return true;
    }
};
struct SingleUnit {
    int pm, pn, valid;
    __device__ bool next(int i, Unit& u) const { if (i != 0 || !valid) return false; u.pm = pm; u.pn = pn; return true; }
};

template <int ACT> struct EpiG {
    static constexpr bool PERM = true;
    bf16_t* O; int ldc; int split_cols; size_t split_stride; const float* colscale; const bf16_t* aux;
    __device__ __forceinline__ void operator()(const f32x4 (&acc)[2][2][4][2], const Unit& u, int wr, int wc, int fr, int fq) const {
        const int row0 = u.pm * BM + wr * 64 + fr; int colt = u.pn * BM; bf16_t* base = O;
        if (split_cols) { const int t = colt / split_cols; base += (size_t)t * split_stride; colt -= t * split_cols; }
        const int col0 = colt + wc * 32 + 8 * fq, gcol0 = u.pn * BM + wc * 32 + 8 * fq;
        f32x4 cs[2][2];
        if (ACT == 4) {
#pragma unroll
            for (int bj = 0; bj < 2; ++bj)
#pragma unroll
                for (int n = 0; n < 2; ++n) cs[bj][n] = *(const f32x4*)(colscale + gcol0 + bj * HALF + 4 * n);
        }
#pragma unroll
        for (int ai = 0; ai < 2; ++ai)
#pragma unroll
            for (int m = 0; m < 4; ++m) { const size_t roff = (size_t)(row0 + ai * HALF + m * 16) * ldc + col0;
#pragma unroll
                for (int bj = 0; bj < 2; ++bj) { f32x4 v0 = acc[ai][bj][m][0], v1 = acc[ai][bj][m][1];
                    if (ACT == 2) {
#pragma unroll
                        for (int e = 0; e < 4; ++e) { float a = fmaxf(v0[e], 0.f), b = fmaxf(v1[e], 0.f); v0[e] = a * a; v1[e] = b * b; }
                    }
                    if (ACT == 3) { const u32x4 ev = *(const u32x4*)(aux + roff + bj * HALF);
                        const float e0[4] = {bf_lo(ev.x), bf_hi(ev.x), bf_lo(ev.y), bf_hi(ev.y)}, e1[4] = {bf_lo(ev.z), bf_hi(ev.z), bf_lo(ev.w), bf_hi(ev.w)};
#pragma unroll
                        for (int e = 0; e < 4; ++e) { v0[e] = __builtin_amdgcn_rcpf(1.f + __builtin_amdgcn_exp2f(-1.4426950408889634f * v0[e])) * e0[e];
                                                      v1[e] = __builtin_amdgcn_rcpf(1.f + __builtin_amdgcn_exp2f(-1.4426950408889634f * v1[e])) * e1[e]; }
                    }
                    if (ACT == 4) { v0 = v0 * cs[bj][0]; v1 = v1 * cs[bj][1]; }
                    u32x4 w; w.x = cvt_pk_bf16(v0[0], v0[1]); w.y = cvt_pk_bf16(v0[2], v0[3]); w.z = cvt_pk_bf16(v1[0], v1[1]); w.w = cvt_pk_bf16(v1[2], v1[3]);
                    *(u32x4*)(base + roff + bj * HALF) = w; } }
    }
};

template <class Epi, class Sched>
__device__ __forceinline__ void gemm_phase(LAS unsigned char* lds, const Gemm g, const Sched& S, const Epi& E) {
    constexpr bool ALIGN_EPI = true;
    const int tid = fresh_tid(), wid = __builtin_amdgcn_readfirstlane(tid >> 6), lane = tid & 63, wr = wid >> 2, wc = wid & 3, fr = lane & 15, fq = lane >> 4;
    const int K = g.K, nt = K / BK;
    unsigned voffA[2], voffB[2];
#pragma unroll
    for (int i = 0; i < 2; ++i) { int R, C; stage_rc(tid * 16 + i * 8192, R, C); const int Rb = Epi::PERM ? ((R & ~31) + perm32(R & 31)) : R;
        voffA[i] = (unsigned)(R * g.lda + C) * 2u; voffB[i] = (unsigned)(Rb * g.ldb + C) * 2u; }
    const size_t kstep = (size_t)(BK * 2);
    const size_t hstepA = (size_t)HALF * g.lda * 2, hstepB = (size_t)HALF * g.ldb * 2;
    const size_t tstepA = 2 * hstepA, tstepB = 2 * hstepB;
    const unsigned ldsw = (unsigned)wid * 1024u;
    const int aoff = lds_byte(wr * 64 + fr, fq * 8), boff = lds_byte(wc * 32 + fr, fq * 8);
#define PG8_SA(b, h) (((b) * 2 + (h)) * HTB)
#define PG8_SB(b, h) ((4 + (b) * 2 + (h)) * HTB)
#define PG8_STAGE(bufoff, gbase, voff) do { _Pragma("unroll") for (int _i = 0; _i < 2; ++_i) \
        __builtin_amdgcn_global_load_lds((const unsigned*)((const char*)(gbase) + (voff)[_i]), (LAS unsigned*)(lds + (bufoff) + ldsw + _i * 8192), 16, 0, 0); } while (0)
#define PG8_LDA(dst, b, h) do { _Pragma("unroll") for (int m = 0; m < 4; ++m) _Pragma("unroll") for (int k = 0; k < 2; ++k) dst[m][k] = *(const LAS bf16x8*)(lds + PG8_SA(b, h) + aoff + m * 2048 + k * 1024); } while (0)
#define PG8_LDB(dst, b, h) do { _Pragma("unroll") for (int n = 0; n < 2; ++n) _Pragma("unroll") for (int k = 0; k < 2; ++k) dst[n][k] = *(const LAS bf16x8*)(lds + PG8_SB(b, h) + boff + n * 2048 + k * 1024); } while (0)
#define PG8_MMA(ai, bj, At, Bt) do { __builtin_amdgcn_s_setprio(1); _Pragma("unroll") for (int m = 0; m < 4; ++m) _Pragma("unroll") for (int n = 0; n < 2; ++n) _Pragma("unroll") for (int k = 0; k < 2; ++k) \
        acc[ai][bj][m][n] = __builtin_amdgcn_mfma_f32_16x16x32_bf16(Bt[n][k], At[m][k], acc[ai][bj][m][n], 0, 0, 0); __builtin_amdgcn_s_setprio(0); } while (0)
#define PG8_WAIT_V(n) asm volatile("s_waitcnt vmcnt(" #n ")" ::: "memory")
#define PG8_WAIT_L(n) asm volatile("s_waitcnt lgkmcnt(" #n ")" ::: "memory")
#define PG8_BAR __builtin_amdgcn_s_barrier()
#define PG8_SCHED __builtin_amdgcn_sched_barrier(0)
    Unit cur, nxt; int ui = 0;
    if (!S.next(0, cur)) return;
    f32x4 acc[2][2][4][2];
#pragma unroll
    for (int a = 0; a < 2; ++a)
#pragma unroll
        for (int b = 0; b < 2; ++b)
#pragma unroll
            for (int m = 0; m < 4; ++m)
#pragma unroll
                for (int n = 0; n < 2; ++n) acc[a][b][m][n] = (f32x4){0.f, 0.f, 0.f, 0.f};
    bf16x8 At[4][2], B0[2][2], B1[2][2];
    const char* cA = (const char*)g.A + (size_t)cur.pm * tstepA + (size_t)cur.pn * g.a_pn_koff * 2; const char* cB = (const char*)g.Bt + (size_t)cur.pn * tstepB;
    PG8_STAGE(PG8_SB(0, 0), cB, voffB); PG8_STAGE(PG8_SB(0, 1), cB + hstepB, voffB); PG8_STAGE(PG8_SA(0, 0), cA, voffA); PG8_STAGE(PG8_SA(0, 1), cA + hstepA, voffA);
    if (wr == 1) PG8_BAR;
    PG8_WAIT_V(2); PG8_BAR;
    PG8_STAGE(PG8_SB(1, 0), cB + kstep, voffB); PG8_STAGE(PG8_SA(1, 0), cA + kstep, voffA); PG8_STAGE(PG8_SB(1, 1), cB + hstepB + kstep, voffB);
    PG8_WAIT_V(6); PG8_BAR;
    for (;;) {
        const bool has_next = S.next(ui + 1, nxt);
        const char* nA = has_next ? (const char*)g.A + (size_t)nxt.pm * tstepA + (size_t)nxt.pn * g.a_pn_koff * 2 : cA; const char* nB = has_next ? (const char*)g.Bt + (size_t)nxt.pn * tstepB : cB;
        for (int t = 0; t < nt; t += 2) {
            const bool last = (t == nt - 2);
            const char* a1 = cA + (size_t)(t + 1) * kstep;
            const char* a2 = last ? nA : cA + (size_t)(t + 2) * kstep; const char* b2 = last ? nB : cB + (size_t)(t + 2) * kstep;
            const char* a3 = a2 + kstep; const char* b3 = b2 + kstep;
            PG8_LDB(B0, 0, 0); PG8_LDB(B1, 0, 1); PG8_SCHED; PG8_LDA(At, 0, 0); PG8_STAGE(PG8_SA(1, 1), a1 + hstepA, voffA);
            PG8_WAIT_V(8); PG8_WAIT_L(0); PG8_BAR; PG8_MMA(0, 0, At, B0); PG8_MMA(0, 1, At, B1); PG8_BAR; PG8_SCHED;
            PG8_LDA(At, 0, 1); PG8_STAGE(PG8_SB(0, 0), b2, voffB); PG8_STAGE(PG8_SB(0, 1), b2 + hstepB, voffB); PG8_STAGE(PG8_SA(0, 0), a2, voffA);
            PG8_WAIT_V(8); PG8_WAIT_L(0); PG8_BAR; PG8_MMA(1, 0, At, B0); PG8_MMA(1, 1, At, B1); PG8_BAR; PG8_SCHED;
            PG8_LDB(B0, 1, 0); PG8_LDB(B1, 1, 1); PG8_SCHED; PG8_LDA(At, 1, 0); PG8_STAGE(PG8_SA(0, 1), a2 + hstepA, voffA);
            PG8_WAIT_V(8); PG8_WAIT_L(0); PG8_BAR; PG8_MMA(0, 0, At, B0); PG8_MMA(0, 1, At, B1); PG8_BAR; PG8_SCHED;
            PG8_LDA(At, 1, 1); PG8_STAGE(PG8_SB(1, 0), b3, voffB); PG8_STAGE(PG8_SB(1, 1), b3 + hstepB, voffB); PG8_STAGE(PG8_SA(1, 0), a3, voffA);
            PG8_WAIT_V(8); PG8_WAIT_L(0); PG8_BAR; PG8_MMA(1, 0, At, B0); PG8_MMA(1, 1, At, B1); PG8_BAR; PG8_SCHED;
        }
        if constexpr (ALIGN_EPI) { if (wr == 0) PG8_BAR; }
        E(acc, cur, wr, wc, fr, fq);
        if (!has_next) break;
#pragma unroll
        for (int a = 0; a < 2; ++a)
#pragma unroll
            for (int b = 0; b < 2; ++b)
#pragma unroll
                for (int m = 0; m < 4; ++m)
#pragma unroll
                    for (int n = 0; n < 2; ++n) acc[a][b][m][n] = (f32x4){0.f, 0.f, 0.f, 0.f};
        cur = nxt; cA = nA; cB = nB; ++ui;
        if constexpr (ALIGN_EPI) { if (wr == 1) PG8_BAR; }
    }
    PG8_WAIT_V(0);
    if constexpr (!ALIGN_EPI) { if (wr == 0) PG8_BAR; }
    PG8_BAR;
#undef PG8_SA
#undef PG8_SB
#undef PG8_STAGE
#undef PG8_LDA
#undef PG8_LDB
#undef PG8_MMA
#undef PG8_WAIT_V
#undef PG8_WAIT_L
#undef PG8_BAR
#undef PG8_SCHED
}
}

namespace att {
constexpr int D = 128, LD = 1024;
constexpr float SCALE = 0.08838834764831845f;
constexpr float THR = 8.f;
constexpr int NW = 8, QBLK = 32, KVBLK = 64, QB = NW * QBLK;
constexpr int SHM_V = KVBLK * D * 2, SHM_K = KVBLK * D * 2;
constexpr int OFF_WS = 2 * SHM_V + 2 * SHM_K, OFF_BIAS = OFF_WS + NW * 64 * 4, LDS_BYTES = OFF_BIAS + 512;
typedef bf16_t bf16;
#define KSWZ(row, colB) ((row) * 256 + ((colB) ^ (((row) & 7) << 4)))
#define SBAR() __builtin_amdgcn_sched_barrier(0)
__device__ __forceinline__ int v_st(int k, int c) { const int kk = (k & ~0xC) | ((k & 4) << 1) | ((k & 8) >> 1); return ((kk >> 3) * 4 + (c >> 5)) * 512 + ((kk & 7) * 32 + (c & 31)) * 2; }
__device__ __forceinline__ int v_rd_base(int lane) { return ((lane & 3) << 3) | (((lane >> 2) & 3) << 6) | (((lane >> 4) & 1) << 5) | (((lane >> 5) & 1) << 8); }
constexpr int v_rd_off(int d0, int ks, int half) { return d0 * 512 + ks * 4096 + half * 2048; }
__device__ __forceinline__ int crow(int r, int hi) { return (r & 3) + 8 * (r >> 2) + 4 * hi; }
__device__ __forceinline__ unsigned cvtpk(float lo, float hi) { unsigned r; asm volatile("v_cvt_pk_bf16_f32 %0, %1, %2" : "=v"(r) : "v"(lo), "v"(hi)); return r; }
__device__ __forceinline__ bf16x8 load8(const bf16* p) { return *reinterpret_cast<const bf16x8*>(p); }
__device__ __forceinline__ void mask_tile(f32x16& p0, f32x16& p1, int dq, unsigned W) {
    const float NEG = -__builtin_inff();
#pragma unroll
    for (int r = 0; r < 16; ++r) {
        const int c = (r & 3) + 8 * (r >> 2);
        if ((unsigned)(dq - c) >= W) p0[r] = NEG;
        if ((unsigned)(dq - c - 32) >= W) p1[r] = NEG;
    }
}
__device__ __forceinline__ void partialSM(f32x16& p0, f32x16& p1, float& m_reg, float& mn, float& alpha) {
    float pmax = p0[0]; for (int r = 1; r < 16; ++r) pmax = fmaxf(pmax, p0[r]); for (int r = 0; r < 16; ++r) pmax = fmaxf(pmax, p1[r]);
    { auto rr = __builtin_amdgcn_permlane32_swap(__float_as_uint(pmax), __float_as_uint(pmax), false, false);
      pmax = fmaxf(__uint_as_float(rr[0]), __uint_as_float(rr[1])); }
    constexpr float C2 = 1.4426950408889634f * SCALE;
    if (__builtin_expect(__all((pmax - m_reg) * SCALE <= THR), 1)) { mn = m_reg; alpha = 1.f; }
    else { mn = fmaxf(m_reg, pmax); alpha = __builtin_amdgcn_exp2f((m_reg - mn) * C2); m_reg = mn; }
    const float mnL = -mn * C2;
    for (int r = 0; r < 16; ++r) p0[r] = fmaf(p0[r], C2, mnL); for (int r = 0; r < 16; ++r) p1[r] = fmaf(p1[r], C2, mnL);
    for (int r = 0; r < 16; ++r) p0[r] = __builtin_amdgcn_exp2f(p0[r]);
}
__device__ __forceinline__ void finishSM(f32x16& p0, f32x16& p1, float alpha, float& l_reg, bf16x8& pa0, bf16x8& pa1, bf16x8& pa2, bf16x8& pa3) {
    for (int r = 0; r < 16; ++r) p1[r] = __builtin_amdgcn_exp2f(p1[r]);
    float ps = 0; for (int r = 0; r < 16; ++r) ps += p0[r]; for (int r = 0; r < 16; ++r) ps += p1[r];
    { auto rr = __builtin_amdgcn_permlane32_swap(__float_as_uint(ps), __float_as_uint(ps), false, false);
      ps = __uint_as_float(rr[0]) + __uint_as_float(rr[1]); }
    l_reg = l_reg * alpha + ps;
#define PK4(P, B_, OUT) do { unsigned a0 = cvtpk(P[B_+0], P[B_+1]), a1 = cvtpk(P[B_+2], P[B_+3]);                          \
        unsigned b0 = cvtpk(P[B_+4], P[B_+5]), b1 = cvtpk(P[B_+6], P[B_+7]);                                             \
        auto r0 = __builtin_amdgcn_permlane32_swap(a0, b0, false, false); auto r1 = __builtin_amdgcn_permlane32_swap(a1, b1, false, false); \
        u32x4 w = {r0[0], r1[0], r0[1], r1[1]}; OUT = *reinterpret_cast<bf16x8*>(&w); } while (0)
    PK4(p0, 0, pa0); PK4(p0, 8, pa1); PK4(p1, 0, pa2); PK4(p1, 8, pa3);
#undef PK4
}
template <int KB>
__device__ __forceinline__ void qkt(f32x16& p0, f32x16& p1, const char* K_lds, const char* B_lds, int r32, int hi, const bf16x8* qr) {
    const f32x4* bp = (const f32x4*)(B_lds + KB * 256 + hi * 16);
#pragma unroll
    for (int i = 0; i < 4; ++i) { const f32x4 a = bp[2 * i], b = bp[8 + 2 * i];
        p0[4 * i] = a[0]; p0[4 * i + 1] = a[1]; p0[4 * i + 2] = a[2]; p0[4 * i + 3] = a[3];
        p1[4 * i] = b[0]; p1[4 * i + 1] = b[1]; p1[4 * i + 2] = b[2]; p1[4 * i + 3] = b[3]; }
    const char* kb[4];
#pragma unroll
    for (int dd = 0; dd < 4; ++dd) kb[dd] = K_lds + KB * SHM_K + KSWZ(r32, (dd * 16 + hi * 8) * 2);
#pragma unroll
    for (int d0 = 0; d0 < 8; ++d0) { const char* a = kb[d0 & 3] + (d0 >> 2) * 128;
        bf16x8 b0 = *reinterpret_cast<const bf16x8*>(a);
        bf16x8 b1 = *reinterpret_cast<const bf16x8*>(a + 32 * 256);
        p0 = __builtin_amdgcn_mfma_f32_32x32x16_bf16(b0, qr[d0], p0, 0, 0, 0);
        p1 = __builtin_amdgcn_mfma_f32_32x32x16_bf16(b1, qr[d0], p1, 0, 0, 0); }
}
template <int VB>
__device__ __forceinline__ void pv_tile(f32x16* o, int vb0, bf16x8 pa0, bf16x8 pa1, bf16x8 pa2, bf16x8 pa3) {
#define TRRD(dst, off) asm volatile("ds_read_b64_tr_b16 %0, %1 offset:%2" : "=&v"(dst) : "v"(vb0), "i"(off) : "memory")
#define PV_D0(d0) do { s16x4 l0, l1, l2, l3, h0, h1, h2, h3; constexpr int b_ = VB * SHM_V + v_rd_off(d0, 0, 0); \
        TRRD(l0, b_); TRRD(h0, b_ + 2048); TRRD(l1, b_ + 4096); TRRD(h1, b_ + 6144); TRRD(l2, b_ + 8192); TRRD(h2, b_ + 10240); TRRD(l3, b_ + 12288); TRRD(h3, b_ + 14336); \
        asm volatile("s_waitcnt lgkmcnt(0)" ::: "memory"); SBAR();   \
        o[d0] = __builtin_amdgcn_mfma_f32_32x32x16_bf16(pa0, (bf16x8){l0[0], l0[1], l0[2], l0[3], h0[0], h0[1], h0[2], h0[3]}, o[d0], 0, 0, 0);   \
        o[d0] = __builtin_amdgcn_mfma_f32_32x32x16_bf16(pa1, (bf16x8){l1[0], l1[1], l1[2], l1[3], h1[0], h1[1], h1[2], h1[3]}, o[d0], 0, 0, 0);   \
        o[d0] = __builtin_amdgcn_mfma_f32_32x32x16_bf16(pa2, (bf16x8){l2[0], l2[1], l2[2], l2[3], h2[0], h2[1], h2[2], h2[3]}, o[d0], 0, 0, 0);   \
        o[d0] = __builtin_amdgcn_mfma_f32_32x32x16_bf16(pa3, (bf16x8){l3[0], l3[1], l3[2], l3[3], h3[0], h3[1], h3[2], h3[3]}, o[d0], 0, 0, 0); } while (0)
    PV_D0(0); PV_D0(1); PV_D0(2); PV_D0(3);
#undef PV_D0
#undef TRRD
}
struct BlockRef { const bf16* Q; const bf16* K; const bf16* V; const float* FB; bf16* O; int P0; };
struct Seam { bf16x8 qr[8]; bf16x8 st_v0, st_v1, st_k0, st_k1; float st_b; };
#define ROW(p, k0, rr) ((p) + (size_t)((k0) + (rr)) * LD + sc)
#define VMW() asm volatile("s_waitcnt vmcnt(0)" ::: "memory")
#define VMWN(n) asm volatile("s_waitcnt vmcnt(%0)" :: "i"(n) : "memory")
#define SLOAD_H(Kp, Vp, Fp, k0) do { S.st_v0 = load8(ROW(Vp, k0, sr)); S.st_v1 = load8(ROW(Vp, k0, 32 + sr));              \
                         S.st_k0 = load8(ROW(Kp, k0, sr)); S.st_k1 = load8(ROW(Kp, k0, 32 + sr)); S.st_b = (Fp)[(k0) + (tid & 63)]; } while (0)
#define SWRITE_HK(bf) do { *(bf16x8*)(K_lds + (bf) * SHM_K + kws) = S.st_k0; *(bf16x8*)(K_lds + (bf) * SHM_K + kws + 32 * 256) = S.st_k1; \
                           if (tid < 64) ((float*)B_lds)[(bf) * 64 + tid] = S.st_b; } while (0)
#define SWRITE_HV(bf) do { *(bf16x8*)(V_lds + (bf) * SHM_V + vst0) = S.st_v0; *(bf16x8*)(V_lds + (bf) * SHM_V + vst1) = S.st_v1; } while (0)
#define SWRITE_H(bf) do { SWRITE_HV(bf); SWRITE_HK(bf); } while (0)
__device__ __forceinline__ void prime(const BlockRef& cur, char* lds, Seam& S) {
    const int tid = fresh_tid(), wid = __builtin_amdgcn_readfirstlane(tid >> 6), lane = tid & 63, r32 = lane & 31, hi = lane >> 5;
    const int sr = tid >> 4, sc = (tid & 15) * 8, kws = KSWZ(sr, sc * 2); char* K_lds = lds + 2 * SHM_V; char* B_lds = lds + OFF_BIAS;
    for (int d0 = 0; d0 < 8; ++d0) S.qr[d0] = load8(cur.Q + (size_t)(wid * QBLK + r32) * LD + d0 * 16 + hi * 8);
    SLOAD_H(cur.K, cur.V, cur.FB, 0); VMW(); SWRITE_HK(0);
    __syncthreads();
}
__device__ __forceinline__ void block(const BlockRef& cur, const BlockRef& nxt, char* lds, Seam& S) {
    const int tid = fresh_tid(), wid = __builtin_amdgcn_readfirstlane(tid >> 6), lane = tid & 63, r32 = lane & 31, hi = lane >> 5;
    constexpr unsigned W = 1u << 30;
    const int NT = (cur.P0 + QB - 1) / KVBLK + 1;
    const int qlo = cur.P0 + wid * QBLK, qm = qlo + r32 - 4 * hi;
    char* V_lds = lds; char* K_lds = lds + 2 * SHM_V; char* B_lds = lds + OFF_BIAS;
    float* ws = (float*)(lds + OFF_WS) + wid * 64; float* li_l = ws, * al_l = ws + 32;
    float m_reg = -1e30f, l_reg = 0; f32x16 o[4] = {};
    const int sr = tid >> 4, sc = (tid & 15) * 8, vst0 = v_st(sr, sc), vst1 = v_st(32 + sr, sc), kws = KSWZ(sr, sc * 2);
    const int vb0 = (int)(uintptr_t)V_lds + v_rd_base(lane);
    const bf16* Kh = cur.K; const bf16* Vh = cur.V; const float* Fh = cur.FB;
#define RESC(a) do { if (__any((a) < 1.f)) { if (hi == 0) al_l[r32] = (a); asm volatile("s_waitcnt lgkmcnt(0)" ::: "memory");              \
                     for (int d_ = 0; d_ < 4; ++d_) for (int r = 0; r < 16; ++r) o[d_][r] *= al_l[crow(r, hi)]; } } while (0)
#define KBASE(t) ((t) * KVBLK)
#define MASKT(P0_, P1_, t) do { const int kb_ = KBASE(t); if (kb_ + KVBLK - 1 > qlo) mask_tile(P0_, P1_, qm - kb_, W); } while (0)
    constexpr int NQL = 8;
#define SEAM_K0() do { VMWN(NQL); SWRITE_HK(0); SBAR(); } while (0)
    f32x16 pA0, pA1, pB0, pB1; float mnA, mnB, alA, alB; bf16x8 pa0, pa1, pa2, pa3;
    SWRITE_HV(0); SBAR();
    if (NT > 1) SLOAD_H(Kh, Vh, Fh, KBASE(1));
    SBAR(); qkt<0>(pA0, pA1, K_lds, B_lds, r32, hi, S.qr);
    MASKT(pA0, pA1, 0); partialSM(pA0, pA1, m_reg, mnA, alA);
    if (NT > 1) { VMW(); SWRITE_H(1); }
    __syncthreads();
#define HALF_STEP(PX0, PX1, mnX, alX, PY0, PY1, alY, t, KB, VB, SB) do {                                                      \
        SBAR(); qkt<KB>(PX0, PX1, K_lds, B_lds, r32, hi, S.qr);                                                               \
        finishSM(PY0, PY1, alY, l_reg, pa0, pa1, pa2, pa3); SBAR();                                                           \
        if ((t) + 1 < NT) { SLOAD_H(Kh, Vh, Fh, KBASE((t) + 1)); SBAR(); }                                                    \
        pv_tile<VB>(o, vb0, pa0, pa1, pa2, pa3); MASKT(PX0, PX1, (t)); partialSM(PX0, PX1, m_reg, mnX, alX);                  \
        __syncthreads();                                                                                                      \
        if ((t) + 1 < NT) { VMW(); SWRITE_H(SB); }                                                                            \
        RESC(alX); __syncthreads(); } while (0)
    for (int t = 1; t + 1 < NT; t += 2) {
        HALF_STEP(pB0, pB1, mnB, alB, pA0, pA1, alA, t, 1, 0, 0);
        HALF_STEP(pA0, pA1, mnA, alA, pB0, pB1, alB, t + 1, 0, 1, 1);
    }
    const bool even = (NT & 1) == 0;
    if (even) { SBAR(); qkt<1>(pB0, pB1, K_lds, B_lds, r32, hi, S.qr); SBAR(); }
    SLOAD_H(nxt.K, nxt.V, nxt.FB, 0); SBAR();
#pragma unroll
    for (int d0 = 0; d0 < 8; ++d0) S.qr[d0] = load8(nxt.Q + (size_t)(wid * QBLK + r32) * LD + d0 * 16 + hi * 8);
    SBAR();
    finishSM(pA0, pA1, alA, l_reg, pa0, pa1, pa2, pa3); SBAR();
    pv_tile<0>(o, vb0, pa0, pa1, pa2, pa3);
    if (even) { MASKT(pB0, pB1, NT - 1); partialSM(pB0, pB1, m_reg, mnB, alB); __syncthreads(); RESC(alB);
        finishSM(pB0, pB1, alB, l_reg, pa0, pa1, pa2, pa3); SBAR(); pv_tile<1>(o, vb0, pa0, pa1, pa2, pa3); }
    SBAR(); SEAM_K0();
    if (hi == 0) li_l[r32] = l_reg; asm volatile("s_waitcnt lgkmcnt(0)" ::: "memory");
    float rli[16];
#pragma unroll
    for (int r = 0; r < 16; ++r) rli[r] = __builtin_amdgcn_rcpf(li_l[crow(r, hi)]);
    bf16* Ow = cur.O + (size_t)(wid * QBLK) * LD;
#pragma unroll
    for (int r = 0; r < 16; ++r) { const int orow = crow(r, hi);
#pragma unroll
        for (int d0 = 0; d0 < 4; ++d0) { const float v = o[d0][r] * rli[r];
            const float vn = __shfl_xor(v, 1);
            if ((r32 & 1) == 0) *(unsigned*)(Ow + (size_t)orow * LD + d0 * 32 + r32) = cvtpk(v, vn); } }
    __syncthreads();
#undef RESC
#undef KBASE
#undef MASKT
#undef SEAM_K0
#undef HALF_STEP
}
#undef ROW
#undef VMW
#undef VMWN
#undef SLOAD_H
#undef SWRITE_HK
#undef SWRITE_HV
#undef SWRITE_H
#undef SBAR
#undef KSWZ
}

constexpr int NWAVES = 8, NTHREADS = 512;
constexpr int LDS_BYTES = 147456;
struct Args { const float* in[19]; float* out; unsigned char* ws; };
enum { I_X = 0, I_P, I_GPREMIX, I_WIN, I_BF, I_WPOOL, I_POOLSCALE, I_GPOOLOUT, I_GATTNOUT, I_WOUT, I_GPOSTMIX, I_GPREMLP, I_WUP, I_WDOWN, I_GPOSTMLP, I_GPLEGATE, I_WGATE, I_WPLE, I_GPOSTPLE };

__device__ __forceinline__ void p0_transpose_item(const float* W, int K, int N, int ldw, bf16_t* WT, int row_off, LAS float* scr, int item, int lane) {
    const int nblk = N / 32, kb = item / nblk, nb = item % nblk, k0 = 64 * kb, n0 = 32 * nb;
#pragma unroll 8
    for (int i = 0; i < 32; ++i) { const int kk = 2 * i + (lane >> 5); scr[kk * 33 + (lane & 31)] = W[(size_t)(k0 + kk) * ldw + n0 + (lane & 31)]; }
    asm volatile("s_waitcnt lgkmcnt(0)" ::: "memory");
    const int c = lane & 7;
#pragma unroll
    for (int j = 0; j < 4; ++j) { const int n = (lane >> 3) + 8 * j; const LAS float* s = scr + (8 * c) * 33 + n;
        u32x4 o; o.x = cvt_pk_bf16(s[0 * 33], s[1 * 33]); o.y = cvt_pk_bf16(s[2 * 33], s[3 * 33]); o.z = cvt_pk_bf16(s[4 * 33], s[5 * 33]); o.w = cvt_pk_bf16(s[6 * 33], s[7 * 33]);
        *(u32x4*)(WT + (size_t)(row_off + n0 + n) * K + k0 + 8 * c) = o; }
    asm volatile("s_waitcnt lgkmcnt(0)" ::: "memory");
}

__device__ __forceinline__ void row_resnorm(const float* base_row, const bf16_t* raw_row, const float* g_post, float* out_row, const float* g_next, bf16_t* hn_row, int lane) {
    f32x4 r[8]; float ss = 0.f;
#pragma unroll
    for (int j = 0; j < 8; ++j) { const u32x2 w = *((const u32x2*)raw_row + lane + 64 * j); r[j] = (f32x4){bf_lo(w.x), bf_hi(w.x), bf_lo(w.y), bf_hi(w.y)};
        ss += (r[j].x * r[j].x + r[j].y * r[j].y) + (r[j].z * r[j].z + r[j].w * r[j].w); }
    const float rs = 1.0f / sqrtf(wave_sum(ss) * (1.f / DM) + EPS);
    float ss2 = 0.f;
#pragma unroll
    for (int j = 0; j < 8; ++j) { const f32x4 b = *((const f32x4*)base_row + lane + 64 * j), g = *((const f32x4*)g_post + lane + 64 * j);
        r[j] = b + r[j] * rs * g; *((f32x4*)out_row + lane + 64 * j) = r[j];
        ss2 += (r[j].x * r[j].x + r[j].y * r[j].y) + (r[j].z * r[j].z + r[j].w * r[j].w); }
    if (g_next) {
        const float rs2 = 1.0f / sqrtf(wave_sum(ss2) * (1.f / DM) + EPS);
#pragma unroll
        for (int j = 0; j < 8; ++j) { const f32x4 g = *((const f32x4*)g_next + lane + 64 * j); const f32x4 h = r[j] * rs2 * g;
            u32x2 w; w.x = cvt_pk_bf16(h.x, h.y); w.y = cvt_pk_bf16(h.z, h.w); *((u32x2*)hn_row + lane + 64 * j) = w; }
    }
}
__device__ __forceinline__ void row_norm1024(const bf16_t* src, const float* g, bf16_t* dst, int lane) {
    float v[2][8]; float ss = 0.f;
#pragma unroll
    for (int j = 0; j < 2; ++j) { const u32x4 w = *((const u32x4*)src + lane + 64 * j);
        v[j][0] = bf_lo(w.x); v[j][1] = bf_hi(w.x); v[j][2] = bf_lo(w.y); v[j][3] = bf_hi(w.y); v[j][4] = bf_lo(w.z); v[j][5] = bf_hi(w.z); v[j][6] = bf_lo(w.w); v[j][7] = bf_hi(w.w);
#pragma unroll
        for (int e = 0; e < 8; ++e) ss += v[j][e] * v[j][e]; }
    const float rs = 1.0f / sqrtf(wave_sum(ss) * (1.f / 1024.f) + EPS);
#pragma unroll
    for (int j = 0; j < 2; ++j) { const f32x4 g0 = *((const f32x4*)g + 2 * (lane + 64 * j)), g1 = *((const f32x4*)g + 2 * (lane + 64 * j) + 1);
        u32x4 w; w.x = cvt_pk_bf16(v[j][0] * rs * g0.x, v[j][1] * rs * g0.y); w.y = cvt_pk_bf16(v[j][2] * rs * g0.z, v[j][3] * rs * g0.w);
        w.z = cvt_pk_bf16(v[j][4] * rs * g1.x, v[j][5] * rs * g1.y); w.w = cvt_pk_bf16(v[j][6] * rs * g1.z, v[j][7] * rs * g1.w);
        *((u32x4*)dst + lane + 64 * j) = w; }
}
__device__ __forceinline__ float log_sigmoid(float x) { return x < 0.f ? x - log1pf(expf(x)) : -log1pf(expf(-x)); }

__global__ void __launch_bounds__(NTHREADS, 2) mega_fwd(Args args) {
    extern __shared__ __attribute__((aligned(16))) unsigned char lds[];
    cg::grid_group grid = cg::this_grid();
    LAS unsigned char* ldsl = (LAS unsigned char*)lds;
    const int G = gridDim.x, bid = blockIdx.x, NGW = G * NWAVES;
#define PHASE_IDS() const int tid = fresh_tid(), lane = tid & 63, wave = __builtin_amdgcn_readfirstlane(tid >> 6), gw = bid * NWAVES + wave; (void)lane; (void)gw
    unsigned char* ws = args.ws;
    const float* x = args.in[I_X];
    float* out = args.out;
    float* flog = (float*)(ws + WS_FLOG); float* fb = (float*)(ws + WS_FB);
    bf16_t* WinT = (bf16_t*)(ws + WS_WIN); bf16_t* WoutT = (bf16_t*)(ws + WS_WOUT); bf16_t* WupT = (bf16_t*)(ws + WS_WUP); bf16_t* WdownT = (bf16_t*)(ws + WS_WDOWN);
    bf16_t* WgateT = (bf16_t*)(ws + WS_WGATE); bf16_t* WpleT = (bf16_t*)(ws + WS_WPLE); bf16_t* WpoolT = (bf16_t*)(ws + WS_WPOOL);
    bf16_t* HN = (bf16_t*)(ws + WS_HN);
    bf16_t* U = (bf16_t*)(ws + AR_U); bf16_t* Qb = (bf16_t*)(ws + AR_Q); bf16_t* Kb = (bf16_t*)(ws + AR_K); bf16_t* Vb = (bf16_t*)(ws + AR_V);
    bf16_t* YP = (bf16_t*)(ws + AR_YP); bf16_t* YA = (bf16_t*)(ws + AR_YA); bf16_t* DP = (bf16_t*)(ws + AR_DP);
    bf16_t* Y = (bf16_t*)(ws + AR_Y); bf16_t* RAW1 = (bf16_t*)(ws + AR_RAW1); bf16_t* HID = (bf16_t*)(ws + AR_HID); bf16_t* Eb = (bf16_t*)(ws + AR_E);
    bf16_t* RAW2 = (bf16_t*)(ws + WS_RAW2); bf16_t* PBF = (bf16_t*)(ws + WS_PBF);

    {
        PHASE_IDS();
        LAS float* wf = (LAS float*)ldsl;
        const float* w_in = args.in[I_WIN]; const float* gpm = args.in[I_GPREMIX];
        for (int idx = tid; idx < DM * 8; idx += NTHREADS) { const int k = idx >> 3, c = idx & 7;
            const float val = w_in[(size_t)k * INW + 4096 + c] * gpm[k];
            const int l = (k & 255) >> 2, i = k & 3, j = k >> 8; wf[((j * 4 + i) * 64 + l) * 8 + c] = val; }
        __syncthreads();
        for (int m = gw; m < M; m += NGW) {
            const f32x4* xr = (const f32x4*)(x + (size_t)m * DM) + lane; f32x4 v[8]; float ss = 0.f;
#pragma unroll
            for (int j = 0; j < 8; ++j) { v[j] = xr[64 * j]; ss += (v[j].x * v[j].x + v[j].y * v[j].y) + (v[j].z * v[j].z + v[j].w * v[j].w); }
            const float rs = 1.0f / sqrtf(wave_sum(ss) * (1.f / DM) + EPS);
            float fa[8] = {0.f, 0.f, 0.f, 0.f, 0.f, 0.f, 0.f, 0.f};
#pragma unroll
            for (int j = 0; j < 8; ++j)
#pragma unroll
                for (int i = 0; i < 4; ++i) { const LAS f32x4* wp = (const LAS f32x4*)(wf + ((j * 4 + i) * 64 + lane) * 8); const f32x4 w0 = wp[0], w1 = wp[1]; const float xv = v[j][i];
                    fa[0] += xv * w0.x; fa[1] += xv * w0.y; fa[2] += xv * w0.z; fa[3] += xv * w0.w; fa[4] += xv * w1.x; fa[5] += xv * w1.y; fa[6] += xv * w1.z; fa[7] += xv * w1.w; }
#pragma unroll
            for (int c = 0; c < 8; ++c) fa[c] = wave_sum(fa[c]) * rs;
            if (lane == 0) { *(f32x4*)(flog + (size_t)m * 8) = (f32x4){fa[0], fa[1], fa[2], fa[3]}; *(f32x4*)(flog + (size_t)m * 8 + 4) = (f32x4){fa[4], fa[5], fa[6], fa[7]}; }
            u32x2* o8 = (u32x2*)(HN + (size_t)m * DM) + lane;
#pragma unroll
            for (int j = 0; j < 8; ++j) { const f32x4 g = *((const f32x4*)gpm + lane + 64 * j); const f32x4 h = v[j] * rs * g;
                u32x2 w; w.x = cvt_pk_bf16(h.x, h.y); w.y = cvt_pk_bf16(h.z, h.w); o8[64 * j] = w; }
        }
        __syncthreads();
        LAS float* scr = (LAS float*)(ldsl + wave * 16384);
        constexpr int IT_IN = (DM / 64) * (4096 / 32), IT_OUT = (DM / 64) * (DM / 32), IT_UP = (DM / 64) * (DFF / 32), IT_DOWN = (DFF / 64) * (DM / 32),
                      IT_GATE = IT_OUT, IT_PLE = (PLE / 64) * (DM / 32), IT_POOL1 = (256 / 64) * (256 / 32);
        constexpr int NITEMS = IT_IN + IT_OUT + IT_UP + IT_DOWN + IT_GATE + IT_PLE + 4 * IT_POOL1;
        for (int it = gw; it < NITEMS; it += NGW) {
            int r = it;
            if (r < IT_IN) { p0_transpose_item(args.in[I_WIN], DM, 4096, INW, WinT, 0, scr, r, lane); continue; } r -= IT_IN;
            if (r < IT_OUT) { p0_transpose_item(args.in[I_WOUT], DM, DM, DM, WoutT, 0, scr, r, lane); continue; } r -= IT_OUT;
            if (r < IT_UP) { p0_transpose_item(args.in[I_WUP], DM, DFF, DFF, WupT, 0, scr, r, lane); continue; } r -= IT_UP;
            if (r < IT_DOWN) { p0_transpose_item(args.in[I_WDOWN], DFF, DM, DM, WdownT, 0, scr, r, lane); continue; } r -= IT_DOWN;
            if (r < IT_GATE) { p0_transpose_item(args.in[I_WGATE], DM, DM, DM, WgateT, 0, scr, r, lane); continue; } r -= IT_GATE;
            if (r < IT_PLE) { p0_transpose_item(args.in[I_WPLE], PLE, DM, DM, WpleT, 0, scr, r, lane); continue; } r -= IT_PLE;
            { const int gi = r / IT_POOL1; p0_transpose_item(args.in[I_WPOOL] + (size_t)gi * 65536, 256, 256, 256, WpoolT, gi * 256, scr, r % IT_POOL1, lane); }
        }
        const float* p = args.in[I_P];
        for (int idx = bid * NTHREADS + tid; idx < M * PLE / 8; idx += G * NTHREADS) { const f32x4 a = *((const f32x4*)p + 2 * idx), b = *((const f32x4*)p + 2 * idx + 1);
            u32x4 w; w.x = cvt_pk_bf16(a.x, a.y); w.y = cvt_pk_bf16(a.z, a.w); w.z = cvt_pk_bf16(b.x, b.y); w.w = cvt_pk_bf16(b.z, b.w); *((u32x4*)PBF + idx) = w; }
    }
    grid.sync();

    {
        pg8::Gemm g{HN, WinT, DM, DM, DM, 0}; pg8::StaticOrder S; S.init(M, 4096, G, bid);
        pg8::EpiG<0> E{U, 1024, 1024, (size_t)(AR_Q - AR_U) / 2, nullptr, nullptr};
        pg8::gemm_phase(ldsl, g, S, E);
    }
    grid.sync();

    {
        PHASE_IDS();
        for (int idx = bid * NTHREADS + tid; idx < M * (POOLW / 8); idx += G * NTHREADS) {
            const int token = idx >> 7, c = (idx & 127) * 8, gi = c >> 8, w = 2 << gi, pos = token & (SEQ - 1);
            const int n = (pos + 1 < w) ? pos + 1 : w;
            float s[8] = {0.f, 0.f, 0.f, 0.f, 0.f, 0.f, 0.f, 0.f}, cur[8];
            const bf16_t* up = U + (size_t)token * POOLW + c;
            for (int j = 0; j < n; ++j) { const u32x4 v = *(const u32x4*)(up - (size_t)j * POOLW);
                const float f[8] = {bf_lo(v.x), bf_hi(v.x), bf_lo(v.y), bf_hi(v.y), bf_lo(v.z), bf_hi(v.z), bf_lo(v.w), bf_hi(v.w)};
#pragma unroll
                for (int e = 0; e < 8; ++e) { s[e] += f[e]; if (j == 0) cur[e] = f[e]; } }
            const float inv = 1.0f / (float)n;
            u32x4 o; o.x = cvt_pk_bf16(s[0] * inv - cur[0], s[1] * inv - cur[1]); o.y = cvt_pk_bf16(s[2] * inv - cur[2], s[3] * inv - cur[3]);
            o.z = cvt_pk_bf16(s[4] * inv - cur[4], s[5] * inv - cur[5]); o.w = cvt_pk_bf16(s[6] * inv - cur[6], s[7] * inv - cur[7]);
            *(u32x4*)(DP + (size_t)token * POOLW + c) = o;
        }
        if (gw < NB * NH) {
            const int b = gw >> 3, h = gw & 7; const float bfv = args.in[I_BF][h];
            const float* fl = flog + ((size_t)b * SEQ + 32 * lane) * 8 + h;
            float tot = 0.f;
            for (int i = 0; i < 32; ++i) tot += log_sigmoid(fl[i * 8] + bfv);
            float incl = tot;
#pragma unroll
            for (int o = 1; o < 64; o <<= 1) { const float t = __shfl_up(incl, o); if (lane >= o) incl += t; }
            float run = incl - tot;
            float* fo = fb + (size_t)gw * SEQ + 32 * lane;
            for (int i = 0; i < 32; ++i) { run += log_sigmoid(fl[i * 8] + bfv); fo[i] = -run * 11.313708498984761f; }
        }
    }
    grid.sync();

    {
        const int xcd = bid & 7, ix = bid >> 3;
        const int bh = (xcd * 4 + (ix >> 3)) & 31, qb = ix & 7, b = bh >> 3, h = bh & 7;
        if (bid < 256) {
            att::BlockRef cur;
            const size_t rowb = (size_t)b * SEQ;
            cur.Q = Qb + (rowb + (size_t)qb * 256) * 1024 + h * HD; cur.K = Kb + rowb * 1024 + h * HD; cur.V = Vb + rowb * 1024 + h * HD;
            cur.FB = fb + (size_t)bh * SEQ; cur.O = YA + (rowb + (size_t)qb * 256) * 1024 + h * HD; cur.P0 = qb * 256;
            att::Seam S;
            att::prime(cur, (char*)lds, S);
            att::block(cur, cur, (char*)lds, S);
            asm volatile("s_waitcnt vmcnt(0)" ::: "memory");
            __syncthreads();
        }
        {
            pg8::SingleUnit S; const int id = bh * 4 + qb; S.valid = (bid < 256 && qb < 4) ? 1 : 0; S.pm = id >> 2; S.pn = id & 3;
            pg8::Gemm g{DP, WpoolT, POOLW, 256, 256, 256};
            pg8::EpiG<4> E{YP, POOLW, 0, 0, args.in[I_POOLSCALE], nullptr};
            pg8::gemm_phase(ldsl, g, S, E);
        }
    }
    grid.sync();

    { PHASE_IDS();
    for (int m = gw; m < M; m += NGW) {
        row_norm1024(YP + (size_t)m * POOLW, args.in[I_GPOOLOUT], Y + (size_t)m * DM, lane);
        row_norm1024(YA + (size_t)m * ATTW, args.in[I_GATTNOUT], Y + (size_t)m * DM + POOLW, lane);
    } }
    grid.sync();

    {
        pg8::Gemm g{Y, WoutT, DM, DM, DM, 0}; pg8::StaticOrder S; S.init(M, DM, G, bid);
        pg8::EpiG<0> E{RAW1, DM, 0, 0, nullptr, nullptr};
        pg8::gemm_phase(ldsl, g, S, E);
    }
    grid.sync();

    { PHASE_IDS();
    for (int m = gw; m < M; m += NGW)
        row_resnorm(x + (size_t)m * DM, RAW1 + (size_t)m * DM, args.in[I_GPOSTMIX], out + (size_t)m * DM, args.in[I_GPREMLP], HN + (size_t)m * DM, lane); }
    grid.sync();

    {
        pg8::Gemm g{HN, WupT, DM, DM, DM, 0}; pg8::StaticOrder S; S.init(M, DFF, G, bid);
        pg8::EpiG<2> E{HID, DFF, 0, 0, nullptr, nullptr};
        pg8::gemm_phase(ldsl, g, S, E);
    }
    grid.sync();

    {
        pg8::Gemm g{HID, WdownT, DFF, DFF, DFF, 0}; pg8::StaticOrder S; S.init(M, DM, G, bid);
        pg8::EpiG<0> E{RAW2, DM, 0, 0, nullptr, nullptr};
        pg8::gemm_phase(ldsl, g, S, E);
    }
    grid.sync();

    { PHASE_IDS();
    for (int m = gw; m < M; m += NGW)
        row_resnorm(out + (size_t)m * DM, RAW2 + (size_t)m * DM, args.in[I_GPOSTMLP], out + (size_t)m * DM, args.in[I_GPLEGATE], HN + (size_t)m * DM, lane); }
    grid.sync();

    {
        pg8::StaticOrder S; S.init(M, DM, G, bid);
        { pg8::Gemm g{PBF, WpleT, PLE, PLE, PLE, 0}; pg8::EpiG<0> E{Eb, DM, 0, 0, nullptr, nullptr}; pg8::gemm_phase(ldsl, g, S, E); }
        asm volatile("s_waitcnt vmcnt(0)" ::: "memory");
        __syncthreads();
        { pg8::Gemm g{HN, WgateT, DM, DM, DM, 0}; pg8::EpiG<3> E{RAW2, DM, 0, 0, nullptr, Eb}; pg8::gemm_phase(ldsl, g, S, E); }
    }
    grid.sync();

    { PHASE_IDS();
    for (int m = gw; m < M; m += NGW)
        row_resnorm(out + (size_t)m * DM, RAW2 + (size_t)m * DM, args.in[I_GPOSTPLE], out + (size_t)m * DM, nullptr, nullptr, lane); }
}

extern "C" void kernel_launch(void* const* d_in, const int* in_sizes, int n_in, void* d_out, int out_size, void* d_ws, size_t ws_size, hipStream_t stream) {
    static int grid = 0;
    if (grid == 0) {
        if (n_in != 19 || in_sizes[0] != M * DM || out_size != M * DM || ws_size < WS_END) {
            fprintf(stderr, "kernel_launch: unexpected shapes (n_in %d in0 %d out %d ws %zu)\n", n_in, n_in > 0 ? in_sizes[0] : -1, out_size, ws_size); grid = -1; return; }
        int dev = 0, cus = 0, per_cu = 0;
        hipGetDevice(&dev); hipDeviceGetAttribute(&cus, hipDeviceAttributeMultiprocessorCount, dev);
        if (hipFuncSetAttribute((const void*)mega_fwd, hipFuncAttributeMaxDynamicSharedMemorySize, LDS_BYTES) != hipSuccess) { fprintf(stderr, "kernel_launch: hipFuncSetAttribute failed\n"); grid = -1; return; }
        if (hipOccupancyMaxActiveBlocksPerMultiprocessor(&per_cu, (const void*)mega_fwd, NTHREADS, LDS_BYTES) != hipSuccess || per_cu < 1) {
            fprintf(stderr, "kernel_launch: occupancy query says %d\n", per_cu); per_cu = 1; }
        (void)hipGetLastError();
        grid = cus * 1;
        if (grid != 256) fprintf(stderr, "kernel_launch: grid %d (expected 256)\n", grid);
    }
    if (grid < 0) return;
    Args a{};
    for (int i = 0; i < 19; ++i) a.in[i] = (const float*)d_in[i];
    a.out = (float*)d_out; a.ws = (unsigned char*)d_ws;
    void* kargs[] = {&a};
    hipError_t e = hipLaunchCooperativeKernel((const void*)mega_fwd, dim3(grid), dim3(NTHREADS), kargs, LDS_BYTES, stream);
    if (e != hipSuccess) fprintf(stderr, "kernel_launch: cooperative launch failed: %s (grid %d)\n", hipGetErrorString(e), grid);
}
```

```cpp
#include <hip/hip_runtime.h>
#include <hip/hip_bf16.h>
#include <hip/hip_cooperative_groups.h>
#include <cstdio>
#include <cstdint>
namespace cg = cooperative_groups;

#define LAS __attribute__((address_space(3)))
typedef unsigned short bf16_t;
typedef short bf16x8 __attribute__((ext_vector_type(8)));
typedef short s16x4 __attribute__((ext_vector_type(4)));
typedef float f32x4 __attribute__((ext_vector_type(4)));
typedef float f32x2 __attribute__((ext_vector_type(2)));
typedef float f32x16 __attribute__((ext_vector_type(16)));
typedef unsigned u32x4 __attribute__((ext_vector_type(4)));
typedef unsigned u32x2 __attribute__((ext_vector_type(2)));

constexpr int DM = 2048, SEQ = 2048, NB = 4, M = NB * SEQ, POOLW = 1024, ATTW = 1024, NH = 8, HD = 128, DFF = 8192, PLE = 256, INW = 4104;
constexpr float EPS = 1e-6f;

constexpr size_t MiB = 1u << 20;
constexpr size_t WS_FLOG = 1 * MiB;
constexpr size_t WS_FB = 1 * MiB + 512 * 1024;
constexpr size_t WS_WIN = 2 * MiB, WS_WOUT = 18 * MiB, WS_WUP = 26 * MiB, WS_WDOWN = 58 * MiB, WS_WGATE = 90 * MiB, WS_WPLE = 98 * MiB, WS_WPOOL = 99 * MiB;
constexpr size_t WS_HN = 100 * MiB;
constexpr size_t WS_ARENA = 132 * MiB;
constexpr size_t AR_U = WS_ARENA, AR_Q = WS_ARENA + 16 * MiB, AR_K = WS_ARENA + 32 * MiB, AR_V = WS_ARENA + 48 * MiB;
constexpr size_t AR_YP = WS_ARENA + 64 * MiB, AR_YA = WS_ARENA + 80 * MiB, AR_DP = WS_ARENA + 96 * MiB;
constexpr size_t AR_Y = WS_ARENA;
constexpr size_t AR_RAW1 = WS_ARENA + 32 * MiB;
constexpr size_t AR_HID = WS_ARENA;
constexpr size_t AR_E = WS_ARENA;
constexpr size_t WS_RAW2 = WS_WUP;
constexpr size_t WS_PBF = 260 * MiB;
constexpr size_t WS_END = 264 * MiB;

__device__ __forceinline__ unsigned cvt_pk_bf16(float lo, float hi) { unsigned r; asm volatile("v_cvt_pk_bf16_f32 %0, %1, %2" : "=v"(r) : "v"(lo), "v"(hi)); return r; }
__device__ __forceinline__ int fresh_tid() { int t = threadIdx.x; asm volatile("" : "+v"(t)); return t; }
__device__ __forceinline__ float bf_lo(unsigned w) { return __uint_as_float(w << 16); }
__device__ __forceinline__ float bf_hi(unsigned w) { return __uint_as_float(w & 0xffff0000u); }
__device__ __forceinline__ float wave_sum(float v) {
#pragma unroll
    for (int o = 1; o < 64; o <<= 1) v += __shfl_xor(v, o);
    return v;
}

namespace pg8 {
constexpr int BM = 256, BK = 64, HALF = 128, HTB = HALF * BK * 2, STAGE_BYTES = 8 * HTB, NXCD = 8, WGM = 8;
__host__ __device__ __forceinline__ int lds_byte(int r, int c) { const int st = (r >> 4) * 2 + (c >> 5), rr = r & 15, cc = c & 31, ob = rr * 64 + cc * 2; return st * 1024 + (ob ^ (((ob >> 9) & 1) << 5)); }
__host__ __device__ __forceinline__ void stage_rc(int b, int& R, int& C) { const int st = b / 1024, sb = b % 1024, swz = sb ^ (((sb >> 9) & 1) << 5); R = (st >> 1) * 16 + swz / 64; C = (st & 1) * 32 + (swz % 64) / 2; }
__host__ __device__ __forceinline__ int perm32(int rho) { const int n = rho >> 4, i = rho & 15; return 8 * (i >> 2) + 4 * n + (i & 3); }

struct Unit { int pm, pn; };
struct Gemm { const bf16_t* A; const bf16_t* Bt; int lda, ldb, K, a_pn_koff; };

struct StaticOrder {
    int nM, nN, nwg, G, c;
    __device__ void init(int M_, int N_, int G_, int c_) { nM = M_ / BM; nN = N_ / BM; nwg = nM * nN; G = G_; c = c_; }
    __device__ bool next(int i, Unit& u) const {
        const long L = (long)i * G + c; if (L >= nwg) return false;
        int wgid = (int)L; { const int q = nwg / NXCD, r = nwg % NXCD, xcd = wgid % NXCD, off = wgid / NXCD; wgid = (xcd < r ? xcd * (q + 1) : r * (q + 1) + (xcd - r) * q) + off; }
        const int nig = WGM * nN, gid = wgid / nig, fm = gid * WGM, gsz = (nM - fm) < WGM ? (nM - fm) : WGM;
        u.pm = fm + ((wgid % nig) % gsz); u.pn = (wgid % nig) / gsz; return true;
    }
};
struct SingleUnit {
    int pm, pn, valid;
    __device__ bool next(int i, Unit& u) const { if (i != 0 || !valid) return false; u.pm = pm; u.pn = pn; return true; }
};

template <int ACT> struct EpiG {
    static constexpr bool PERM = true;
    bf16_t* O; int ldc; int split_cols; size_t split_stride; const float* colscale; const bf16_t* aux;
    __device__ __forceinline__ void operator()(const f32x4 (&acc)[2][2][4][2], const Unit& u, int wr, int wc, int fr, int fq) const {
        const int row0 = u.pm * BM + wr * 64 + fr; int colt = u.pn * BM; bf16_t* base = O;
        if (split_cols) { const int t = colt / split_cols; base += (size_t)t * split_stride; colt -= t * split_cols; }
        const int col0 = colt + wc * 32 + 8 * fq, gcol0 = u.pn * BM + wc * 32 + 8 * fq;
        f32x4 cs[2][2];
        if (ACT == 4) {
#pragma unroll
            for (int bj = 0; bj < 2; ++bj)
#pragma unroll
                for (int n = 0; n < 2; ++n) cs[bj][n] = *(const f32x4*)(colscale + gcol0 + bj * HALF + 4 * n);
        }
#pragma unroll
        for (int ai = 0; ai < 2; ++ai)
#pragma unroll
            for (int m = 0; m < 4; ++m) { const size_t roff = (size_t)(row0 + ai * HALF + m * 16) * ldc + col0;
#pragma unroll
                for (int bj = 0; bj < 2; ++bj) { f32x4 v0 = acc[ai][bj][m][0], v1 = acc[ai][bj][m][1];
                    if (ACT == 2) {
#pragma unroll
                        for (int e = 0; e < 4; ++e) { float a = fmaxf(v0[e], 0.f), b = fmaxf(v1[e], 0.f); v0[e] = a * a; v1[e] = b * b; }
                    }
                    if (ACT == 3) { const u32x4 ev = *(const u32x4*)(aux + roff + bj * HALF);
                        const float e0[4] = {bf_lo(ev.x), bf_hi(ev.x), bf_lo(ev.y), bf_hi(ev.y)}, e1[4] = {bf_lo(ev.z), bf_hi(ev.z), bf_lo(ev.w), bf_hi(ev.w)};
#pragma unroll
                        for (int e = 0; e < 4; ++e) { v0[e] = __builtin_amdgcn_rcpf(1.f + __builtin_amdgcn_exp2f(-1.4426950408889634f * v0[e])) * e0[e];
                                                      v1[e] = __builtin_amdgcn_rcpf(1.f + __builtin_amdgcn_exp2f(-1.4426950408889634f * v1[e])) * e1[e]; }
                    }
                    if (ACT == 4) { v0 = v0 * cs[bj][0]; v1 = v1 * cs[bj][1]; }
                    u32x4 w; w.x = cvt_pk_bf16(v0[0], v0[1]); w.y = cvt_pk_bf16(v0[2], v0[3]); w.z = cvt_pk_bf16(v1[0], v1[1]); w.w = cvt_pk_bf16(v1[2], v1[3]);
                    *(u32x4*)(base + roff + bj * HALF) = w; } }
    }
};

template <class Epi, class Sched>
__device__ __forceinline__ void gemm_phase(LAS unsigned char* lds, const Gemm g, const Sched& S, const Epi& E) {
    constexpr bool ALIGN_EPI = true;
    const int tid = fresh_tid(), wid = __builtin_amdgcn_readfirstlane(tid >> 6), lane = tid & 63, wr = wid >> 2, wc = wid & 3, fr = lane & 15, fq = lane >> 4;
    const int K = g.K, nt = K / BK;
    unsigned voffA[2], voffB[2];
#pragma unroll
    for (int i = 0; i < 2; ++i) { int R, C; stage_rc(tid * 16 + i * 8192, R, C); const int Rb = Epi::PERM ? ((R & ~31) + perm32(R & 31)) : R;
        voffA[i] = (unsigned)(R * g.lda + C) * 2u; voffB[i] = (unsigned)(Rb * g.ldb + C) * 2u; }
    const size_t kstep = (size_t)(BK * 2);
    const size_t hstepA = (size_t)HALF * g.lda * 2, hstepB = (size_t)HALF * g.ldb * 2;
    const size_t tstepA = 2 * hstepA, tstepB = 2 * hstepB;
    const unsigned ldsw = (unsigned)wid * 1024u;
    const int aoff = lds_byte(wr * 64 + fr, fq * 8), boff = lds_byte(wc * 32 + fr, fq * 8);
#define PG8_SA(b, h) (((b) * 2 + (h)) * HTB)
#define PG8_SB(b, h) ((4 + (b) * 2 + (h)) * HTB)
#define PG8_STAGE(bufoff, gbase, voff) do { _Pragma("unroll") for (int _i = 0; _i < 2; ++_i) \
        __builtin_amdgcn_global_load_lds((const unsigned*)((const char*)(gbase) + (voff)[_i]), (LAS unsigned*)(lds + (bufoff) + ldsw + _i * 8192), 16, 0, 0); } while (0)
#define PG8_LDA(dst, b, h) do { _Pragma("unroll") for (int m = 0; m < 4; ++m) _Pragma("unroll") for (int k = 0; k < 2; ++k) dst[m][k] = *(const LAS bf16x8*)(lds + PG8_SA(b, h) + aoff + m * 2048 + k * 1024); } while (0)
#define PG8_LDB(dst, b, h) do { _Pragma("unroll") for (int n = 0; n < 2; ++n) _Pragma("unroll") for (int k = 0; k < 2; ++k) dst[n][k] = *(const LAS bf16x8*)(lds + PG8_SB(b, h) + boff + n * 2048 + k * 1024); } while (0)
#define PG8_MMA(ai, bj, At, Bt) do { __builtin_amdgcn_s_setprio(1); _Pragma("unroll") for (int m = 0; m < 4; ++m) _Pragma("unroll") for (int n = 0; n < 2; ++n) _Pragma("unroll") for (int k = 0; k < 2; ++k) \
        acc[ai][bj][m][n] = __builtin_amdgcn_mfma_f32_16x16x32_bf16(Bt[n][k], At[m][k], acc[ai][bj][m][n], 0, 0, 0); __builtin_amdgcn_s_setprio(0); } while (0)
#define PG8_WAIT_V(n) asm volatile("s_waitcnt vmcnt(" #n ")" ::: "memory")
#define PG8_WAIT_L(n) asm volatile("s_waitcnt lgkmcnt(" #n ")" ::: "memory")
#define PG8_BAR __builtin_amdgcn_s_barrier()
#define PG8_SCHED __builtin_amdgcn_sched_barrier(0)
    Unit cur, nxt; int ui = 0;
    if (!S.next(0, cur)) return;
    f32x4 acc[2][2][4][2];
#pragma unroll
    for (int a = 0; a < 2; ++a)
#pragma unroll
        for (int b = 0; b < 2; ++b)
#pragma unroll
            for (int m = 0; m < 4; ++m)
#pragma unroll
                for (int n = 0; n < 2; ++n) acc[a][b][m][n] = (f32x4){0.f, 0.f, 0.f, 0.f};
    bf16x8 At[4][2], B0[2][2], B1[2][2];
    const char* cA = (const char*)g.A + (size_t)cur.pm * tstepA + (size_t)cur.pn * g.a_pn_koff * 2; const char* cB = (const char*)g.Bt + (size_t)cur.pn * tstepB;
    PG8_STAGE(PG8_SB(0, 0), cB, voffB); PG8_STAGE(PG8_SB(0, 1), cB + hstepB, voffB); PG8_STAGE(PG8_SA(0, 0), cA, voffA); PG8_STAGE(PG8_SA(0, 1), cA + hstepA, voffA);
    if (wr == 1) PG8_BAR;
    PG8_WAIT_V(2); PG8_BAR;
    PG8_STAGE(PG8_SB(1, 0), cB + kstep, voffB); PG8_STAGE(PG8_SA(1, 0), cA + kstep, voffA); PG8_STAGE(PG8_SB(1, 1), cB + hstepB + kstep, voffB);
    PG8_WAIT_V(6); PG8_BAR;
    for (;;) {
        const bool has_next = S.next(ui + 1, nxt);
        const char* nA = has_next ? (const char*)g.A + (size_t)nxt.pm * tstepA + (size_t)nxt.pn * g.a_pn_koff * 2 : cA; const char* nB = has_next ? (const char*)g.Bt + (size_t)nxt.pn * tstepB : cB;
        asm volatile("" : "+s"(nA), "+s"(nB));
        for (int t = 0; t < nt; t += 2) {
            const bool last = (t == nt - 2);
            const char* a1 = cA + (size_t)(t + 1) * kstep;
            const char* a2 = last ? nA : cA + (size_t)(t + 2) * kstep; const char* b2 = last ? nB : cB + (size_t)(t + 2) * kstep;
            const char* a3 = a2 + kstep; const char* b3 = b2 + kstep;
            PG8_LDB(B0, 0, 0); PG8_LDB(B1, 0, 1); PG8_SCHED; PG8_LDA(At, 0, 0); PG8_STAGE(PG8_SA(1, 1), a1 + hstepA, voffA);
            PG8_WAIT_V(8); PG8_WAIT_L(0); PG8_BAR; PG8_MMA(0, 0, At, B0); PG8_MMA(0, 1, At, B1); PG8_BAR; PG8_SCHED;
            PG8_LDA(At, 0, 1); PG8_STAGE(PG8_SB(0, 0), b2, voffB); PG8_STAGE(PG8_SB(0, 1), b2 + hstepB, voffB); PG8_STAGE(PG8_SA(0, 0), a2, voffA);
            PG8_WAIT_V(8); PG8_WAIT_L(0); PG8_BAR; PG8_MMA(1, 0, At, B0); PG8_MMA(1, 1, At, B1); PG8_BAR; PG8_SCHED;
            PG8_LDB(B0, 1, 0); PG8_LDB(B1, 1, 1); PG8_SCHED; PG8_LDA(At, 1, 0); PG8_STAGE(PG8_SA(0, 1), a2 + hstepA, voffA);
            PG8_WAIT_V(8); PG8_WAIT_L(0); PG8_BAR; PG8_MMA(0, 0, At, B0); PG8_MMA(0, 1, At, B1); PG8_BAR; PG8_SCHED;
            PG8_LDA(At, 1, 1); PG8_STAGE(PG8_SB(1, 0), b3, voffB); PG8_STAGE(PG8_SB(1, 1), b3 + hstepB, voffB); PG8_STAGE(PG8_SA(1, 0), a3, voffA);
            PG8_WAIT_V(8); PG8_WAIT_L(0); PG8_BAR; PG8_MMA(1, 0, At, B0); PG8_MMA(1, 1, At, B1); PG8_BAR; PG8_SCHED;
        }
        if constexpr (ALIGN_EPI) { if (wr == 0) PG8_BAR; }
        E(acc, cur, wr, wc, fr, fq);
        if (!has_next) break;
#pragma unroll
        for (int a = 0; a < 2; ++a)
#pragma unroll
            for (int b = 0; b < 2; ++b)
#pragma unroll
                for (int m = 0; m < 4; ++m)
#pragma unroll
                    for (int n = 0; n < 2; ++n) acc[a][b][m][n] = (f32x4){0.f, 0.f, 0.f, 0.f};
        cur = nxt; cA = nA; cB = nB; ++ui;
        if constexpr (ALIGN_EPI) { if (wr == 1) PG8_BAR; }
    }
    PG8_WAIT_V(0);
    if constexpr (!ALIGN_EPI) { if (wr == 0) PG8_BAR; }
    PG8_BAR;
#undef PG8_SA
#undef PG8_SB
#undef PG8_STAGE
#undef PG8_LDA
#undef PG8_LDB
#undef PG8_MMA
#undef PG8_WAIT_V
#undef PG8_WAIT_L
#undef PG8_BAR
#undef PG8_SCHED
}
}

namespace att {
constexpr int D = 128, LD = 1024;
constexpr float SCALE = 0.08838834764831845f;
constexpr float THR = 8.f;
constexpr int NW = 8, QBLK = 32, KVBLK = 64, QB = NW * QBLK;
constexpr int SHM_V = KVBLK * D * 2, SHM_K = KVBLK * D * 2;
constexpr int OFF_WS = 2 * SHM_V + 2 * SHM_K, OFF_BIAS = OFF_WS + NW * 64 * 4, LDS_BYTES = OFF_BIAS + 512;
typedef bf16_t bf16;
#define KSWZ(row, colB) ((row) * 256 + ((colB) ^ (((row) & 7) << 4)))
#define SBAR() __builtin_amdgcn_sched_barrier(0)
__device__ __forceinline__ int v_st(int k, int c) { const int kk = (k & ~0xC) | ((k & 4) << 1) | ((k & 8) >> 1); return ((kk >> 3) * 4 + (c >> 5)) * 512 + ((kk & 7) * 32 + (c & 31)) * 2; }
__device__ __forceinline__ int v_rd_base(int lane) { return ((lane & 3) << 3) | (((lane >> 2) & 3) << 6) | (((lane >> 4) & 1) << 5) | (((lane >> 5) & 1) << 8); }
constexpr int v_rd_off(int d0, int ks, int half) { return d0 * 512 + ks * 4096 + half * 2048; }
__device__ __forceinline__ int crow(int r, int hi) { return (r & 3) + 8 * (r >> 2) + 4 * hi; }
__device__ __forceinline__ unsigned cvtpk(float lo, float hi) { unsigned r; asm volatile("v_cvt_pk_bf16_f32 %0, %1, %2" : "=v"(r) : "v"(lo), "v"(hi)); return r; }
__device__ __forceinline__ bf16x8 load8(const bf16* p) { return *reinterpret_cast<const bf16x8*>(p); }
__device__ __forceinline__ void mask_tile(f32x16& p0, f32x16& p1, int dq, unsigned W) {
    const float NEG = -__builtin_inff();
#pragma unroll
    for (int r = 0; r < 16; ++r) {
        const int c = (r & 3) + 8 * (r >> 2);
        if ((unsigned)(dq - c) >= W) p0[r] = NEG;
        if ((unsigned)(dq - c - 32) >= W) p1[r] = NEG;
    }
}
__device__ __forceinline__ void partialSM(f32x16& p0, f32x16& p1, float& m_reg, float& mn, float& alpha) {
    float pmax = p0[0]; for (int r = 1; r < 16; ++r) pmax = fmaxf(pmax, p0[r]); for (int r = 0; r < 16; ++r) pmax = fmaxf(pmax, p1[r]);
    { auto rr = __builtin_amdgcn_permlane32_swap(__float_as_uint(pmax), __float_as_uint(pmax), false, false);
      pmax = fmaxf(__uint_as_float(rr[0]), __uint_as_float(rr[1])); }
    constexpr float C2 = 1.4426950408889634f * SCALE;
    if (__builtin_expect(__all((pmax - m_reg) * SCALE <= THR), 1)) { mn = m_reg; alpha = 1.f; }
    else { mn = fmaxf(m_reg, pmax); alpha = __builtin_amdgcn_exp2f((m_reg - mn) * C2); m_reg = mn; }
    const float mnL = -mn * C2;
    for (int r = 0; r < 16; ++r) p0[r] = fmaf(p0[r], C2, mnL); for (int r = 0; r < 16; ++r) p1[r] = fmaf(p1[r], C2, mnL);
    for (int r = 0; r < 16; ++r) p0[r] = __builtin_amdgcn_exp2f(p0[r]);
}
__device__ __forceinline__ void finishSM(f32x16& p0, f32x16& p1, float alpha, float& l_reg, bf16x8& pa0, bf16x8& pa1, bf16x8& pa2, bf16x8& pa3) {
    for (int r = 0; r < 16; ++r) p1[r] = __builtin_amdgcn_exp2f(p1[r]);
    float ps = 0; for (int r = 0; r < 16; ++r) ps += p0[r]; for (int r = 0; r < 16; ++r) ps += p1[r];
    { auto rr = __builtin_amdgcn_permlane32_swap(__float_as_uint(ps), __float_as_uint(ps), false, false);
      ps = __uint_as_float(rr[0]) + __uint_as_float(rr[1]); }
    l_reg = l_reg * alpha + ps;
#define PK4(P, B_, OUT) do { unsigned a0 = cvtpk(P[B_+0], P[B_+1]), a1 = cvtpk(P[B_+2], P[B_+3]);                          \
        unsigned b0 = cvtpk(P[B_+4], P[B_+5]), b1 = cvtpk(P[B_+6], P[B_+7]);                                             \
        auto r0 = __builtin_amdgcn_permlane32_swap(a0, b0, false, false); auto r1 = __builtin_amdgcn_permlane32_swap(a1, b1, false, false); \
        u32x4 w = {r0[0], r1[0], r0[1], r1[1]}; OUT = *reinterpret_cast<bf16x8*>(&w); } while (0)
    PK4(p0, 0, pa0); PK4(p0, 8, pa1); PK4(p1, 0, pa2); PK4(p1, 8, pa3);
#undef PK4
}
template <int KB>
__device__ __forceinline__ void qkt(f32x16& p0, f32x16& p1, const char* K_lds, const char* B_lds, int r32, int hi, const bf16x8* qr) {
    const f32x4* bp = (const f32x4*)(B_lds + KB * 256 + hi * 16);
#pragma unroll
    for (int i = 0; i < 4; ++i) { const f32x4 a = bp[2 * i], b = bp[8 + 2 * i];
        p0[4 * i] = a[0]; p0[4 * i + 1] = a[1]; p0[4 * i + 2] = a[2]; p0[4 * i + 3] = a[3];
        p1[4 * i] = b[0]; p1[4 * i + 1] = b[1]; p1[4 * i + 2] = b[2]; p1[4 * i + 3] = b[3]; }
    const char* kb[4];
#pragma unroll
    for (int dd = 0; dd < 4; ++dd) kb[dd] = K_lds + KB * SHM_K + KSWZ(r32, (dd * 16 + hi * 8) * 2);
#pragma unroll
    for (int d0 = 0; d0 < 8; ++d0) { const char* a = kb[d0 & 3] + (d0 >> 2) * 128;
        bf16x8 b0 = *reinterpret_cast<const bf16x8*>(a);
        bf16x8 b1 = *reinterpret_cast<const bf16x8*>(a + 32 * 256);
        p0 = __builtin_amdgcn_mfma_f32_32x32x16_bf16(b0, qr[d0], p0, 0, 0, 0);
        p1 = __builtin_amdgcn_mfma_f32_32x32x16_bf16(b1, qr[d0], p1, 0, 0, 0); }
}
template <int VB>
__device__ __forceinline__ void pv_tile(f32x16* o, int vb0, bf16x8 pa0, bf16x8 pa1, bf16x8 pa2, bf16x8 pa3) {
#define TRRD(dst, off) asm volatile("ds_read_b64_tr_b16 %0, %1 offset:%2" : "=&v"(dst) : "v"(vb0), "i"(off) : "memory")
#define PV_D0(d0) do { s16x4 l0, l1, l2, l3, h0, h1, h2, h3; constexpr int b_ = VB * SHM_V + v_rd_off(d0, 0, 0); \
        TRRD(l0, b_); TRRD(h0, b_ + 2048); TRRD(l1, b_ + 4096); TRRD(h1, b_ + 6144); TRRD(l2, b_ + 8192); TRRD(h2, b_ + 10240); TRRD(l3, b_ + 12288); TRRD(h3, b_ + 14336); \
        asm volatile("s_waitcnt lgkmcnt(0)" ::: "memory"); SBAR();   \
        o[d0] = __builtin_amdgcn_mfma_f32_32x32x16_bf16(pa0, (bf16x8){l0[0], l0[1], l0[2], l0[3], h0[0], h0[1], h0[2], h0[3]}, o[d0], 0, 0, 0);   \
        o[d0] = __builtin_amdgcn_mfma_f32_32x32x16_bf16(pa1, (bf16x8){l1[0], l1[1], l1[2], l1[3], h1[0], h1[1], h1[2], h1[3]}, o[d0], 0, 0, 0);   \
        o[d0] = __builtin_amdgcn_mfma_f32_32x32x16_bf16(pa2, (bf16x8){l2[0], l2[1], l2[2], l2[3], h2[0], h2[1], h2[2], h2[3]}, o[d0], 0, 0, 0);   \
        o[d0] = __builtin_amdgcn_mfma_f32_32x32x16_bf16(pa3, (bf16x8){l3[0], l3[1], l3[2], l3[3], h3[0], h3[1], h3[2], h3[3]}, o[d0], 0, 0, 0); } while (0)
    PV_D0(0); PV_D0(1); PV_D0(2); PV_D0(3);
#undef PV_D0
#undef TRRD
}
struct BlockRef { const bf16* Q; const bf16* K; const bf16* V; const float* FB; bf16* O; int P0; };
struct Seam { bf16x8 qr[8]; bf16x8 st_v0, st_v1, st_k0, st_k1; float st_b; };
#define ROW(p, k0, rr) ((p) + (size_t)((k0) + (rr)) * LD + sc)
#define VMW() asm volatile("s_waitcnt vmcnt(0)" ::: "memory")
#define VMWN(n) asm volatile("s_waitcnt vmcnt(%0)" :: "i"(n) : "memory")
#define SLOAD_H(Kp, Vp, Fp, k0) do { S.st_v0 = load8(ROW(Vp, k0, sr)); S.st_v1 = load8(ROW(Vp, k0, 32 + sr));              \
                         S.st_k0 = load8(ROW(Kp, k0, sr)); S.st_k1 = load8(ROW(Kp, k0, 32 + sr)); S.st_b = (Fp)[(k0) + (tid & 63)]; } while (0)
#define SWRITE_HK(bf) do { *(bf16x8*)(K_lds + (bf) * SHM_K + kws) = S.st_k0; *(bf16x8*)(K_lds + (bf) * SHM_K + kws + 32 * 256) = S.st_k1; \
                           if (tid < 64) ((float*)B_lds)[(bf) * 64 + tid] = S.st_b; } while (0)
#define SWRITE_HV(bf) do { *(bf16x8*)(V_lds + (bf) * SHM_V + vst0) = S.st_v0; *(bf16x8*)(V_lds + (bf) * SHM_V + vst1) = S.st_v1; } while (0)
#define SWRITE_H(bf) do { SWRITE_HV(bf); SWRITE_HK(bf); } while (0)
__device__ __forceinline__ void prime(const BlockRef& cur, char* lds, Seam& S) {
    const int tid = fresh_tid(), wid = __builtin_amdgcn_readfirstlane(tid >> 6), lane = tid & 63, r32 = lane & 31, hi = lane >> 5;
    const int sr = tid >> 4, sc = (tid & 15) * 8, kws = KSWZ(sr, sc * 2); char* K_lds = lds + 2 * SHM_V; char* B_lds = lds + OFF_BIAS;
    for (int d0 = 0; d0 < 8; ++d0) S.qr[d0] = load8(cur.Q + (size_t)(wid * QBLK + r32) * LD + d0 * 16 + hi * 8);
    SLOAD_H(cur.K, cur.V, cur.FB, 0); VMW(); SWRITE_HK(0);
    __syncthreads();
}
__device__ __forceinline__ void block(const BlockRef& cur, const BlockRef& nxt, char* lds, Seam& S) {
    const int tid = fresh_tid(), wid = __builtin_amdgcn_readfirstlane(tid >> 6), lane = tid & 63, r32 = lane & 31, hi = lane >> 5;
    constexpr unsigned W = 1u << 30;
    const int NT = (cur.P0 + QB - 1) / KVBLK + 1;
    const int qlo = cur.P0 + wid * QBLK, qm = qlo + r32 - 4 * hi;
    char* V_lds = lds; char* K_lds = lds + 2 * SHM_V; char* B_lds = lds + OFF_BIAS;
    float* ws = (float*)(lds + OFF_WS) + wid * 64; float* li_l = ws, * al_l = ws + 32;
    float m_reg = -1e30f, l_reg = 0; f32x16 o[4] = {};
    const int sr = tid >> 4, sc = (tid & 15) * 8, vst0 = v_st(sr, sc), vst1 = v_st(32 + sr, sc), kws = KSWZ(sr, sc * 2);
    const int vb0 = (int)(uintptr_t)V_lds + v_rd_base(lane);
    const bf16* Kh = cur.K; const bf16* Vh = cur.V; const float* Fh = cur.FB;
#define RESC(a) do { if (__any((a) < 1.f)) { if (hi == 0) al_l[r32] = (a); asm volatile("s_waitcnt lgkmcnt(0)" ::: "memory");              \
                     for (int d_ = 0; d_ < 4; ++d_) for (int r = 0; r < 16; ++r) o[d_][r] *= al_l[crow(r, hi)]; } } while (0)
#define KBASE(t) ((t) * KVBLK)
#define MASKT(P0_, P1_, t) do { const int kb_ = KBASE(t); if (kb_ + KVBLK - 1 > qlo) mask_tile(P0_, P1_, qm - kb_, W); } while (0)
    constexpr int NQL = 8;
#define SEAM_K0() do { VMWN(NQL); SWRITE_HK(0); SBAR(); } while (0)
    f32x16 pA0, pA1, pB0, pB1; float mnA, mnB, alA, alB; bf16x8 pa0, pa1, pa2, pa3;
    SWRITE_HV(0); SBAR();
    if (NT > 1) SLOAD_H(Kh, Vh, Fh, KBASE(1));
    SBAR(); qkt<0>(pA0, pA1, K_lds, B_lds, r32, hi, S.qr);
    MASKT(pA0, pA1, 0); partialSM(pA0, pA1, m_reg, mnA, alA);
    if (NT > 1) { VMW(); SWRITE_H(1); }
    __syncthreads();
#define HALF_STEP(PX0, PX1, mnX, alX, PY0, PY1, alY, t, KB, VB, SB) do {                                                      \
        SBAR(); qkt<KB>(PX0, PX1, K_lds, B_lds, r32, hi, S.qr);                                                               \
        finishSM(PY0, PY1, alY, l_reg, pa0, pa1, pa2, pa3); SBAR();                                                           \
        if ((t) + 1 < NT) { SLOAD_H(Kh, Vh, Fh, KBASE((t) + 1)); SBAR(); }                                                    \
        pv_tile<VB>(o, vb0, pa0, pa1, pa2, pa3); MASKT(PX0, PX1, (t)); partialSM(PX0, PX1, m_reg, mnX, alX);                  \
        __syncthreads();                                                                                                      \
        if ((t) + 1 < NT) { VMW(); SWRITE_H(SB); }                                                                            \
        RESC(alX); __syncthreads(); } while (0)
    for (int t = 1; t + 1 < NT; t += 2) {
        HALF_STEP(pB0, pB1, mnB, alB, pA0, pA1, alA, t, 1, 0, 0);
        HALF_STEP(pA0, pA1, mnA, alA, pB0, pB1, alB, t + 1, 0, 1, 1);
    }
    const bool even = (NT & 1) == 0;
    if (even) { SBAR(); qkt<1>(pB0, pB1, K_lds, B_lds, r32, hi, S.qr); SBAR(); }
    SLOAD_H(nxt.K, nxt.V, nxt.FB, 0); SBAR();
#pragma unroll
    for (int d0 = 0; d0 < 8; ++d0) S.qr[d0] = load8(nxt.Q + (size_t)(wid * QBLK + r32) * LD + d0 * 16 + hi * 8);
    SBAR();
    finishSM(pA0, pA1, alA, l_reg, pa0, pa1, pa2, pa3); SBAR();
    pv_tile<0>(o, vb0, pa0, pa1, pa2, pa3);
    if (even) { MASKT(pB0, pB1, NT - 1); partialSM(pB0, pB1, m_reg, mnB, alB); __syncthreads(); RESC(alB);
        finishSM(pB0, pB1, alB, l_reg, pa0, pa1, pa2, pa3); SBAR(); pv_tile<1>(o, vb0, pa0, pa1, pa2, pa3); }
    SBAR(); SEAM_K0();
    if (hi == 0) li_l[r32] = l_reg; asm volatile("s_waitcnt lgkmcnt(0)" ::: "memory");
    float rli[16];
#pragma unroll
    for (int r = 0; r < 16; ++r) rli[r] = __builtin_amdgcn_rcpf(li_l[crow(r, hi)]);
    bf16* Ow = cur.O + (size_t)(wid * QBLK) * LD;
#pragma unroll
    for (int r = 0; r < 16; ++r) { const int orow = crow(r, hi);
#pragma unroll
        for (int d0 = 0; d0 < 4; ++d0) { const float v = o[d0][r] * rli[r];
            const float vn = __shfl_xor(v, 1);
            if ((r32 & 1) == 0) *(unsigned*)(Ow + (size_t)orow * LD + d0 * 32 + r32) = cvtpk(v, vn); } }
    __syncthreads();
#undef RESC
#undef KBASE
#undef MASKT
#undef SEAM_K0
#undef HALF_STEP
}
#undef ROW
#undef VMW
#undef VMWN
#undef SLOAD_H
#undef SWRITE_HK
#undef SWRITE_HV
#undef SWRITE_H
#undef SBAR
#undef KSWZ
}

#define XB_TMO      128
#define XB_XCNT(j)  (256  + 64 * (j))
#define XB_XSUB(j)  (1280 + 64 * (j))
#define XB_XGEN(j)  (2304 + 64 * (j))
#define XB_TOP      3328
#define XB_TOPGEN   3392
#define XCD_BAR_WORDS 3456
#define XB_SPIN_CAP (1u << 18)
__device__ __forceinline__ unsigned xb_ld(unsigned* p)              { return __hip_atomic_load(p, __ATOMIC_RELAXED, __HIP_MEMORY_SCOPE_AGENT); }
__device__ __forceinline__ unsigned xb_add(unsigned* p, unsigned v) { return __hip_atomic_fetch_add(p, v, __ATOMIC_RELAXED, __HIP_MEMORY_SCOPE_AGENT); }
__device__ __forceinline__ unsigned xb_xcc_id() { return (unsigned)__builtin_amdgcn_s_getreg((3 << 11) | 20) & 0xFu; }
#define XB_SPIN(cond, bar) do { unsigned _sp = 0; while (cond) { __builtin_amdgcn_s_sleep(1); \
    if ((++_sp & 255u) == 0u) { if (xb_ld(&(bar)[XB_TMO])) break; if (_sp > XB_SPIN_CAP) { atomicAdd(&(bar)[XB_TMO], 1u); break; } } } } while (0)
struct XcdBarrier { unsigned* bar; unsigned x; volatile LAS unsigned* st; };
__device__ __forceinline__ XcdBarrier xcd_barrier_post(unsigned* bar, volatile LAS unsigned* st) {
    XcdBarrier b; b.bar = bar; b.x = xb_xcc_id(); b.st = st;
    if (threadIdx.x == 0) (void)xb_add(&bar[XB_XCNT(b.x)], 1u);
    return b;
}
__device__ __forceinline__ void xcd_barrier_complete(unsigned* bar, unsigned x, unsigned& nloc, unsigned& nx) {
    const unsigned G = gridDim.x * gridDim.y * gridDim.z;
    unsigned sum, cnt, mine, sp = 0u;
    for (;;) {
        sum = 0u; cnt = 0u; mine = 0u;
#pragma unroll
        for (unsigned j = 0; j < 16; ++j) { const unsigned c = xb_ld(&bar[XB_XCNT(j)]); sum += c; cnt += (c > 0u) ? 1u : 0u; mine = (j == x) ? c : mine; }
        if (sum == G) break;
        __builtin_amdgcn_s_sleep(1);
        if ((++sp & 255u) == 0u) { if (xb_ld(&bar[XB_TMO])) break; if (sp > XB_SPIN_CAP) { atomicAdd(&bar[XB_TMO], 1u); break; } }
    }
    nloc = mine > 0u ? mine : 1u; nx = cnt > 0u ? cnt : 1u;
}
__device__ __forceinline__ void xcd_barrier(const XcdBarrier& b) {
    asm volatile("s_waitcnt vmcnt(0)" ::: "memory");
    __syncthreads();
    if (threadIdx.x == 0) {
        unsigned* bar = b.bar;
        __builtin_amdgcn_s_waitcnt(0);
        unsigned nloc = b.st[0], nx = b.st[1];
        if (nloc == 0u) { xcd_barrier_complete(bar, b.x, nloc, nx); b.st[0] = nloc; b.st[1] = nx; }
        const unsigned old = xb_add(&bar[XB_XSUB(b.x)], 1u);
        const unsigned gen = old / nloc;
        if (old + 1u == (gen + 1u) * nloc) {
            __builtin_amdgcn_fence(__ATOMIC_RELEASE, "agent");
            asm volatile("s_waitcnt vmcnt(0)" ::: "memory");
            const unsigned og = xb_add(&bar[XB_TOP], 1u);
            const unsigned tg = og / nx;
            if (og + 1u == (tg + 1u) * nx) xb_add(&bar[XB_TOPGEN], 1u);
            else XB_SPIN(xb_ld(&bar[XB_TOPGEN]) == tg, bar);
            __builtin_amdgcn_fence(__ATOMIC_ACQUIRE, "agent");
            xb_add(&bar[XB_XGEN(b.x)], 1u);
            asm volatile("s_waitcnt vmcnt(0)" ::: "memory");
        } else {
            XB_SPIN(xb_ld(&bar[XB_XGEN(b.x)]) == gen, bar);
            __builtin_amdgcn_fence(__ATOMIC_ACQUIRE, "agent");
            asm volatile("s_waitcnt vmcnt(0)" ::: "memory");
        }
    }
    __syncthreads();
}

#ifndef PROBE_PHASE
#define PROBE_PHASE -1
#endif
#define PH(id) for (int rep_ = 0; rep_ < ((PROBE_PHASE == (id)) ? 2 : 1); ++rep_)
constexpr int NWAVES = 8, NTHREADS = 512;
constexpr int LDS_BYTES = 147456;
struct Args { const float* in[19]; float* out; unsigned char* ws; };
enum { I_X = 0, I_P, I_GPREMIX, I_WIN, I_BF, I_WPOOL, I_POOLSCALE, I_GPOOLOUT, I_GATTNOUT, I_WOUT, I_GPOSTMIX, I_GPREMLP, I_WUP, I_WDOWN, I_GPOSTMLP, I_GPLEGATE, I_WGATE, I_WPLE, I_GPOSTPLE };

__device__ __forceinline__ void p0_transpose_item(const float* W, int K, int N, int ldw, bf16_t* WT, int row_off, LAS float* scr, int item, int lane) {
    const int nblk = N / 32, kb = item / nblk, nb = item % nblk, k0 = 64 * kb, n0 = 32 * nb;
#pragma unroll 8
    for (int i = 0; i < 32; ++i) { const int kk = 2 * i + (lane >> 5); scr[kk * 33 + (lane & 31)] = W[(size_t)(k0 + kk) * ldw + n0 + (lane & 31)]; }
    asm volatile("s_waitcnt lgkmcnt(0)" ::: "memory");
    const int c = lane & 7;
#pragma unroll
    for (int j = 0; j < 4; ++j) { const int n = (lane >> 3) + 8 * j; const LAS float* s = scr + (8 * c) * 33 + n;
        u32x4 o; o.x = cvt_pk_bf16(s[0 * 33], s[1 * 33]); o.y = cvt_pk_bf16(s[2 * 33], s[3 * 33]); o.z = cvt_pk_bf16(s[4 * 33], s[5 * 33]); o.w = cvt_pk_bf16(s[6 * 33], s[7 * 33]);
        *(u32x4*)(WT + (size_t)(row_off + n0 + n) * K + k0 + 8 * c) = o; }
    asm volatile("s_waitcnt lgkmcnt(0)" ::: "memory");
}

__device__ __forceinline__ void row_resnorm(const float* base_row, const bf16_t* raw_row, const float* g_post, float* out_row, const float* g_next, bf16_t* hn_row, int lane) {
    f32x4 r[8]; float ss = 0.f;
#pragma unroll
    for (int j = 0; j < 8; ++j) { const u32x2 w = *((const u32x2*)raw_row + lane + 64 * j); r[j] = (f32x4){bf_lo(w.x), bf_hi(w.x), bf_lo(w.y), bf_hi(w.y)};
        ss += (r[j].x * r[j].x + r[j].y * r[j].y) + (r[j].z * r[j].z + r[j].w * r[j].w); }
    const float rs = 1.0f / sqrtf(wave_sum(ss) * (1.f / DM) + EPS);
    float ss2 = 0.f;
#pragma unroll
    for (int j = 0; j < 8; ++j) { const f32x4 b = *((const f32x4*)base_row + lane + 64 * j), g = *((const f32x4*)g_post + lane + 64 * j);
        r[j] = b + r[j] * rs * g; *((f32x4*)out_row + lane + 64 * j) = r[j];
        ss2 += (r[j].x * r[j].x + r[j].y * r[j].y) + (r[j].z * r[j].z + r[j].w * r[j].w); }
    if (g_next) {
        const float rs2 = 1.0f / sqrtf(wave_sum(ss2) * (1.f / DM) + EPS);
#pragma unroll
        for (int j = 0; j < 8; ++j) { const f32x4 g = *((const f32x4*)g_next + lane + 64 * j); const f32x4 h = r[j] * rs2 * g;
            u32x2 w; w.x = cvt_pk_bf16(h.x, h.y); w.y = cvt_pk_bf16(h.z, h.w); *((u32x2*)hn_row + lane + 64 * j) = w; }
    }
}
__device__ __forceinline__ void row_norm1024(const bf16_t* src, const float* g, bf16_t* dst, int lane) {
    float v[2][8]; float ss = 0.f;
#pragma unroll
    for (int j = 0; j < 2; ++j) { const u32x4 w = *((const u32x4*)src + lane + 64 * j);
        v[j][0] = bf_lo(w.x); v[j][1] = bf_hi(w.x); v[j][2] = bf_lo(w.y); v[j][3] = bf_hi(w.y); v[j][4] = bf_lo(w.z); v[j][5] = bf_hi(w.z); v[j][6] = bf_lo(w.w); v[j][7] = bf_hi(w.w);
#pragma unroll
        for (int e = 0; e < 8; ++e) ss += v[j][e] * v[j][e]; }
    const float rs = 1.0f / sqrtf(wave_sum(ss) * (1.f / 1024.f) + EPS);
#pragma unroll
    for (int j = 0; j < 2; ++j) { const f32x4 g0 = *((const f32x4*)g + 2 * (lane + 64 * j)), g1 = *((const f32x4*)g + 2 * (lane + 64 * j) + 1);
        u32x4 w; w.x = cvt_pk_bf16(v[j][0] * rs * g0.x, v[j][1] * rs * g0.y); w.y = cvt_pk_bf16(v[j][2] * rs * g0.z, v[j][3] * rs * g0.w);
        w.z = cvt_pk_bf16(v[j][4] * rs * g1.x, v[j][5] * rs * g1.y); w.w = cvt_pk_bf16(v[j][6] * rs * g1.z, v[j][7] * rs * g1.w);
        *((u32x4*)dst + lane + 64 * j) = w; }
}
__device__ __forceinline__ float log_sigmoid(float x) { return x < 0.f ? x - log1pf(expf(x)) : -log1pf(expf(-x)); }

__global__ void __launch_bounds__(NTHREADS, 2) mega_fwd(Args args) {
    extern __shared__ __attribute__((aligned(16))) unsigned char lds[];
    cg::grid_group grid = cg::this_grid();
    LAS unsigned char* ldsl = (LAS unsigned char*)lds;
    const int G = gridDim.x, bid = blockIdx.x, NGW = G * NWAVES;
#define PHASE_IDS() const int tid = fresh_tid(), lane = tid & 63, wave = __builtin_amdgcn_readfirstlane(tid >> 6), gw = bid * NWAVES + wave; (void)lane; (void)gw
    unsigned char* ws = args.ws;
    unsigned* barw = (unsigned*)ws;
    volatile LAS unsigned* MISC = (volatile LAS unsigned*)(ldsl + 131072 + 320);
    { const int t0 = fresh_tid(); if (t0 < 64) MISC[t0] = 0u;
      if (bid == 0) for (int i = t0; i < XCD_BAR_WORDS + 64; i += NTHREADS) __hip_atomic_store(barw + i, 0u, __ATOMIC_RELAXED, __HIP_MEMORY_SCOPE_AGENT);
      __syncthreads(); }
    const float* x = args.in[I_X];
    float* out = args.out;
    float* flog = (float*)(ws + WS_FLOG); float* fb = (float*)(ws + WS_FB);
    bf16_t* WinT = (bf16_t*)(ws + WS_WIN); bf16_t* WoutT = (bf16_t*)(ws + WS_WOUT); bf16_t* WupT = (bf16_t*)(ws + WS_WUP); bf16_t* WdownT = (bf16_t*)(ws + WS_WDOWN);
    bf16_t* WgateT = (bf16_t*)(ws + WS_WGATE); bf16_t* WpleT = (bf16_t*)(ws + WS_WPLE); bf16_t* WpoolT = (bf16_t*)(ws + WS_WPOOL);
    bf16_t* HN = (bf16_t*)(ws + WS_HN);
    bf16_t* U = (bf16_t*)(ws + AR_U); bf16_t* Qb = (bf16_t*)(ws + AR_Q); bf16_t* Kb = (bf16_t*)(ws + AR_K); bf16_t* Vb = (bf16_t*)(ws + AR_V);
    bf16_t* YP = (bf16_t*)(ws + AR_YP); bf16_t* YA = (bf16_t*)(ws + AR_YA); bf16_t* DP = (bf16_t*)(ws + AR_DP);
    bf16_t* Y = (bf16_t*)(ws + AR_Y); bf16_t* RAW1 = (bf16_t*)(ws + AR_RAW1); bf16_t* HID = (bf16_t*)(ws + AR_HID); bf16_t* Eb = (bf16_t*)(ws + AR_E);
    bf16_t* RAW2 = (bf16_t*)(ws + WS_RAW2); bf16_t* PBF = (bf16_t*)(ws + WS_PBF);

    PH(0) {
    {
        PHASE_IDS();
        LAS float* wf = (LAS float*)ldsl;
        const float* w_in = args.in[I_WIN]; const float* gpm = args.in[I_GPREMIX];
        for (int idx = tid; idx < DM * 8; idx += NTHREADS) { const int k = idx >> 3, c = idx & 7;
            const float val = w_in[(size_t)k * INW + 4096 + c] * gpm[k];
            const int l = (k & 255) >> 2, i = k & 3, j = k >> 8; wf[((j * 4 + i) * 64 + l) * 8 + c] = val; }
        __syncthreads();
        for (int m = gw; m < M; m += NGW) {
            const f32x4* xr = (const f32x4*)(x + (size_t)m * DM) + lane; f32x4 v[8]; float ss = 0.f;
#pragma unroll
            for (int j = 0; j < 8; ++j) { v[j] = xr[64 * j]; ss += (v[j].x * v[j].x + v[j].y * v[j].y) + (v[j].z * v[j].z + v[j].w * v[j].w); }
            const float rs = 1.0f / sqrtf(wave_sum(ss) * (1.f / DM) + EPS);
            float fa[8] = {0.f, 0.f, 0.f, 0.f, 0.f, 0.f, 0.f, 0.f};
#pragma unroll
            for (int j = 0; j < 8; ++j)
#pragma unroll
                for (int i = 0; i < 4; ++i) { const LAS f32x4* wp = (const LAS f32x4*)(wf + ((j * 4 + i) * 64 + lane) * 8); const f32x4 w0 = wp[0], w1 = wp[1]; const float xv = v[j][i];
                    fa[0] += xv * w0.x; fa[1] += xv * w0.y; fa[2] += xv * w0.z; fa[3] += xv * w0.w; fa[4] += xv * w1.x; fa[5] += xv * w1.y; fa[6] += xv * w1.z; fa[7] += xv * w1.w; }
#pragma unroll
            for (int c = 0; c < 8; ++c) fa[c] = wave_sum(fa[c]) * rs;
            if (lane < 8) { float fv = fa[0];
#pragma unroll
                for (int c = 1; c < 8; ++c) fv = (lane == c) ? fa[c] : fv;
                flog[((size_t)(m >> 11) * NH + lane) * SEQ + (m & (SEQ - 1))] = log_sigmoid(fv + args.in[I_BF][lane]); }
            u32x2* o8 = (u32x2*)(HN + (size_t)m * DM) + lane;
#pragma unroll
            for (int j = 0; j < 8; ++j) { const f32x4 g = *((const f32x4*)gpm + lane + 64 * j); const f32x4 h = v[j] * rs * g;
                u32x2 w; w.x = cvt_pk_bf16(h.x, h.y); w.y = cvt_pk_bf16(h.z, h.w); o8[64 * j] = w; }
        }
        __syncthreads();
        LAS float* scr = (LAS float*)(ldsl + wave * 16384);
        constexpr int IT_IN = (DM / 64) * (4096 / 32), IT_OUT = (DM / 64) * (DM / 32), IT_UP = (DM / 64) * (DFF / 32), IT_DOWN = (DFF / 64) * (DM / 32),
                      IT_GATE = IT_OUT, IT_PLE = (PLE / 64) * (DM / 32), IT_POOL1 = (256 / 64) * (256 / 32);
        constexpr int NITEMS = IT_IN + IT_OUT + IT_UP + IT_DOWN + IT_GATE + IT_PLE + 4 * IT_POOL1;
        for (int it = gw; it < NITEMS; it += NGW) {
            int r = it;
            if (r < IT_IN) { p0_transpose_item(args.in[I_WIN], DM, 4096, INW, WinT, 0, scr, r, lane); continue; } r -= IT_IN;
            if (r < IT_OUT) { p0_transpose_item(args.in[I_WOUT], DM, DM, DM, WoutT, 0, scr, r, lane); continue; } r -= IT_OUT;
            if (r < IT_UP) { p0_transpose_item(args.in[I_WUP], DM, DFF, DFF, WupT, 0, scr, r, lane); continue; } r -= IT_UP;
            if (r < IT_DOWN) { p0_transpose_item(args.in[I_WDOWN], DFF, DM, DM, WdownT, 0, scr, r, lane); continue; } r -= IT_DOWN;
            if (r < IT_GATE) { p0_transpose_item(args.in[I_WGATE], DM, DM, DM, WgateT, 0, scr, r, lane); continue; } r -= IT_GATE;
            if (r < IT_PLE) { p0_transpose_item(args.in[I_WPLE], PLE, DM, DM, WpleT, 0, scr, r, lane); continue; } r -= IT_PLE;
            { const int gi = r / IT_POOL1; p0_transpose_item(args.in[I_WPOOL] + (size_t)gi * 65536, 256, 256, 256, WpoolT, gi * 256, scr, r % IT_POOL1, lane); }
        }
        const float* p = args.in[I_P];
        for (int idx = bid * NTHREADS + tid; idx < M * PLE / 8; idx += G * NTHREADS) { const f32x4 a = *((const f32x4*)p + 2 * idx), b = *((const f32x4*)p + 2 * idx + 1);
            u32x4 w; w.x = cvt_pk_bf16(a.x, a.y); w.y = cvt_pk_bf16(a.z, a.w); w.z = cvt_pk_bf16(b.x, b.y); w.w = cvt_pk_bf16(b.z, b.w); *((u32x4*)PBF + idx) = w; }
    }
    grid.sync();
    }
    const XcdBarrier bar = xcd_barrier_post(barw, MISC + 8);

#if PROBE_PHASE == 100
    for (int i_ = 0; i_ < 16; ++i_) xcd_barrier(bar);
#endif
    PH(1) {
    {
        { PHASE_IDS();
          if (bid < NB * NH && wave == 0) {
            const f32x4* fl = (const f32x4*)(flog + (size_t)bid * SEQ + 32 * lane); f32x4 v[8]; float run = 0.f;
#pragma unroll
            for (int j = 0; j < 8; ++j) v[j] = fl[j];
#pragma unroll
            for (int j = 0; j < 8; ++j) { v[j].x += run; v[j].y += v[j].x; v[j].z += v[j].y; v[j].w += v[j].z; run = v[j].w; }
            float incl = run;
#pragma unroll
            for (int o = 1; o < 64; o <<= 1) { const float t = __shfl_up(incl, o); if (lane >= o) incl += t; }
            const float excl = incl - run;
            f32x4* fo = (f32x4*)(fb + (size_t)bid * SEQ + 32 * lane);
#pragma unroll
            for (int j = 0; j < 8; ++j) fo[j] = (v[j] + excl) * -11.313708498984761f;
          } }
        pg8::Gemm g{HN, WinT, DM, DM, DM, 0}; pg8::StaticOrder S; S.init(M, 4096, G, bid);
        pg8::EpiG<0> E{U, 1024, 1024, (size_t)(AR_Q - AR_U) / 2, nullptr, nullptr};
        pg8::gemm_phase(ldsl, g, S, E);
    }
    xcd_barrier(bar);
    }

    PH(3) {
    {
        const int xcd = bid & 7, ix = bid >> 3;
        const int bh = (xcd * 4 + (ix >> 3)) & 31, qb = ix & 7, b = bh >> 3, h = bh & 7;
        if (bid < 256) {
            att::BlockRef cur;
            const size_t rowb = (size_t)b * SEQ;
            cur.Q = Qb + (rowb + (size_t)qb * 256) * 1024 + h * HD; cur.K = Kb + rowb * 1024 + h * HD; cur.V = Vb + rowb * 1024 + h * HD;
            cur.FB = fb + (size_t)bh * SEQ; cur.O = YA + (rowb + (size_t)qb * 256) * 1024 + h * HD; cur.P0 = qb * 256;
            att::Seam S;
            att::prime(cur, (char*)lds, S);
            att::block(cur, cur, (char*)lds, S);
            asm volatile("s_waitcnt vmcnt(0)" ::: "memory");
            __syncthreads();
        }
        {
            pg8::SingleUnit S; const int id = bh * 4 + qb; S.valid = (bid < 256 && qb < 4) ? 1 : 0; S.pm = id >> 2; S.pn = id & 3;
            if (S.valid) {
                const int tid = fresh_tid(), cc = tid & 31, tg = tid >> 5, gi = S.pn, w = 2 << gi;
                const int t0 = S.pm * 256 + tg * 16, pos0 = t0 & (SEQ - 1), col = gi * 256 + cc * 8;
                const bf16_t* up = U + (size_t)t0 * POOLW + col; bf16_t* dp = DP + (size_t)t0 * POOLW + col;
                float sm[8] = {0.f, 0.f, 0.f, 0.f, 0.f, 0.f, 0.f, 0.f};
                for (int j = 1; j < w; ++j) if (pos0 - j >= 0) { const u32x4 v = *(const u32x4*)(up - (size_t)j * POOLW);
                    sm[0] += bf_lo(v.x); sm[1] += bf_hi(v.x); sm[2] += bf_lo(v.y); sm[3] += bf_hi(v.y); sm[4] += bf_lo(v.z); sm[5] += bf_hi(v.z); sm[6] += bf_lo(v.w); sm[7] += bf_hi(v.w); }
                for (int i = 0; i < 16; ++i) { const int pos = pos0 + i; const u32x4 v = *(const u32x4*)(up + (size_t)i * POOLW);
                    const float f[8] = {bf_lo(v.x), bf_hi(v.x), bf_lo(v.y), bf_hi(v.y), bf_lo(v.z), bf_hi(v.z), bf_lo(v.w), bf_hi(v.w)};
                    const float inv = 1.0f / (float)((pos + 1 < w) ? pos + 1 : w);
                    float d[8];
#pragma unroll
                    for (int e = 0; e < 8; ++e) { sm[e] += f[e]; d[e] = sm[e] * inv - f[e]; }
                    u32x4 o; o.x = cvt_pk_bf16(d[0], d[1]); o.y = cvt_pk_bf16(d[2], d[3]); o.z = cvt_pk_bf16(d[4], d[5]); o.w = cvt_pk_bf16(d[6], d[7]);
                    *(u32x4*)(dp + (size_t)i * POOLW) = o;
                    if (pos - w + 1 >= 0) { const u32x4 q = *(const u32x4*)(up + (size_t)(i - w + 1) * POOLW);
                        sm[0] -= bf_lo(q.x); sm[1] -= bf_hi(q.x); sm[2] -= bf_lo(q.y); sm[3] -= bf_hi(q.y); sm[4] -= bf_lo(q.z); sm[5] -= bf_hi(q.z); sm[6] -= bf_lo(q.w); sm[7] -= bf_hi(q.w); } }
                asm volatile("s_waitcnt vmcnt(0)" ::: "memory");
                __syncthreads();
            }
            pg8::Gemm g{DP, WpoolT, POOLW, 256, 256, 256};
            pg8::EpiG<4> E{YP, POOLW, 0, 0, args.in[I_POOLSCALE], nullptr};
            pg8::gemm_phase(ldsl, g, S, E);
        }
    }
    xcd_barrier(bar);
    }

    PH(4) {
    { PHASE_IDS();
    for (int m = gw; m < M; m += NGW) {
        row_norm1024(YP + (size_t)m * POOLW, args.in[I_GPOOLOUT], Y + (size_t)m * DM, lane);
        row_norm1024(YA + (size_t)m * ATTW, args.in[I_GATTNOUT], Y + (size_t)m * DM + POOLW, lane);
    } }
    xcd_barrier(bar);
    }

    PH(5) {
    {
        pg8::Gemm g{Y, WoutT, DM, DM, DM, 0}; pg8::StaticOrder S; S.init(M, DM, G, bid);
        pg8::EpiG<0> E{RAW1, DM, 0, 0, nullptr, nullptr};
        pg8::gemm_phase(ldsl, g, S, E);
    }
    xcd_barrier(bar);
    }

    PH(6) {
    { PHASE_IDS();
    for (int m = gw; m < M; m += NGW)
        row_resnorm(x + (size_t)m * DM, RAW1 + (size_t)m * DM, args.in[I_GPOSTMIX], out + (size_t)m * DM, args.in[I_GPREMLP], HN + (size_t)m * DM, lane); }
    xcd_barrier(bar);
    }

    PH(7) {
    {
        pg8::Gemm g{HN, WupT, DM, DM, DM, 0}; pg8::StaticOrder S; S.init(M, DFF, G, bid);
        pg8::EpiG<2> E{HID, DFF, 0, 0, nullptr, nullptr};
        pg8::gemm_phase(ldsl, g, S, E);
    }
    xcd_barrier(bar);
    }

    PH(8) {
    {
        pg8::Gemm g{HID, WdownT, DFF, DFF, DFF, 0}; pg8::StaticOrder S; S.init(M, DM, G, bid);
        pg8::EpiG<0> E{RAW2, DM, 0, 0, nullptr, nullptr};
        pg8::gemm_phase(ldsl, g, S, E);
    }
    xcd_barrier(bar);
    }

    PH(9) {
    { PHASE_IDS();
    for (int m = gw; m < M; m += NGW)
        row_resnorm(out + (size_t)m * DM, RAW2 + (size_t)m * DM, args.in[I_GPOSTMLP], out + (size_t)m * DM, args.in[I_GPLEGATE], HN + (size_t)m * DM, lane); }
    xcd_barrier(bar);
    }

    PH(10) {
    {
        pg8::StaticOrder S; S.init(M, DM, G, bid);
        { pg8::Gemm g{PBF, WpleT, PLE, PLE, PLE, 0}; pg8::EpiG<0> E{Eb, DM, 0, 0, nullptr, nullptr}; pg8::gemm_phase(ldsl, g, S, E); }
        asm volatile("s_waitcnt vmcnt(0)" ::: "memory");
        __syncthreads();
        { pg8::Gemm g{HN, WgateT, DM, DM, DM, 0}; pg8::EpiG<3> E{RAW2, DM, 0, 0, nullptr, Eb}; pg8::gemm_phase(ldsl, g, S, E); }
    }
    xcd_barrier(bar);
    }

    PH(11) {
    { PHASE_IDS();
    for (int m = gw; m < M; m += NGW)
        row_resnorm(out + (size_t)m * DM, RAW2 + (size_t)m * DM, args.in[I_GPOSTPLE], out + (size_t)m * DM, nullptr, nullptr, lane); }
    }
}

extern "C" void kernel_launch(void* const* d_in, const int* in_sizes, int n_in, void* d_out, int out_size, void* d_ws, size_t ws_size, hipStream_t stream) {
    static int grid = 0;
    if (grid == 0) {
        if (n_in != 19 || in_sizes[0] != M * DM || out_size != M * DM || ws_size < WS_END) {
            fprintf(stderr, "kernel_launch: unexpected shapes (n_in %d in0 %d out %d ws %zu)\n", n_in, n_in > 0 ? in_sizes[0] : -1, out_size, ws_size); grid = -1; return; }
        int dev = 0, cus = 0, per_cu = 0;
        hipGetDevice(&dev); hipDeviceGetAttribute(&cus, hipDeviceAttributeMultiprocessorCount, dev);
        if (hipFuncSetAttribute((const void*)mega_fwd, hipFuncAttributeMaxDynamicSharedMemorySize, LDS_BYTES) != hipSuccess) { fprintf(stderr, "kernel_launch: hipFuncSetAttribute failed\n"); grid = -1; return; }
        if (hipOccupancyMaxActiveBlocksPerMultiprocessor(&per_cu, (const void*)mega_fwd, NTHREADS, LDS_BYTES) != hipSuccess || per_cu < 1) {
            fprintf(stderr, "kernel_launch: occupancy query says %d\n", per_cu); per_cu = 1; }
        (void)hipGetLastError();
        grid = cus * 1;
        if (grid != 256) fprintf(stderr, "kernel_launch: grid %d (expected 256)\n", grid);
    }
    if (grid < 0) return;
    Args a{};
    for (int i = 0; i < 19; ++i) a.in[i] = (const float*)d_in[i];
    a.out = (float*)d_out; a.ws = (unsigned char*)d_ws;
    void* kargs[] = {&a};
    hipError_t e = hipLaunchCooperativeKernel((const void*)mega_fwd, dim3(grid), dim3(NTHREADS), kargs, LDS_BYTES, stream);
    if (e != hipSuccess) fprintf(stderr, "kernel_launch: cooperative launch failed: %s (grid %d)\n", hipGetErrorString(e), grid);
}
```

```cpp
#include <hip/hip_runtime.h>
#include <hip/hip_bf16.h>
#include <hip/hip_cooperative_groups.h>
#include <cstdio>
#include <cstdint>
namespace cg = cooperative_groups;

#define LAS __attribute__((address_space(3)))
typedef unsigned short bf16_t;
typedef short bf16x8 __attribute__((ext_vector_type(8)));
typedef short s16x4 __attribute__((ext_vector_type(4)));
typedef float f32x4 __attribute__((ext_vector_type(4)));
typedef float f32x2 __attribute__((ext_vector_type(2)));
typedef float f32x16 __attribute__((ext_vector_type(16)));
typedef unsigned u32x4 __attribute__((ext_vector_type(4)));
typedef unsigned u32x2 __attribute__((ext_vector_type(2)));

constexpr int DM = 2048, SEQ = 2048, NB = 4, M = NB * SEQ, POOLW = 1024, ATTW = 1024, NH = 8, HD = 128, DFF = 8192, PLE = 256, INW = 4104;
constexpr float EPS = 1e-6f;

constexpr size_t MiB = 1u << 20;
constexpr size_t WS_FLOG = 1 * MiB;
constexpr size_t WS_FB = 1 * MiB + 512 * 1024;
constexpr size_t WS_WIN = 2 * MiB, WS_WOUT = 18 * MiB, WS_WUP = 26 * MiB, WS_WDOWN = 58 * MiB, WS_WGATE = 90 * MiB, WS_WPLE = 98 * MiB, WS_WPOOL = 99 * MiB;
constexpr size_t WS_HN = 100 * MiB;
constexpr size_t WS_ARENA = 132 * MiB;
constexpr size_t AR_U = WS_ARENA, AR_Q = WS_ARENA + 16 * MiB, AR_K = WS_ARENA + 32 * MiB, AR_V = WS_ARENA + 48 * MiB;
constexpr size_t AR_YP = WS_ARENA + 64 * MiB, AR_YA = WS_ARENA + 80 * MiB, AR_DP = WS_ARENA + 96 * MiB;
constexpr size_t AR_Y = WS_ARENA;
constexpr size_t AR_RAW1 = WS_ARENA + 32 * MiB;
constexpr size_t AR_HID = WS_ARENA;
constexpr size_t AR_E = WS_ARENA;
constexpr size_t WS_RAW2 = WS_WUP;
constexpr size_t WS_PBF = 260 * MiB;
constexpr size_t WS_END = 264 * MiB;

__device__ __forceinline__ unsigned cvt_pk_bf16(float lo, float hi) { unsigned r; asm volatile("v_cvt_pk_bf16_f32 %0, %1, %2" : "=v"(r) : "v"(lo), "v"(hi)); return r; }
__device__ __forceinline__ int fresh_tid() { int t = threadIdx.x; asm volatile("" : "+v"(t)); return t; }
__device__ __forceinline__ float bf_lo(unsigned w) { return __uint_as_float(w << 16); }
__device__ __forceinline__ float bf_hi(unsigned w) { return __uint_as_float(w & 0xffff0000u); }
__device__ __forceinline__ float wave_sum(float v) {
#pragma unroll
    for (int o = 1; o < 64; o <<= 1) v += __shfl_xor(v, o);
    return v;
}

namespace pg8 {
constexpr int BM = 256, BK = 64, HALF = 128, HTB = HALF * BK * 2, STAGE_BYTES = 8 * HTB, NXCD = 8, WGM = 8;
__host__ __device__ __forceinline__ int lds_byte(int r, int c) { const int st = (r >> 4) * 2 + (c >> 5), rr = r & 15, cc = c & 31, ob = rr * 64 + cc * 2; return st * 1024 + (ob ^ (((ob >> 9) & 1) << 5)); }
__host__ __device__ __forceinline__ void stage_rc(int b, int& R, int& C) { const int st = b / 1024, sb = b % 1024, swz = sb ^ (((sb >> 9) & 1) << 5); R = (st >> 1) * 16 + swz / 64; C = (st & 1) * 32 + (swz % 64) / 2; }
__host__ __device__ __forceinline__ int perm32(int rho) { const int n = rho >> 4, i = rho & 15; return 8 * (i >> 2) + 4 * n + (i & 3); }

struct Unit { int pm, pn; };
struct Gemm { const bf16_t* A; const bf16_t* Bt; int lda, ldb, K, a_pn_koff; };

struct StaticOrder {
    int nM, nN, nwg, G, c;
    __device__ void init(int M_, int N_, int G_, int c_) { nM = M_ / BM; nN = N_ / BM; nwg = nM * nN; G = G_; c = c_; }
    __device__ bool next(int i, Unit& u) const {
        const long L = (long)i * G + c; if (L >= nwg) return false;
        int wgid = (int)L; { const int q = nwg / NXCD, r = nwg % NXCD, xcd = wgid % NXCD, off = wgid / NXCD; wgid = (xcd < r ? xcd * (q + 1) : r * (q + 1) + (xcd - r) * q) + off; }
        const int nig = WGM * nN, gid = wgid / nig, fm = gid * WGM, gsz = (nM - fm) < WGM ? (nM - fm) : WGM;
        u.pm = fm + ((wgid % nig) % gsz); u.pn = (wgid % nig) / gsz; return true;
    }
};
struct SingleUnit {
    int pm, pn, valid;
    __device__ bool next(int i, Unit& u) const { if (i != 0 || !valid) return false; u.pm = pm; u.pn = pn; return true; }
};

template <int ACT> struct EpiG {
    static constexpr bool PERM = true;
    bf16_t* O; int ldc; int split_cols; size_t split_stride; const float* colscale; const bf16_t* aux;
    __device__ __forceinline__ void operator()(const f32x4 (&acc)[2][2][4][2], const Unit& u, int wr, int wc, int fr, int fq) const {
        const int row0 = u.pm * BM + wr * 64 + fr; int colt = u.pn * BM; bf16_t* base = O;
        if (split_cols) { const int t = colt / split_cols; base += (size_t)t * split_stride; colt -= t * split_cols; }
        const int col0 = colt + wc * 32 + 8 * fq, gcol0 = u.pn * BM + wc * 32 + 8 * fq;
        f32x4 cs[2][2];
        if (ACT == 4) {
#pragma unroll
            for (int bj = 0; bj < 2; ++bj)
#pragma unroll
                for (int n = 0; n < 2; ++n) cs[bj][n] = *(const f32x4*)(colscale + gcol0 + bj * HALF + 4 * n);
        }
#pragma unroll
        for (int ai = 0; ai < 2; ++ai)
#pragma unroll
            for (int m = 0; m < 4; ++m) { const size_t roff = (size_t)(row0 + ai * HALF + m * 16) * ldc + col0;
#pragma unroll
                for (int bj = 0; bj < 2; ++bj) { f32x4 v0 = acc[ai][bj][m][0], v1 = acc[ai][bj][m][1];
                    if (ACT == 2) {
#pragma unroll
                        for (int e = 0; e < 4; ++e) { float a = fmaxf(v0[e], 0.f), b = fmaxf(v1[e], 0.f); v0[e] = a * a; v1[e] = b * b; }
                    }
                    if (ACT == 3) { const u32x4 ev = *(const u32x4*)(aux + roff + bj * HALF);
                        const float e0[4] = {bf_lo(ev.x), bf_hi(ev.x), bf_lo(ev.y), bf_hi(ev.y)}, e1[4] = {bf_lo(ev.z), bf_hi(ev.z), bf_lo(ev.w), bf_hi(ev.w)};
#pragma unroll
                        for (int e = 0; e < 4; ++e) { v0[e] = __builtin_amdgcn_rcpf(1.f + __builtin_amdgcn_exp2f(-1.4426950408889634f * v0[e])) * e0[e];
                                                      v1[e] = __builtin_amdgcn_rcpf(1.f + __builtin_amdgcn_exp2f(-1.4426950408889634f * v1[e])) * e1[e]; }
                    }
                    if (ACT == 4) { v0 = v0 * cs[bj][0]; v1 = v1 * cs[bj][1]; }
                    u32x4 w; w.x = cvt_pk_bf16(v0[0], v0[1]); w.y = cvt_pk_bf16(v0[2], v0[3]); w.z = cvt_pk_bf16(v1[0], v1[1]); w.w = cvt_pk_bf16(v1[2], v1[3]);
                    *(u32x4*)(base + roff + bj * HALF) = w; } }
    }
};

template <class Epi, class Sched>
__device__ __forceinline__ void gemm_phase(LAS unsigned char* lds, const Gemm g, const Sched& S, const Epi& E) {
    constexpr bool ALIGN_EPI = true;
    const int tid = fresh_tid(), wid = __builtin_amdgcn_readfirstlane(tid >> 6), lane = tid & 63, wr = wid >> 2, wc = wid & 3, fr = lane & 15, fq = lane >> 4;
    const int K = g.K, nt = K / BK;
    unsigned voffA[2], voffB[2];
#pragma unroll
    for (int i = 0; i < 2; ++i) { int R, C; stage_rc(tid * 16 + i * 8192, R, C); const int Rb = Epi::PERM ? ((R & ~31) + perm32(R & 31)) : R;
        voffA[i] = (unsigned)(R * g.lda + C) * 2u; voffB[i] = (unsigned)(Rb * g.ldb + C) * 2u; }
    const size_t kstep = (size_t)(BK * 2);
    const size_t hstepA = (size_t)HALF * g.lda * 2, hstepB = (size_t)HALF * g.ldb * 2;
    const size_t tstepA = 2 * hstepA, tstepB = 2 * hstepB;
    const unsigned ldsw = (unsigned)wid * 1024u;
    const int aoff = lds_byte(wr * 64 + fr, fq * 8), boff = lds_byte(wc * 32 + fr, fq * 8);
#define PG8_SA(b, h) (((b) * 2 + (h)) * HTB)
#define PG8_SB(b, h) ((4 + (b) * 2 + (h)) * HTB)
#define PG8_STAGE(bufoff, gbase, voff) do { _Pragma("unroll") for (int _i = 0; _i < 2; ++_i) \
        __builtin_amdgcn_global_load_lds((const unsigned*)((const char*)(gbase) + (voff)[_i]), (LAS unsigned*)(lds + (bufoff) + ldsw + _i * 8192), 16, 0, 0); } while (0)
#define PG8_LDA(dst, b, h) do { _Pragma("unroll") for (int m = 0; m < 4; ++m) _Pragma("unroll") for (int k = 0; k < 2; ++k) dst[m][k] = *(const LAS bf16x8*)(lds + PG8_SA(b, h) + aoff + m * 2048 + k * 1024); } while (0)
#define PG8_LDB(dst, b, h) do { _Pragma("unroll") for (int n = 0; n < 2; ++n) _Pragma("unroll") for (int k = 0; k < 2; ++k) dst[n][k] = *(const LAS bf16x8*)(lds + PG8_SB(b, h) + boff + n * 2048 + k * 1024); } while (0)
#define PG8_MMA(ai, bj, At, Bt) do { __builtin_amdgcn_s_setprio(1); _Pragma("unroll") for (int m = 0; m < 4; ++m) _Pragma("unroll") for (int n = 0; n < 2; ++n) _Pragma("unroll") for (int k = 0; k < 2; ++k) \
        acc[ai][bj][m][n] = __builtin_amdgcn_mfma_f32_16x16x32_bf16(Bt[n][k], At[m][k], acc[ai][bj][m][n], 0, 0, 0); __builtin_amdgcn_s_setprio(0); } while (0)
#define PG8_WAIT_V(n) asm volatile("s_waitcnt vmcnt(" #n ")" ::: "memory")
#define PG8_WAIT_L(n) asm volatile("s_waitcnt lgkmcnt(" #n ")" ::: "memory")
#define PG8_BAR __builtin_amdgcn_s_barrier()
#define PG8_SCHED __builtin_amdgcn_sched_barrier(0)
    Unit cur, nxt; int ui = 0;
    if (!S.next(0, cur)) return;
    f32x4 acc[2][2][4][2];
#pragma unroll
    for (int a = 0; a < 2; ++a)
#pragma unroll
        for (int b = 0; b < 2; ++b)
#pragma unroll
            for (int m = 0; m < 4; ++m)
#pragma unroll
                for (int n = 0; n < 2; ++n) acc[a][b][m][n] = (f32x4){0.f, 0.f, 0.f, 0.f};
    bf16x8 At[4][2], B0[2][2], B1[2][2];
    const char* cA = (const char*)g.A + (size_t)cur.pm * tstepA + (size_t)cur.pn * g.a_pn_koff * 2; const char* cB = (const char*)g.Bt + (size_t)cur.pn * tstepB;
    PG8_STAGE(PG8_SB(0, 0), cB, voffB); PG8_STAGE(PG8_SB(0, 1), cB + hstepB, voffB); PG8_STAGE(PG8_SA(0, 0), cA, voffA); PG8_STAGE(PG8_SA(0, 1), cA + hstepA, voffA);
    if (wr == 1) PG8_BAR;
    PG8_WAIT_V(2); PG8_BAR;
    PG8_STAGE(PG8_SB(1, 0), cB + kstep, voffB); PG8_STAGE(PG8_SA(1, 0), cA + kstep, voffA); PG8_STAGE(PG8_SB(1, 1), cB + hstepB + kstep, voffB);
    PG8_WAIT_V(6); PG8_BAR;
    for (;;) {
        const bool has_next = S.next(ui + 1, nxt);
        const char* nA = has_next ? (const char*)g.A + (size_t)nxt.pm * tstepA + (size_t)nxt.pn * g.a_pn_koff * 2 : cA; const char* nB = has_next ? (const char*)g.Bt + (size_t)nxt.pn * tstepB : cB;
        asm volatile("" : "+s"(nA), "+s"(nB));
        for (int t = 0; t < nt; t += 2) {
            const bool last = (t == nt - 2);
            const char* a1 = cA + (size_t)(t + 1) * kstep;
            const char* a2 = last ? nA : cA + (size_t)(t + 2) * kstep; const char* b2 = last ? nB : cB + (size_t)(t + 2) * kstep;
            const char* a3 = a2 + kstep; const char* b3 = b2 + kstep;
            PG8_LDB(B0, 0, 0); PG8_LDB(B1, 0, 1); PG8_SCHED; PG8_LDA(At, 0, 0); PG8_STAGE(PG8_SA(1, 1), a1 + hstepA, voffA);
            PG8_WAIT_V(8); PG8_WAIT_L(0); PG8_BAR; PG8_MMA(0, 0, At, B0); PG8_MMA(0, 1, At, B1); PG8_BAR; PG8_SCHED;
            PG8_LDA(At, 0, 1); PG8_STAGE(PG8_SB(0, 0), b2, voffB); PG8_STAGE(PG8_SB(0, 1), b2 + hstepB, voffB); PG8_STAGE(PG8_SA(0, 0), a2, voffA);
            PG8_WAIT_V(8); PG8_WAIT_L(0); PG8_BAR; PG8_MMA(1, 0, At, B0); PG8_MMA(1, 1, At, B1); PG8_BAR; PG8_SCHED;
            PG8_LDB(B0, 1, 0); PG8_LDB(B1, 1, 1); PG8_SCHED; PG8_LDA(At, 1, 0); PG8_STAGE(PG8_SA(0, 1), a2 + hstepA, voffA);
            PG8_WAIT_V(8); PG8_WAIT_L(0); PG8_BAR; PG8_MMA(0, 0, At, B0); PG8_MMA(0, 1, At, B1); PG8_BAR; PG8_SCHED;
            PG8_LDA(At, 1, 1); PG8_STAGE(PG8_SB(1, 0), b3, voffB); PG8_STAGE(PG8_SB(1, 1), b3 + hstepB, voffB); PG8_STAGE(PG8_SA(1, 0), a3, voffA);
            PG8_WAIT_V(8); PG8_WAIT_L(0); PG8_BAR; PG8_MMA(1, 0, At, B0); PG8_MMA(1, 1, At, B1); PG8_BAR; PG8_SCHED;
        }
        if constexpr (ALIGN_EPI) { if (wr == 0) PG8_BAR; }
        E(acc, cur, wr, wc, fr, fq);
        if (!has_next) break;
#pragma unroll
        for (int a = 0; a < 2; ++a)
#pragma unroll
            for (int b = 0; b < 2; ++b)
#pragma unroll
                for (int m = 0; m < 4; ++m)
#pragma unroll
                    for (int n = 0; n < 2; ++n) acc[a][b][m][n] = (f32x4){0.f, 0.f, 0.f, 0.f};
        cur = nxt; cA = nA; cB = nB; ++ui;
        if constexpr (ALIGN_EPI) { if (wr == 1) PG8_BAR; }
    }
    PG8_WAIT_V(0);
    if constexpr (!ALIGN_EPI) { if (wr == 0) PG8_BAR; }
    PG8_BAR;
#undef PG8_SA
#undef PG8_SB
#undef PG8_STAGE
#undef PG8_LDA
#undef PG8_LDB
#undef PG8_MMA
#undef PG8_WAIT_V
#undef PG8_WAIT_L
#undef PG8_BAR
#undef PG8_SCHED
}
}

namespace att {
constexpr int D = 128, LD = 1024;
constexpr float SCALE = 0.08838834764831845f;
constexpr float THR = 8.f;
constexpr int NW = 8, QBLK = 32, KVBLK = 64, QB = NW * QBLK;
constexpr int SHM_V = KVBLK * D * 2, SHM_K = KVBLK * D * 2;
constexpr int OFF_WS = 2 * SHM_V + 2 * SHM_K, OFF_BIAS = OFF_WS + NW * 64 * 4, LDS_BYTES = OFF_BIAS + 512;
typedef bf16_t bf16;
#define KSWZ(row, colB) ((row) * 256 + ((colB) ^ (((row) & 7) << 4)))
#define SBAR() __builtin_amdgcn_sched_barrier(0)
__device__ __forceinline__ int v_st(int k, int c) { const int kk = (k & ~0xC) | ((k & 4) << 1) | ((k & 8) >> 1); return ((kk >> 3) * 4 + (c >> 5)) * 512 + ((kk & 7) * 32 + (c & 31)) * 2; }
__device__ __forceinline__ int v_rd_base(int lane) { return ((lane & 3) << 3) | (((lane >> 2) & 3) << 6) | (((lane >> 4) & 1) << 5) | (((lane >> 5) & 1) << 8); }
constexpr int v_rd_off(int d0, int ks, int half) { return d0 * 512 + ks * 4096 + half * 2048; }
__device__ __forceinline__ int crow(int r, int hi) { return (r & 3) + 8 * (r >> 2) + 4 * hi; }
__device__ __forceinline__ unsigned cvtpk(float lo, float hi) { unsigned r; asm volatile("v_cvt_pk_bf16_f32 %0, %1, %2" : "=v"(r) : "v"(lo), "v"(hi)); return r; }
__device__ __forceinline__ bf16x8 load8(const bf16* p) { return *reinterpret_cast<const bf16x8*>(p); }
__device__ __forceinline__ void mask_tile(f32x16& p0, f32x16& p1, int dq, unsigned W) {
    const float NEG = -__builtin_inff();
#pragma unroll
    for (int r = 0; r < 16; ++r) {
        const int c = (r & 3) + 8 * (r >> 2);
        if ((unsigned)(dq - c) >= W) p0[r] = NEG;
        if ((unsigned)(dq - c - 32) >= W) p1[r] = NEG;
    }
}
__device__ __forceinline__ void partialSM(f32x16& p0, f32x16& p1, float& m_reg, float& mn, float& alpha) {
    float pmax = p0[0]; for (int r = 1; r < 16; ++r) pmax = fmaxf(pmax, p0[r]); for (int r = 0; r < 16; ++r) pmax = fmaxf(pmax, p1[r]);
    { auto rr = __builtin_amdgcn_permlane32_swap(__float_as_uint(pmax), __float_as_uint(pmax), false, false);
      pmax = fmaxf(__uint_as_float(rr[0]), __uint_as_float(rr[1])); }
    constexpr float C2 = 1.4426950408889634f * SCALE;
    if (__builtin_expect(__all((pmax - m_reg) * SCALE <= THR), 1)) { mn = m_reg; alpha = 1.f; }
    else { mn = fmaxf(m_reg, pmax); alpha = __builtin_amdgcn_exp2f((m_reg - mn) * C2); m_reg = mn; }
    const float mnL = -mn * C2;
    for (int r = 0; r < 16; ++r) p0[r] = fmaf(p0[r], C2, mnL); for (int r = 0; r < 16; ++r) p1[r] = fmaf(p1[r], C2, mnL);
    for (int r = 0; r < 16; ++r) p0[r] = __builtin_amdgcn_exp2f(p0[r]);
}
__device__ __forceinline__ void finishSM(f32x16& p0, f32x16& p1, float alpha, float& l_reg, bf16x8& pa0, bf16x8& pa1, bf16x8& pa2, bf16x8& pa3) {
    for (int r = 0; r < 16; ++r) p1[r] = __builtin_amdgcn_exp2f(p1[r]);
    float ps = 0; for (int r = 0; r < 16; ++r) ps += p0[r]; for (int r = 0; r < 16; ++r) ps += p1[r];
    { auto rr = __builtin_amdgcn_permlane32_swap(__float_as_uint(ps), __float_as_uint(ps), false, false);
      ps = __uint_as_float(rr[0]) + __uint_as_float(rr[1]); }
    l_reg = l_reg * alpha + ps;
#define PK4(P, B_, OUT) do { unsigned a0 = cvtpk(P[B_+0], P[B_+1]), a1 = cvtpk(P[B_+2], P[B_+3]);                          \
        unsigned b0 = cvtpk(P[B_+4], P[B_+5]), b1 = cvtpk(P[B_+6], P[B_+7]);                                             \
        auto r0 = __builtin_amdgcn_permlane32_swap(a0, b0, false, false); auto r1 = __builtin_amdgcn_permlane32_swap(a1, b1, false, false); \
        u32x4 w = {r0[0], r1[0], r0[1], r1[1]}; OUT = *reinterpret_cast<bf16x8*>(&w); } while (0)
    PK4(p0, 0, pa0); PK4(p0, 8, pa1); PK4(p1, 0, pa2); PK4(p1, 8, pa3);
#undef PK4
}
template <int KB>
__device__ __forceinline__ void qkt(f32x16& p0, f32x16& p1, const char* K_lds, const char* B_lds, int r32, int hi, const bf16x8* qr) {
    const f32x4* bp = (const f32x4*)(B_lds + KB * 256 + hi * 16);
#pragma unroll
    for (int i = 0; i < 4; ++i) { const f32x4 a = bp[2 * i], b = bp[8 + 2 * i];
        p0[4 * i] = a[0]; p0[4 * i + 1] = a[1]; p0[4 * i + 2] = a[2]; p0[4 * i + 3] = a[3];
        p1[4 * i] = b[0]; p1[4 * i + 1] = b[1]; p1[4 * i + 2] = b[2]; p1[4 * i + 3] = b[3]; }
    const char* kb[4];
#pragma unroll
    for (int dd = 0; dd < 4; ++dd) kb[dd] = K_lds + KB * SHM_K + KSWZ(r32, (dd * 16 + hi * 8) * 2);
#pragma unroll
    for (int d0 = 0; d0 < 8; ++d0) { const char* a = kb[d0 & 3] + (d0 >> 2) * 128;
        bf16x8 b0 = *reinterpret_cast<const bf16x8*>(a);
        bf16x8 b1 = *reinterpret_cast<const bf16x8*>(a + 32 * 256);
        p0 = __builtin_amdgcn_mfma_f32_32x32x16_bf16(b0, qr[d0], p0, 0, 0, 0);
        p1 = __builtin_amdgcn_mfma_f32_32x32x16_bf16(b1, qr[d0], p1, 0, 0, 0); }
}
template <int VB>
__device__ __forceinline__ void pv_tile(f32x16* o, int vb0, bf16x8 pa0, bf16x8 pa1, bf16x8 pa2, bf16x8 pa3) {
#define TRRD(dst, off) asm volatile("ds_read_b64_tr_b16 %0, %1 offset:%2" : "=&v"(dst) : "v"(vb0), "i"(off) : "memory")
#define PV_D0(d0) do { s16x4 l0, l1, l2, l3, h0, h1, h2, h3; constexpr int b_ = VB * SHM_V + v_rd_off(d0, 0, 0); \
        TRRD(l0, b_); TRRD(h0, b_ + 2048); TRRD(l1, b_ + 4096); TRRD(h1, b_ + 6144); TRRD(l2, b_ + 8192); TRRD(h2, b_ + 10240); TRRD(l3, b_ + 12288); TRRD(h3, b_ + 14336); \
        asm volatile("s_waitcnt lgkmcnt(0)" ::: "memory"); SBAR();   \
        o[d0] = __builtin_amdgcn_mfma_f32_32x32x16_bf16(pa0, (bf16x8){l0[0], l0[1], l0[2], l0[3], h0[0], h0[1], h0[2], h0[3]}, o[d0], 0, 0, 0);   \
        o[d0] = __builtin_amdgcn_mfma_f32_32x32x16_bf16(pa1, (bf16x8){l1[0], l1[1], l1[2], l1[3], h1[0], h1[1], h1[2], h1[3]}, o[d0], 0, 0, 0);   \
        o[d0] = __builtin_amdgcn_mfma_f32_32x32x16_bf16(pa2, (bf16x8){l2[0], l2[1], l2[2], l2[3], h2[0], h2[1], h2[2], h2[3]}, o[d0], 0, 0, 0);   \
        o[d0] = __builtin_amdgcn_mfma_f32_32x32x16_bf16(pa3, (bf16x8){l3[0], l3[1], l3[2], l3[3], h3[0], h3[1], h3[2], h3[3]}, o[d0], 0, 0, 0); } while (0)
    PV_D0(0); PV_D0(1); PV_D0(2); PV_D0(3);
#undef PV_D0
#undef TRRD
}
struct BlockRef { const bf16* Q; const bf16* K; const bf16* V; const float* FB; bf16* O; int P0; };
struct Seam { bf16x8 qr[8]; bf16x8 st_v0, st_v1, st_k0, st_k1; float st_b; };
#define ROW(p, k0, rr) ((p) + (size_t)((k0) + (rr)) * LD + sc)
#define VMW() asm volatile("s_waitcnt vmcnt(0)" ::: "memory")
#define VMWN(n) asm volatile("s_waitcnt vmcnt(%0)" :: "i"(n) : "memory")
#define SLOAD_H(Kp, Vp, Fp, k0) do { S.st_v0 = load8(ROW(Vp, k0, sr)); S.st_v1 = load8(ROW(Vp, k0, 32 + sr));              \
                         S.st_k0 = load8(ROW(Kp, k0, sr)); S.st_k1 = load8(ROW(Kp, k0, 32 + sr)); S.st_b = (Fp)[(k0) + (tid & 63)]; } while (0)
#define SWRITE_HK(bf) do { *(bf16x8*)(K_lds + (bf) * SHM_K + kws) = S.st_k0; *(bf16x8*)(K_lds + (bf) * SHM_K + kws + 32 * 256) = S.st_k1; \
                           if (tid < 64) ((float*)B_lds)[(bf) * 64 + tid] = S.st_b; } while (0)
#define SWRITE_HV(bf) do { *(bf16x8*)(V_lds + (bf) * SHM_V + vst0) = S.st_v0; *(bf16x8*)(V_lds + (bf) * SHM_V + vst1) = S.st_v1; } while (0)
#define SWRITE_H(bf) do { SWRITE_HV(bf); SWRITE_HK(bf); } while (0)
__device__ __forceinline__ void prime(const BlockRef& cur, char* lds, Seam& S) {
    const int tid = fresh_tid(), wid = __builtin_amdgcn_readfirstlane(tid >> 6), lane = tid & 63, r32 = lane & 31, hi = lane >> 5;
    const int sr = tid >> 4, sc = (tid & 15) * 8, kws = KSWZ(sr, sc * 2); char* K_lds = lds + 2 * SHM_V; char* B_lds = lds + OFF_BIAS;
    for (int d0 = 0; d0 < 8; ++d0) S.qr[d0] = load8(cur.Q + (size_t)(wid * QBLK + r32) * LD + d0 * 16 + hi * 8);
    SLOAD_H(cur.K, cur.V, cur.FB, 0); VMW(); SWRITE_HK(0);
    __syncthreads();
}
__device__ __forceinline__ void block(const BlockRef& cur, const BlockRef& nxt, char* lds, Seam& S) {
    const int tid = fresh_tid(), wid = __builtin_amdgcn_readfirstlane(tid >> 6), lane = tid & 63, r32 = lane & 31, hi = lane >> 5;
    constexpr unsigned W = 1u << 30;
    const int NT = (cur.P0 + QB - 1) / KVBLK + 1;
    const int qlo = cur.P0 + wid * QBLK, qm = qlo + r32 - 4 * hi;
    char* V_lds = lds; char* K_lds = lds + 2 * SHM_V; char* B_lds = lds + OFF_BIAS;
    float* ws = (float*)(lds + OFF_WS) + wid * 64; float* li_l = ws, * al_l = ws + 32;
    float m_reg = -1e30f, l_reg = 0; f32x16 o[4] = {};
    const int sr = tid >> 4, sc = (tid & 15) * 8, vst0 = v_st(sr, sc), vst1 = v_st(32 + sr, sc), kws = KSWZ(sr, sc * 2);
    const int vb0 = (int)(uintptr_t)V_lds + v_rd_base(lane);
    const bf16* Kh = cur.K; const bf16* Vh = cur.V; const float* Fh = cur.FB;
#define RESC(a) do { if (__any((a) < 1.f)) { if (hi == 0) al_l[r32] = (a); asm volatile("s_waitcnt lgkmcnt(0)" ::: "memory");              \
                     for (int d_ = 0; d_ < 4; ++d_) for (int r = 0; r < 16; ++r) o[d_][r] *= al_l[crow(r, hi)]; } } while (0)
#define KBASE(t) ((t) * KVBLK)
#define MASKT(P0_, P1_, t) do { const int kb_ = KBASE(t); if (kb_ + KVBLK - 1 > qlo) mask_tile(P0_, P1_, qm - kb_, W); } while (0)
    constexpr int NQL = 8;
#define SEAM_K0() do { VMWN(NQL); SWRITE_HK(0); SBAR(); } while (0)
    f32x16 pA0, pA1, pB0, pB1; float mnA, mnB, alA, alB; bf16x8 pa0, pa1, pa2, pa3;
    SWRITE_HV(0); SBAR();
    if (NT > 1) SLOAD_H(Kh, Vh, Fh, KBASE(1));
    SBAR(); qkt<0>(pA0, pA1, K_lds, B_lds, r32, hi, S.qr);
    MASKT(pA0, pA1, 0); partialSM(pA0, pA1, m_reg, mnA, alA);
    if (NT > 1) { VMW(); SWRITE_H(1); }
    __syncthreads();
#define HALF_STEP(PX0, PX1, mnX, alX, PY0, PY1, alY, t, KB, VB, SB) do {                                                      \
        SBAR(); qkt<KB>(PX0, PX1, K_lds, B_lds, r32, hi, S.qr);                                                               \
        finishSM(PY0, PY1, alY, l_reg, pa0, pa1, pa2, pa3); SBAR();                                                           \
        if ((t) + 1 < NT) { SLOAD_H(Kh, Vh, Fh, KBASE((t) + 1)); SBAR(); }                                                    \
        pv_tile<VB>(o, vb0, pa0, pa1, pa2, pa3); MASKT(PX0, PX1, (t)); partialSM(PX0, PX1, m_reg, mnX, alX);                  \
        __syncthreads();                                                                                                      \
        if ((t) + 1 < NT) { VMW(); SWRITE_H(SB); }                                                                            \
        RESC(alX); __syncthreads(); } while (0)
    for (int t = 1; t + 1 < NT; t += 2) {
        HALF_STEP(pB0, pB1, mnB, alB, pA0, pA1, alA, t, 1, 0, 0);
        HALF_STEP(pA0, pA1, mnA, alA, pB0, pB1, alB, t + 1, 0, 1, 1);
    }
    const bool even = (NT & 1) == 0;
    if (even) { SBAR(); qkt<1>(pB0, pB1, K_lds, B_lds, r32, hi, S.qr); SBAR(); }
    SLOAD_H(nxt.K, nxt.V, nxt.FB, 0); SBAR();
#pragma unroll
    for (int d0 = 0; d0 < 8; ++d0) S.qr[d0] = load8(nxt.Q + (size_t)(wid * QBLK + r32) * LD + d0 * 16 + hi * 8);
    SBAR();
    finishSM(pA0, pA1, alA, l_reg, pa0, pa1, pa2, pa3); SBAR();
    pv_tile<0>(o, vb0, pa0, pa1, pa2, pa3);
    if (even) { MASKT(pB0, pB1, NT - 1); partialSM(pB0, pB1, m_reg, mnB, alB); __syncthreads(); RESC(alB);
        finishSM(pB0, pB1, alB, l_reg, pa0, pa1, pa2, pa3); SBAR(); pv_tile<1>(o, vb0, pa0, pa1, pa2, pa3); }
    SBAR(); SEAM_K0();
    if (hi == 0) li_l[r32] = l_reg; asm volatile("s_waitcnt lgkmcnt(0)" ::: "memory");
    float rli[16];
#pragma unroll
    for (int r = 0; r < 16; ++r) rli[r] = __builtin_amdgcn_rcpf(li_l[crow(r, hi)]);
    bf16* Ow = cur.O + (size_t)(wid * QBLK) * LD;
#pragma unroll
    for (int r = 0; r < 16; ++r) { const int orow = crow(r, hi);
#pragma unroll
        for (int d0 = 0; d0 < 4; ++d0) { const float v = o[d0][r] * rli[r];
            const float vn = __shfl_xor(v, 1);
            if ((r32 & 1) == 0) *(unsigned*)(Ow + (size_t)orow * LD + d0 * 32 + r32) = cvtpk(v, vn); } }
    __syncthreads();
#undef RESC
#undef KBASE
#undef MASKT
#undef SEAM_K0
#undef HALF_STEP
}
#undef ROW
#undef VMW
#undef VMWN
#undef SLOAD_H
#undef SWRITE_HK
#undef SWRITE_HV
#undef SWRITE_H
#undef SBAR
#undef KSWZ
}

#define XB_TMO      128
#define XB_XCNT(j)  (256  + 64 * (j))
#define XB_XSUB(j)  (1280 + 64 * (j))
#define XB_XGEN(j)  (2304 + 64 * (j))
#define XB_TOP      3328
#define XB_TOPGEN   3392
#define XCD_BAR_WORDS 3456
#define XB_SPIN_CAP (1u << 18)
__device__ __forceinline__ unsigned xb_ld(unsigned* p)              { return __hip_atomic_load(p, __ATOMIC_RELAXED, __HIP_MEMORY_SCOPE_AGENT); }
__device__ __forceinline__ unsigned xb_add(unsigned* p, unsigned v) { return __hip_atomic_fetch_add(p, v, __ATOMIC_RELAXED, __HIP_MEMORY_SCOPE_AGENT); }
__device__ __forceinline__ unsigned xb_xcc_id() { return (unsigned)__builtin_amdgcn_s_getreg((3 << 11) | 20) & 0xFu; }
#define XB_SPIN(cond, bar) do { unsigned _sp = 0; while (cond) { __builtin_amdgcn_s_sleep(1); \
    if ((++_sp & 255u) == 0u) { if (xb_ld(&(bar)[XB_TMO])) break; if (_sp > XB_SPIN_CAP) { atomicAdd(&(bar)[XB_TMO], 1u); break; } } } } while (0)
struct XcdBarrier { unsigned* bar; unsigned x; volatile LAS unsigned* st; };
__device__ __forceinline__ XcdBarrier xcd_barrier_post(unsigned* bar, volatile LAS unsigned* st) {
    XcdBarrier b; b.bar = bar; b.x = xb_xcc_id(); b.st = st;
    if (threadIdx.x == 0) (void)xb_add(&bar[XB_XCNT(b.x)], 1u);
    return b;
}
__device__ __forceinline__ void xcd_barrier_complete(unsigned* bar, unsigned x, unsigned& nloc, unsigned& nx) {
    const unsigned G = gridDim.x * gridDim.y * gridDim.z;
    unsigned sum, cnt, mine, sp = 0u;
    for (;;) {
        sum = 0u; cnt = 0u; mine = 0u;
#pragma unroll
        for (unsigned j = 0; j < 16; ++j) { const unsigned c = xb_ld(&bar[XB_XCNT(j)]); sum += c; cnt += (c > 0u) ? 1u : 0u; mine = (j == x) ? c : mine; }
        if (sum == G) break;
        __builtin_amdgcn_s_sleep(1);
        if ((++sp & 255u) == 0u) { if (xb_ld(&bar[XB_TMO])) break; if (sp > XB_SPIN_CAP) { atomicAdd(&bar[XB_TMO], 1u); break; } }
    }
    nloc = mine > 0u ? mine : 1u; nx = cnt > 0u ? cnt : 1u;
}
__device__ __forceinline__ void xcd_barrier(const XcdBarrier& b) {
    asm volatile("s_waitcnt vmcnt(0)" ::: "memory");
    __syncthreads();
    if (threadIdx.x == 0) {
        unsigned* bar = b.bar;
        __builtin_amdgcn_s_waitcnt(0);
        unsigned nloc = b.st[0], nx = b.st[1];
        if (nloc == 0u) { xcd_barrier_complete(bar, b.x, nloc, nx); b.st[0] = nloc; b.st[1] = nx; }
        const unsigned old = xb_add(&bar[XB_XSUB(b.x)], 1u);
        const unsigned gen = old / nloc;
        if (old + 1u == (gen + 1u) * nloc) {
            __builtin_amdgcn_fence(__ATOMIC_RELEASE, "agent");
            asm volatile("s_waitcnt vmcnt(0)" ::: "memory");
            const unsigned og = xb_add(&bar[XB_TOP], 1u);
            const unsigned tg = og / nx;
            if (og + 1u == (tg + 1u) * nx) xb_add(&bar[XB_TOPGEN], 1u);
            else XB_SPIN(xb_ld(&bar[XB_TOPGEN]) == tg, bar);
            __builtin_amdgcn_fence(__ATOMIC_ACQUIRE, "agent");
            xb_add(&bar[XB_XGEN(b.x)], 1u);
            asm volatile("s_waitcnt vmcnt(0)" ::: "memory");
        } else {
            XB_SPIN(xb_ld(&bar[XB_XGEN(b.x)]) == gen, bar);
            __builtin_amdgcn_fence(__ATOMIC_ACQUIRE, "agent");
            asm volatile("s_waitcnt vmcnt(0)" ::: "memory");
        }
    }
    __syncthreads();
}

#ifndef PROBE_PHASE
#define PROBE_PHASE -1
#endif
#define PH(id) for (int rep_ = 0; rep_ < ((PROBE_PHASE == (id)) ? 2 : 1); ++rep_)
constexpr int NWAVES = 8, NTHREADS = 512;
constexpr int LDS_BYTES = 147456;
struct Args { const float* in[19]; float* out; unsigned char* ws; };
enum { I_X = 0, I_P, I_GPREMIX, I_WIN, I_BF, I_WPOOL, I_POOLSCALE, I_GPOOLOUT, I_GATTNOUT, I_WOUT, I_GPOSTMIX, I_GPREMLP, I_WUP, I_WDOWN, I_GPOSTMLP, I_GPLEGATE, I_WGATE, I_WPLE, I_GPOSTPLE };

constexpr int TR_PITCH = 68, TR_BYTES = 64 * TR_PITCH * 4;
__device__ __forceinline__ void p0_transpose_item(const float* W, int K, int N, int ldw, bf16_t* WT, int row_off, LAS float* scr, int item, int lane) {
    const int nblk = N / 64, kb = item / nblk, nb = item % nblk, k0 = 64 * kb, n0 = 64 * nb;
    f32x4 v[16];
    const float* src = W + (size_t)(k0 + (lane >> 4)) * ldw + n0 + 4 * (lane & 15);
#pragma unroll
    for (int i = 0; i < 16; ++i) v[i] = *(const f32x4*)(src + (size_t)(4 * i) * ldw);
#pragma unroll
    for (int i = 0; i < 16; ++i) *(LAS f32x4*)(scr + (4 * i + (lane >> 4)) * TR_PITCH + 4 * (lane & 15)) = v[i];
    asm volatile("s_waitcnt lgkmcnt(0)" ::: "memory");
    const int c = lane >> 3;
#pragma unroll
    for (int j = 0; j < 8; ++j) { const int n = (lane & 7) + 8 * j; const LAS float* sp = scr + (8 * c) * TR_PITCH + n;
        u32x4 o; o.x = cvt_pk_bf16(sp[0 * TR_PITCH], sp[1 * TR_PITCH]); o.y = cvt_pk_bf16(sp[2 * TR_PITCH], sp[3 * TR_PITCH]);
        o.z = cvt_pk_bf16(sp[4 * TR_PITCH], sp[5 * TR_PITCH]); o.w = cvt_pk_bf16(sp[6 * TR_PITCH], sp[7 * TR_PITCH]);
        *(u32x4*)(WT + (size_t)(row_off + n0 + n) * K + k0 + 8 * c) = o; }
    asm volatile("s_waitcnt lgkmcnt(0)" ::: "memory");
}

template <bool BIN, bool BOUT>
__device__ __forceinline__ void resnorm_phase(const void* base, const bf16_t* raw, const float* g_post, void* outp, const float* g_next, bf16_t* hn, int gw, int NGW, int lane) {
    u32x2 nraw[8]; f32x4 nbf[8]; u32x2 nbh[8];
#define RN_LOAD(mm) do { const u32x2* rp_ = (const u32x2*)(raw + (size_t)(mm) * DM) + lane; \
        _Pragma("unroll") for (int j = 0; j < 8; ++j) nraw[j] = rp_[64 * j]; \
        if (BIN) { const u32x2* bp_ = (const u32x2*)((const bf16_t*)base + (size_t)(mm) * DM) + lane; _Pragma("unroll") for (int j = 0; j < 8; ++j) nbh[j] = bp_[64 * j]; } \
        else { const f32x4* bp_ = (const f32x4*)((const float*)base + (size_t)(mm) * DM) + lane; _Pragma("unroll") for (int j = 0; j < 8; ++j) nbf[j] = bp_[64 * j]; } } while (0)
    int m = gw; if (m < M) RN_LOAD(m);
    for (; m < M; m += NGW) {
        f32x4 r[8], b[8]; float ss = 0.f;
#pragma unroll
        for (int j = 0; j < 8; ++j) { r[j] = (f32x4){bf_lo(nraw[j].x), bf_hi(nraw[j].x), bf_lo(nraw[j].y), bf_hi(nraw[j].y)};
            if (BIN) b[j] = (f32x4){bf_lo(nbh[j].x), bf_hi(nbh[j].x), bf_lo(nbh[j].y), bf_hi(nbh[j].y)}; else b[j] = nbf[j];
            ss += (r[j].x * r[j].x + r[j].y * r[j].y) + (r[j].z * r[j].z + r[j].w * r[j].w); }
        asm volatile("" ::: "memory");
        if (m + NGW < M) RN_LOAD(m + NGW);
        const float rs = 1.0f / sqrtf(wave_sum(ss) * (1.f / DM) + EPS);
        float ss2 = 0.f;
#pragma unroll
        for (int j = 0; j < 8; ++j) { const f32x4 g = *((const f32x4*)g_post + lane + 64 * j);
            r[j] = b[j] + r[j] * rs * g;
            if (BOUT) { u32x2 w; w.x = cvt_pk_bf16(r[j].x, r[j].y); w.y = cvt_pk_bf16(r[j].z, r[j].w); *((u32x2*)((bf16_t*)outp + (size_t)m * DM) + lane + 64 * j) = w; }
            else *((f32x4*)((float*)outp + (size_t)m * DM) + lane + 64 * j) = r[j];
            ss2 += (r[j].x * r[j].x + r[j].y * r[j].y) + (r[j].z * r[j].z + r[j].w * r[j].w); }
        if (g_next) {
            const float rs2 = 1.0f / sqrtf(wave_sum(ss2) * (1.f / DM) + EPS);
#pragma unroll
            for (int j = 0; j < 8; ++j) { const f32x4 g = *((const f32x4*)g_next + lane + 64 * j); const f32x4 h = r[j] * rs2 * g;
                u32x2 w; w.x = cvt_pk_bf16(h.x, h.y); w.y = cvt_pk_bf16(h.z, h.w); *((u32x2*)(hn + (size_t)m * DM) + lane + 64 * j) = w; }
        }
    }
#undef RN_LOAD
}
__device__ __forceinline__ void ynorm_phase(const bf16_t* yp, const bf16_t* ya, const float* gp, const float* ga, bf16_t* y, int gw, int NGW, int lane) {
    u32x4 np[2], na[2];
#define YN_LOAD(mm) do { _Pragma("unroll") for (int j = 0; j < 2; ++j) { np[j] = *((const u32x4*)(yp + (size_t)(mm) * 1024) + lane + 64 * j); na[j] = *((const u32x4*)(ya + (size_t)(mm) * 1024) + lane + 64 * j); } } while (0)
    int m = gw; if (m < M) YN_LOAD(m);
    for (; m < M; m += NGW) {
        float v[2][2][8]; float ss0 = 0.f, ss1 = 0.f;
#pragma unroll
        for (int j = 0; j < 2; ++j) { const u32x4 w = np[j], q = na[j];
            v[0][j][0] = bf_lo(w.x); v[0][j][1] = bf_hi(w.x); v[0][j][2] = bf_lo(w.y); v[0][j][3] = bf_hi(w.y); v[0][j][4] = bf_lo(w.z); v[0][j][5] = bf_hi(w.z); v[0][j][6] = bf_lo(w.w); v[0][j][7] = bf_hi(w.w);
            v[1][j][0] = bf_lo(q.x); v[1][j][1] = bf_hi(q.x); v[1][j][2] = bf_lo(q.y); v[1][j][3] = bf_hi(q.y); v[1][j][4] = bf_lo(q.z); v[1][j][5] = bf_hi(q.z); v[1][j][6] = bf_lo(q.w); v[1][j][7] = bf_hi(q.w);
#pragma unroll
            for (int e = 0; e < 8; ++e) { ss0 += v[0][j][e] * v[0][j][e]; ss1 += v[1][j][e] * v[1][j][e]; } }
        asm volatile("" ::: "memory");
        if (m + NGW < M) YN_LOAD(m + NGW);
#pragma unroll
        for (int o = 1; o < 64; o <<= 1) { ss0 += __shfl_xor(ss0, o); ss1 += __shfl_xor(ss1, o); }
        const float rs[2] = {1.0f / sqrtf(ss0 * (1.f / 1024.f) + EPS), 1.0f / sqrtf(ss1 * (1.f / 1024.f) + EPS)};
#pragma unroll
        for (int h = 0; h < 2; ++h) { const float* g = h ? ga : gp;
#pragma unroll
            for (int j = 0; j < 2; ++j) { const f32x4 g0 = *((const f32x4*)g + 2 * (lane + 64 * j)), g1 = *((const f32x4*)g + 2 * (lane + 64 * j) + 1); const float r_ = rs[h];
                u32x4 w; w.x = cvt_pk_bf16(v[h][j][0] * r_ * g0.x, v[h][j][1] * r_ * g0.y); w.y = cvt_pk_bf16(v[h][j][2] * r_ * g0.z, v[h][j][3] * r_ * g0.w);
                w.z = cvt_pk_bf16(v[h][j][4] * r_ * g1.x, v[h][j][5] * r_ * g1.y); w.w = cvt_pk_bf16(v[h][j][6] * r_ * g1.z, v[h][j][7] * r_ * g1.w);
                *((u32x4*)(y + (size_t)m * DM + h * 1024) + lane + 64 * j) = w; } }
    }
#undef YN_LOAD
}
__device__ __forceinline__ float log_sigmoid(float x) { return x < 0.f ? x - log1pf(expf(x)) : -log1pf(expf(-x)); }

__global__ void __launch_bounds__(NTHREADS, 2) mega_fwd(Args args) {
    extern __shared__ __attribute__((aligned(16))) unsigned char lds[];
    cg::grid_group grid = cg::this_grid();
    LAS unsigned char* ldsl = (LAS unsigned char*)lds;
    const int G = gridDim.x, bid = blockIdx.x, NGW = G * NWAVES;
#define PHASE_IDS() const int tid = fresh_tid(), lane = tid & 63, wave = __builtin_amdgcn_readfirstlane(tid >> 6), gw = bid * NWAVES + wave; (void)lane; (void)gw
    unsigned char* ws = args.ws;
    unsigned* barw = (unsigned*)ws;
    volatile LAS unsigned* MISC = (volatile LAS unsigned*)(ldsl + LDS_BYTES - 256);
    { const int t0 = fresh_tid(); if (t0 < 64) MISC[t0] = 0u;
      if (bid == 0) for (int i = t0; i < XCD_BAR_WORDS + 64; i += NTHREADS) __hip_atomic_store(barw + i, 0u, __ATOMIC_RELAXED, __HIP_MEMORY_SCOPE_AGENT);
      __syncthreads(); }
    const float* x = args.in[I_X];
    float* out = args.out;
    float* flog = (float*)(ws + WS_FLOG); float* fb = (float*)(ws + WS_FB);
    bf16_t* WinT = (bf16_t*)(ws + WS_WIN); bf16_t* WoutT = (bf16_t*)(ws + WS_WOUT); bf16_t* WupT = (bf16_t*)(ws + WS_WUP); bf16_t* WdownT = (bf16_t*)(ws + WS_WDOWN);
    bf16_t* WgateT = (bf16_t*)(ws + WS_WGATE); bf16_t* WpleT = (bf16_t*)(ws + WS_WPLE); bf16_t* WpoolT = (bf16_t*)(ws + WS_WPOOL);
    bf16_t* HN = (bf16_t*)(ws + WS_HN);
    bf16_t* U = (bf16_t*)(ws + AR_U); bf16_t* Qb = (bf16_t*)(ws + AR_Q); bf16_t* Kb = (bf16_t*)(ws + AR_K); bf16_t* Vb = (bf16_t*)(ws + AR_V);
    bf16_t* YP = (bf16_t*)(ws + AR_YP); bf16_t* YA = (bf16_t*)(ws + AR_YA); bf16_t* DP = (bf16_t*)(ws + AR_DP);
    bf16_t* Y = (bf16_t*)(ws + AR_Y); bf16_t* RAW1 = (bf16_t*)(ws + AR_RAW1); bf16_t* HID = (bf16_t*)(ws + AR_HID); bf16_t* Eb = (bf16_t*)(ws + AR_E);
    bf16_t* RAW2 = (bf16_t*)(ws + WS_RAW2); bf16_t* PBF = (bf16_t*)(ws + WS_PBF);
    bf16_t* H1 = (bf16_t*)out;
    bf16_t* H2 = (bf16_t*)(ws + WS_ARENA + 32 * MiB);

    PH(0) {
    {
        PHASE_IDS();
        LAS float* wf = (LAS float*)ldsl;
        const float* w_in = args.in[I_WIN]; const float* gpm = args.in[I_GPREMIX];
        for (int idx = tid; idx < DM * 8; idx += NTHREADS) { const int k = idx >> 3, c = idx & 7;
            const float val = w_in[(size_t)k * INW + 4096 + c] * gpm[k];
            const int l = (k & 255) >> 2, i = k & 3, j = k >> 8; wf[((j * 4 + i) * 64 + l) * 8 + c] = val; }
        __syncthreads();
        f32x4 nx[8];
        if (gw < M) {
#pragma unroll
            for (int j = 0; j < 8; ++j) nx[j] = *((const f32x4*)(x + (size_t)gw * DM) + lane + 64 * j); }
        for (int m = gw; m < M; m += NGW) {
            f32x4 v[8]; float ss = 0.f;
#pragma unroll
            for (int j = 0; j < 8; ++j) { v[j] = nx[j]; ss += (v[j].x * v[j].x + v[j].y * v[j].y) + (v[j].z * v[j].z + v[j].w * v[j].w); }
            asm volatile("" ::: "memory");
            if (m + NGW < M) {
#pragma unroll
                for (int j = 0; j < 8; ++j) nx[j] = *((const f32x4*)(x + (size_t)(m + NGW) * DM) + lane + 64 * j); }
            const float rs = 1.0f / sqrtf(wave_sum(ss) * (1.f / DM) + EPS);
            float fa[8] = {0.f, 0.f, 0.f, 0.f, 0.f, 0.f, 0.f, 0.f};
#pragma unroll
            for (int j = 0; j < 8; ++j)
#pragma unroll
                for (int i = 0; i < 4; ++i) { const LAS f32x4* wp = (const LAS f32x4*)(wf + ((j * 4 + i) * 64 + lane) * 8); const f32x4 w0 = wp[0], w1 = wp[1]; const float xv = v[j][i];
                    fa[0] += xv * w0.x; fa[1] += xv * w0.y; fa[2] += xv * w0.z; fa[3] += xv * w0.w; fa[4] += xv * w1.x; fa[5] += xv * w1.y; fa[6] += xv * w1.z; fa[7] += xv * w1.w; }
#pragma unroll
            for (int c = 0; c < 8; ++c) fa[c] = wave_sum(fa[c]) * rs;
            if (lane < 8) { float fv = fa[0];
#pragma unroll
                for (int c = 1; c < 8; ++c) fv = (lane == c) ? fa[c] : fv;
                flog[((size_t)(m >> 11) * NH + lane) * SEQ + (m & (SEQ - 1))] = log_sigmoid(fv + args.in[I_BF][lane]); }
            u32x2* o8 = (u32x2*)(HN + (size_t)m * DM) + lane;
#pragma unroll
            for (int j = 0; j < 8; ++j) { const f32x4 g = *((const f32x4*)gpm + lane + 64 * j); const f32x4 h = v[j] * rs * g;
                u32x2 w; w.x = cvt_pk_bf16(h.x, h.y); w.y = cvt_pk_bf16(h.z, h.w); o8[64 * j] = w; }
        }
        __syncthreads();
        LAS float* scr = (LAS float*)(ldsl + wave * TR_BYTES);
        constexpr int IT_IN = (DM / 64) * (4096 / 64), IT_OUT = (DM / 64) * (DM / 64), IT_UP = (DM / 64) * (DFF / 64), IT_DOWN = (DFF / 64) * (DM / 64),
                      IT_GATE = IT_OUT, IT_PLE = (PLE / 64) * (DM / 64), IT_POOL1 = (256 / 64) * (256 / 64);
        constexpr int NITEMS = IT_IN + IT_OUT + IT_UP + IT_DOWN + IT_GATE + IT_PLE + 4 * IT_POOL1;
        for (int it = gw; it < NITEMS; it += NGW) {
            int r = it;
            if (r < IT_IN) { p0_transpose_item(args.in[I_WIN], DM, 4096, INW, WinT, 0, scr, r, lane); continue; } r -= IT_IN;
            if (r < IT_OUT) { p0_transpose_item(args.in[I_WOUT], DM, DM, DM, WoutT, 0, scr, r, lane); continue; } r -= IT_OUT;
            if (r < IT_UP) { p0_transpose_item(args.in[I_WUP], DM, DFF, DFF, WupT, 0, scr, r, lane); continue; } r -= IT_UP;
            if (r < IT_DOWN) { p0_transpose_item(args.in[I_WDOWN], DFF, DM, DM, WdownT, 0, scr, r, lane); continue; } r -= IT_DOWN;
            if (r < IT_GATE) { p0_transpose_item(args.in[I_WGATE], DM, DM, DM, WgateT, 0, scr, r, lane); continue; } r -= IT_GATE;
            if (r < IT_PLE) { p0_transpose_item(args.in[I_WPLE], PLE, DM, DM, WpleT, 0, scr, r, lane); continue; } r -= IT_PLE;
            { const int gi = r / IT_POOL1; p0_transpose_item(args.in[I_WPOOL] + (size_t)gi * 65536, 256, 256, 256, WpoolT, gi * 256, scr, r % IT_POOL1, lane); }
        }
        const float* p = args.in[I_P];
        for (int idx = bid * NTHREADS + tid; idx < M * PLE / 8; idx += G * NTHREADS) { const f32x4 a = *((const f32x4*)p + 2 * idx), b = *((const f32x4*)p + 2 * idx + 1);
            u32x4 w; w.x = cvt_pk_bf16(a.x, a.y); w.y = cvt_pk_bf16(a.z, a.w); w.z = cvt_pk_bf16(b.x, b.y); w.w = cvt_pk_bf16(b.z, b.w); *((u32x4*)PBF + idx) = w; }
    }
    grid.sync();
    }
    const XcdBarrier bar = xcd_barrier_post(barw, MISC + 8);

#if PROBE_PHASE == 100
    for (int i_ = 0; i_ < 16; ++i_) xcd_barrier(bar);
#endif
    PH(1) {
    {
        { PHASE_IDS();
          if (bid < NB * NH && wave == 0) {
            const f32x4* fl = (const f32x4*)(flog + (size_t)bid * SEQ + 32 * lane); f32x4 v[8]; float run = 0.f;
#pragma unroll
            for (int j = 0; j < 8; ++j) v[j] = fl[j];
#pragma unroll
            for (int j = 0; j < 8; ++j) { v[j].x += run; v[j].y += v[j].x; v[j].z += v[j].y; v[j].w += v[j].z; run = v[j].w; }
            float incl = run;
#pragma unroll
            for (int o = 1; o < 64; o <<= 1) { const float t = __shfl_up(incl, o); if (lane >= o) incl += t; }
            const float excl = incl - run;
            f32x4* fo = (f32x4*)(fb + (size_t)bid * SEQ + 32 * lane);
#pragma unroll
            for (int j = 0; j < 8; ++j) fo[j] = (v[j] + excl) * -11.313708498984761f;
          } }
        pg8::Gemm g{HN, WinT, DM, DM, DM, 0}; pg8::StaticOrder S; S.init(M, 4096, G, bid);
        pg8::EpiG<0> E{U, 1024, 1024, (size_t)(AR_Q - AR_U) / 2, nullptr, nullptr};
        pg8::gemm_phase(ldsl, g, S, E);
    }
    xcd_barrier(bar);
    }

    PH(3) {
    {
        const int xcd = bid & 7, ix = bid >> 3;
        const int bh = (xcd * 4 + (ix >> 3)) & 31, qb = ix & 7, b = bh >> 3, h = bh & 7;
        if (bid < 256) {
            att::BlockRef cur;
            const size_t rowb = (size_t)b * SEQ;
            cur.Q = Qb + (rowb + (size_t)qb * 256) * 1024 + h * HD; cur.K = Kb + rowb * 1024 + h * HD; cur.V = Vb + rowb * 1024 + h * HD;
            cur.FB = fb + (size_t)bh * SEQ; cur.O = YA + (rowb + (size_t)qb * 256) * 1024 + h * HD; cur.P0 = qb * 256;
            att::Seam S;
            att::prime(cur, (char*)lds, S);
            att::block(cur, cur, (char*)lds, S);
            asm volatile("s_waitcnt vmcnt(0)" ::: "memory");
            __syncthreads();
        }
        {
            pg8::SingleUnit S; const int id = bh * 4 + qb; S.valid = (bid < 256 && qb < 4) ? 1 : 0; S.pm = id >> 2; S.pn = id & 3;
            if (S.valid) {
                const int tid = fresh_tid(), cc = tid & 31, tg = tid >> 5, gi = S.pn, w = 2 << gi;
                const int t0 = S.pm * 256 + tg * 16, pos0 = t0 & (SEQ - 1), col = gi * 256 + cc * 8;
                const bf16_t* up = U + (size_t)t0 * POOLW + col; bf16_t* dp = DP + (size_t)t0 * POOLW + col;
                float sm[8] = {0.f, 0.f, 0.f, 0.f, 0.f, 0.f, 0.f, 0.f};
                for (int j = 1; j < w; ++j) if (pos0 - j >= 0) { const u32x4 v = *(const u32x4*)(up - (size_t)j * POOLW);
                    sm[0] += bf_lo(v.x); sm[1] += bf_hi(v.x); sm[2] += bf_lo(v.y); sm[3] += bf_hi(v.y); sm[4] += bf_lo(v.z); sm[5] += bf_hi(v.z); sm[6] += bf_lo(v.w); sm[7] += bf_hi(v.w); }
                for (int i = 0; i < 16; ++i) { const int pos = pos0 + i; const u32x4 v = *(const u32x4*)(up + (size_t)i * POOLW);
                    const float f[8] = {bf_lo(v.x), bf_hi(v.x), bf_lo(v.y), bf_hi(v.y), bf_lo(v.z), bf_hi(v.z), bf_lo(v.w), bf_hi(v.w)};
                    const float inv = 1.0f / (float)((pos + 1 < w) ? pos + 1 : w);
                    float d[8];
#pragma unroll
                    for (int e = 0; e < 8; ++e) { sm[e] += f[e]; d[e] = sm[e] * inv - f[e]; }
                    u32x4 o; o.x = cvt_pk_bf16(d[0], d[1]); o.y = cvt_pk_bf16(d[2], d[3]); o.z = cvt_pk_bf16(d[4], d[5]); o.w = cvt_pk_bf16(d[6], d[7]);
                    *(u32x4*)(dp + (size_t)i * POOLW) = o;
                    if (pos - w + 1 >= 0) { const u32x4 q = *(const u32x4*)(up + (size_t)(i - w + 1) * POOLW);
                        sm[0] -= bf_lo(q.x); sm[1] -= bf_hi(q.x); sm[2] -= bf_lo(q.y); sm[3] -= bf_hi(q.y); sm[4] -= bf_lo(q.z); sm[5] -= bf_hi(q.z); sm[6] -= bf_lo(q.w); sm[7] -= bf_hi(q.w); } }
                asm volatile("s_waitcnt vmcnt(0)" ::: "memory");
                __syncthreads();
            }
            pg8::Gemm g{DP, WpoolT, POOLW, 256, 256, 256};
            pg8::EpiG<4> E{YP, POOLW, 0, 0, args.in[I_POOLSCALE], nullptr};
            pg8::gemm_phase(ldsl, g, S, E);
        }
    }
    xcd_barrier(bar);
    }

    PH(4) {
    { PHASE_IDS();
    ynorm_phase(YP, YA, args.in[I_GPOOLOUT], args.in[I_GATTNOUT], Y, gw, NGW, lane); }
    xcd_barrier(bar);
    }

    PH(5) {
    {
        pg8::Gemm g{Y, WoutT, DM, DM, DM, 0}; pg8::StaticOrder S; S.init(M, DM, G, bid);
        pg8::EpiG<0> E{RAW1, DM, 0, 0, nullptr, nullptr};
        pg8::gemm_phase(ldsl, g, S, E);
    }
    xcd_barrier(bar);
    }

    PH(6) {
    { PHASE_IDS();
    resnorm_phase<false, true>(x, RAW1, args.in[I_GPOSTMIX], H1, args.in[I_GPREMLP], HN, gw, NGW, lane); }
    xcd_barrier(bar);
    }

    PH(7) {
    {
        pg8::Gemm g{HN, WupT, DM, DM, DM, 0}; pg8::StaticOrder S; S.init(M, DFF, G, bid);
        pg8::EpiG<2> E{HID, DFF, 0, 0, nullptr, nullptr};
        pg8::gemm_phase(ldsl, g, S, E);
    }
    xcd_barrier(bar);
    }

    PH(8) {
    {
        pg8::Gemm g{HID, WdownT, DFF, DFF, DFF, 0}; pg8::StaticOrder S; S.init(M, DM, G, bid);
        pg8::EpiG<0> E{RAW2, DM, 0, 0, nullptr, nullptr};
        pg8::gemm_phase(ldsl, g, S, E);
    }
    xcd_barrier(bar);
    }

    PH(9) {
    { PHASE_IDS();
    resnorm_phase<true, true>(H1, RAW2, args.in[I_GPOSTMLP], H2, args.in[I_GPLEGATE], HN, gw, NGW, lane); }
    xcd_barrier(bar);
    }

    PH(10) {
    {
        pg8::StaticOrder S; S.init(M, DM, G, bid);
        { pg8::Gemm g{PBF, WpleT, PLE, PLE, PLE, 0}; pg8::EpiG<0> E{Eb, DM, 0, 0, nullptr, nullptr}; pg8::gemm_phase(ldsl, g, S, E); }
        asm volatile("s_waitcnt vmcnt(0)" ::: "memory");
        __syncthreads();
        { pg8::Gemm g{HN, WgateT, DM, DM, DM, 0}; pg8::EpiG<3> E{RAW2, DM, 0, 0, nullptr, Eb}; pg8::gemm_phase(ldsl, g, S, E); }
    }
    xcd_barrier(bar);
    }

    PH(11) {
    { PHASE_IDS();
    resnorm_phase<true, false>(H2, RAW2, args.in[I_GPOSTPLE], out, nullptr, nullptr, gw, NGW, lane); }
    }
}

extern "C" void kernel_launch(void* const* d_in, const int* in_sizes, int n_in, void* d_out, int out_size, void* d_ws, size_t ws_size, hipStream_t stream) {
    static int grid = 0;
    if (grid == 0) {
        if (n_in != 19 || in_sizes[0] != M * DM || out_size != M * DM || ws_size < WS_END) {
            fprintf(stderr, "kernel_launch: unexpected shapes (n_in %d in0 %d out %d ws %zu)\n", n_in, n_in > 0 ? in_sizes[0] : -1, out_size, ws_size); grid = -1; return; }
        int dev = 0, cus = 0, per_cu = 0;
        hipGetDevice(&dev); hipDeviceGetAttribute(&cus, hipDeviceAttributeMultiprocessorCount, dev);
        if (hipFuncSetAttribute((const void*)mega_fwd, hipFuncAttributeMaxDynamicSharedMemorySize, LDS_BYTES) != hipSuccess) { fprintf(stderr, "kernel_launch: hipFuncSetAttribute failed\n"); grid = -1; return; }
        if (hipOccupancyMaxActiveBlocksPerMultiprocessor(&per_cu, (const void*)mega_fwd, NTHREADS, LDS_BYTES) != hipSuccess || per_cu < 1) {
            fprintf(stderr, "kernel_launch: occupancy query says %d\n", per_cu); per_cu = 1; }
        (void)hipGetLastError();
        grid = cus * 1;
        if (grid != 256) fprintf(stderr, "kernel_launch: grid %d (expected 256)\n", grid);
    }
    if (grid < 0) return;
    Args a{};
    for (int i = 0; i < 19; ++i) a.in[i] = (const float*)d_in[i];
    a.out = (float*)d_out; a.ws = (unsigned char*)d_ws;
    void* kargs[] = {&a};
    hipError_t e = hipLaunchCooperativeKernel((const void*)mega_fwd, dim3(grid), dim3(NTHREADS), kargs, LDS_BYTES, stream);
    if (e != hipSuccess) fprintf(stderr, "kernel_launch: cooperative launch failed: %s (grid %d)\n", hipGetErrorString(e), grid);
}
```

```cpp
#include <hip/hip_runtime.h>
#include <hip/hip_bf16.h>
#include <hip/hip_cooperative_groups.h>
#include <cstdio>
#include <cstdint>
namespace cg = cooperative_groups;

#define LAS __attribute__((address_space(3)))
typedef unsigned short bf16_t;
typedef short bf16x8 __attribute__((ext_vector_type(8)));
typedef short s16x4 __attribute__((ext_vector_type(4)));
typedef float f32x4 __attribute__((ext_vector_type(4)));
typedef float f32x2 __attribute__((ext_vector_type(2)));
typedef float f32x16 __attribute__((ext_vector_type(16)));
typedef unsigned u32x4 __attribute__((ext_vector_type(4)));
typedef unsigned u32x2 __attribute__((ext_vector_type(2)));

constexpr int DM = 2048, SEQ = 2048, NB = 4, M = NB * SEQ, POOLW = 1024, ATTW = 1024, NH = 8, HD = 128, DFF = 8192, PLE = 256, INW = 4104;
constexpr float EPS = 1e-6f;

constexpr size_t MiB = 1u << 20;
constexpr size_t WS_FLOG = 1 * MiB;
constexpr size_t WS_FB = 1 * MiB + 512 * 1024;
constexpr size_t WS_WIN = 2 * MiB, WS_WOUT = 18 * MiB, WS_WUP = 26 * MiB, WS_WDOWN = 58 * MiB, WS_WGATE = 90 * MiB, WS_WPLE = 98 * MiB, WS_WPOOL = 99 * MiB;
constexpr size_t WS_HN = 100 * MiB;
constexpr size_t WS_ARENA = 132 * MiB;
constexpr size_t AR_U = WS_ARENA, AR_Q = WS_ARENA + 16 * MiB, AR_K = WS_ARENA + 32 * MiB, AR_V = WS_ARENA + 48 * MiB;
constexpr size_t AR_YP = WS_ARENA + 64 * MiB, AR_YA = WS_ARENA + 80 * MiB, AR_DP = WS_ARENA + 96 * MiB;
constexpr size_t AR_Y = WS_ARENA;
constexpr size_t AR_RAW1 = WS_ARENA + 32 * MiB;
constexpr size_t AR_HID = WS_ARENA;
constexpr size_t AR_E = WS_ARENA;
constexpr size_t WS_RAW2 = WS_WUP;
constexpr size_t WS_PBF = 260 * MiB;
constexpr size_t WS_END = 264 * MiB;

__device__ __forceinline__ unsigned cvt_pk_bf16(float lo, float hi) { unsigned r; asm volatile("v_cvt_pk_bf16_f32 %0, %1, %2" : "=v"(r) : "v"(lo), "v"(hi)); return r; }
__device__ __forceinline__ int fresh_tid(int wv) { int l; asm volatile("v_mbcnt_lo_u32_b32 %0, -1, 0\n\tv_mbcnt_hi_u32_b32 %0, -1, %0" : "=v"(l)); return (wv << 6) | l; }
__device__ __forceinline__ float bf_lo(unsigned w) { return __uint_as_float(w << 16); }
__device__ __forceinline__ float bf_hi(unsigned w) { return __uint_as_float(w & 0xffff0000u); }
__device__ __forceinline__ float wave_sum(float v) {
#define WS_SWZ(o) v += __int_as_float(__builtin_amdgcn_ds_swizzle(__float_as_int(v), 0x1f | ((o) << 10)))
    WS_SWZ(1); WS_SWZ(2); WS_SWZ(4); WS_SWZ(8); WS_SWZ(16);
#undef WS_SWZ
    const auto rr = __builtin_amdgcn_permlane32_swap(__float_as_uint(v), __float_as_uint(v), false, false);
    return __uint_as_float(rr[0]) + __uint_as_float(rr[1]);
}

namespace pg8 {
constexpr int BM = 256, BK = 64, HALF = 128, HTB = HALF * BK * 2, STAGE_BYTES = 8 * HTB, NXCD = 8, WGM = 8;
__host__ __device__ __forceinline__ int lds_byte(int r, int c) { const int st = (r >> 4) * 2 + (c >> 5), rr = r & 15, cc = c & 31, ob = rr * 64 + cc * 2; return st * 1024 + (ob ^ (((ob >> 9) & 1) << 5)); }
__host__ __device__ __forceinline__ void stage_rc(int b, int& R, int& C) { const int st = b / 1024, sb = b % 1024, swz = sb ^ (((sb >> 9) & 1) << 5); R = (st >> 1) * 16 + swz / 64; C = (st & 1) * 32 + (swz % 64) / 2; }
__host__ __device__ __forceinline__ int perm32(int rho) { const int n = rho >> 4, i = rho & 15; return 8 * (i >> 2) + 4 * n + (i & 3); }

struct Unit { int pm, pn; };
struct Gemm { const bf16_t* A; const bf16_t* Bt; int lda, ldb, K, a_pn_koff; };

struct StaticOrder {
    int nM, nN, nwg, G, c;
    __device__ void init(int M_, int N_, int G_, int c_) { nM = M_ / BM; nN = N_ / BM; nwg = nM * nN; G = G_; c = c_; }
    __device__ bool next(int i, Unit& u) const {
        const long L = (long)i * G + c; if (L >= nwg) return false;
        int wgid = (int)L; { const int q = nwg / NXCD, r = nwg % NXCD, xcd = wgid % NXCD, off = wgid / NXCD; wgid = (xcd < r ? xcd * (q + 1) : r * (q + 1) + (xcd - r) * q) + off; }
        const int nig = WGM * nN, gid = wgid / nig, fm = gid * WGM, gsz = (nM - fm) < WGM ? (nM - fm) : WGM;
        u.pm = fm + ((wgid % nig) % gsz); u.pn = (wgid % nig) / gsz; return true;
    }
};
struct ListSched {
    int id0, n, nN;
    __device__ bool next(int i, Unit& u) const { if (i >= n) return false; const int id = id0 + i; u.pm = id / nN; u.pn = id % nN; return true; }
};
struct SingleUnit {
    int pm, pn, valid;
    __device__ bool next(int i, Unit& u) const { if (i != 0 || !valid) return false; u.pm = pm; u.pn = pn; return true; }
};

template <int ACT> struct EpiG {
    static constexpr bool PERM = true;
    bf16_t* O; int ldc; int split_cols; size_t split_stride; const float* colscale; const bf16_t* aux;
    __device__ __forceinline__ void operator()(const f32x4 (&acc)[2][2][4][2], const Unit& u, int wr, int wc, int fr, int fq) const {
        const int row0 = u.pm * BM + wr * 64 + fr; int colt = u.pn * BM; bf16_t* base = O;
        if (split_cols) { const int t = colt / split_cols; base += (size_t)t * split_stride; colt -= t * split_cols; }
        const int col0 = colt + wc * 32 + 8 * fq, gcol0 = u.pn * BM + wc * 32 + 8 * fq;
        f32x4 cs[2][2];
        if (ACT == 4) {
#pragma unroll
            for (int bj = 0; bj < 2; ++bj)
#pragma unroll
                for (int n = 0; n < 2; ++n) cs[bj][n] = *(const f32x4*)(colscale + gcol0 + bj * HALF + 4 * n);
        }
#pragma unroll
        for (int ai = 0; ai < 2; ++ai)
#pragma unroll
            for (int m = 0; m < 4; ++m) { const size_t roff = (size_t)(row0 + ai * HALF + m * 16) * ldc + col0;
#pragma unroll
                for (int bj = 0; bj < 2; ++bj) { f32x4 v0 = acc[ai][bj][m][0], v1 = acc[ai][bj][m][1];
                    if (ACT == 2) {
#pragma unroll
                        for (int e = 0; e < 4; ++e) { float a = fmaxf(v0[e], 0.f), b = fmaxf(v1[e], 0.f); v0[e] = a * a; v1[e] = b * b; }
                    }
                    if (ACT == 3) { const u32x4 ev = *(const u32x4*)(aux + roff + bj * HALF);
                        const float e0[4] = {bf_lo(ev.x), bf_hi(ev.x), bf_lo(ev.y), bf_hi(ev.y)}, e1[4] = {bf_lo(ev.z), bf_hi(ev.z), bf_lo(ev.w), bf_hi(ev.w)};
#pragma unroll
                        for (int e = 0; e < 4; ++e) { v0[e] = __builtin_amdgcn_rcpf(1.f + __builtin_amdgcn_exp2f(-1.4426950408889634f * v0[e])) * e0[e];
                                                      v1[e] = __builtin_amdgcn_rcpf(1.f + __builtin_amdgcn_exp2f(-1.4426950408889634f * v1[e])) * e1[e]; }
                    }
                    if (ACT == 4) { v0 = v0 * cs[bj][0]; v1 = v1 * cs[bj][1]; }
                    u32x4 w; w.x = cvt_pk_bf16(v0[0], v0[1]); w.y = cvt_pk_bf16(v0[2], v0[3]); w.z = cvt_pk_bf16(v1[0], v1[1]); w.w = cvt_pk_bf16(v1[2], v1[3]);
                    *(u32x4*)(base + roff + bj * HALF) = w; } }
    }
};

template <class Epi, class Sched>
__device__ __forceinline__ void gemm_phase(LAS unsigned char* lds, const Gemm g, const Sched& S, const Epi& E, int wv) {
    constexpr bool ALIGN_EPI = true;
    const int tid = fresh_tid(wv), wid = __builtin_amdgcn_readfirstlane(tid >> 6), lane = tid & 63, wr = wid >> 2, wc = wid & 3, fr = lane & 15, fq = lane >> 4;
    const int K = g.K, nt = K / BK;
    unsigned voffA[2], voffB[2];
#pragma unroll
    for (int i = 0; i < 2; ++i) { int R, C; stage_rc(tid * 16 + i * 8192, R, C); const int Rb = Epi::PERM ? ((R & ~31) + perm32(R & 31)) : R;
        voffA[i] = (unsigned)(R * g.lda + C) * 2u; voffB[i] = (unsigned)(Rb * g.ldb + C) * 2u; }
    const size_t kstep = (size_t)(BK * 2);
    const size_t hstepA = (size_t)HALF * g.lda * 2, hstepB = (size_t)HALF * g.ldb * 2;
    const size_t tstepA = 2 * hstepA, tstepB = 2 * hstepB;
    const unsigned ldsw = (unsigned)wid * 1024u;
    const int aoff = lds_byte(wr * 64 + fr, fq * 8), boff = lds_byte(wc * 32 + fr, fq * 8);
#define PG8_SA(b, h) (((b) * 2 + (h)) * HTB)
#define PG8_SB(b, h) ((4 + (b) * 2 + (h)) * HTB)
#define PG8_STAGE(bufoff, gbase, voff) do { _Pragma("unroll") for (int _i = 0; _i < 2; ++_i) \
        __builtin_amdgcn_global_load_lds((const unsigned*)((const char*)(gbase) + (voff)[_i]), (LAS unsigned*)(lds + (bufoff) + ldsw + _i * 8192), 16, 0, 0); } while (0)
#define PG8_LDA(dst, b, h) do { _Pragma("unroll") for (int m = 0; m < 4; ++m) _Pragma("unroll") for (int k = 0; k < 2; ++k) dst[m][k] = *(const LAS bf16x8*)(lds + PG8_SA(b, h) + aoff + m * 2048 + k * 1024); } while (0)
#define PG8_LDB(dst, b, h) do { _Pragma("unroll") for (int n = 0; n < 2; ++n) _Pragma("unroll") for (int k = 0; k < 2; ++k) dst[n][k] = *(const LAS bf16x8*)(lds + PG8_SB(b, h) + boff + n * 2048 + k * 1024); } while (0)
#define PG8_MMA(ai, bj, At, Bt) do { __builtin_amdgcn_s_setprio(1); _Pragma("unroll") for (int m = 0; m < 4; ++m) _Pragma("unroll") for (int n = 0; n < 2; ++n) _Pragma("unroll") for (int k = 0; k < 2; ++k) \
        acc[ai][bj][m][n] = __builtin_amdgcn_mfma_f32_16x16x32_bf16(Bt[n][k], At[m][k], acc[ai][bj][m][n], 0, 0, 0); __builtin_amdgcn_s_setprio(0); } while (0)
#define PG8_WAIT_V(n) asm volatile("s_waitcnt vmcnt(" #n ")" ::: "memory")
#define PG8_WAIT_L(n) asm volatile("s_waitcnt lgkmcnt(" #n ")" ::: "memory")
#define PG8_BAR __builtin_amdgcn_s_barrier()
#define PG8_SCHED __builtin_amdgcn_sched_barrier(0)
    Unit cur, nxt; int ui = 0;
    if (!S.next(0, cur)) return;
    f32x4 acc[2][2][4][2];
#pragma unroll
    for (int a = 0; a < 2; ++a)
#pragma unroll
        for (int b = 0; b < 2; ++b)
#pragma unroll
            for (int m = 0; m < 4; ++m)
#pragma unroll
                for (int n = 0; n < 2; ++n) acc[a][b][m][n] = (f32x4){0.f, 0.f, 0.f, 0.f};
    bf16x8 At[4][2], B0[2][2], B1[2][2];
    const char* cA = (const char*)g.A + (size_t)cur.pm * tstepA + (size_t)cur.pn * g.a_pn_koff * 2; const char* cB = (const char*)g.Bt + (size_t)cur.pn * tstepB;
    PG8_STAGE(PG8_SB(0, 0), cB, voffB); PG8_STAGE(PG8_SB(0, 1), cB + hstepB, voffB); PG8_STAGE(PG8_SA(0, 0), cA, voffA); PG8_STAGE(PG8_SA(0, 1), cA + hstepA, voffA);
    if (wr == 1) PG8_BAR;
    PG8_WAIT_V(2); PG8_BAR;
    PG8_STAGE(PG8_SB(1, 0), cB + kstep, voffB); PG8_STAGE(PG8_SA(1, 0), cA + kstep, voffA); PG8_STAGE(PG8_SB(1, 1), cB + hstepB + kstep, voffB);
    PG8_WAIT_V(6); PG8_BAR;
    for (;;) {
        const bool has_next = S.next(ui + 1, nxt);
        const char* nA = has_next ? (const char*)g.A + (size_t)nxt.pm * tstepA + (size_t)nxt.pn * g.a_pn_koff * 2 : cA; const char* nB = has_next ? (const char*)g.Bt + (size_t)nxt.pn * tstepB : cB;
        asm volatile("" : "+s"(nA), "+s"(nB));
        for (int t = 0; t < nt; t += 2) {
            const bool last = (t == nt - 2);
            const char* a1 = cA + (size_t)(t + 1) * kstep;
            const char* a2 = last ? nA : cA + (size_t)(t + 2) * kstep; const char* b2 = last ? nB : cB + (size_t)(t + 2) * kstep;
            const char* a3 = a2 + kstep; const char* b3 = b2 + kstep;
            PG8_LDB(B0, 0, 0); PG8_LDB(B1, 0, 1); PG8_SCHED; PG8_LDA(At, 0, 0); PG8_STAGE(PG8_SA(1, 1), a1 + hstepA, voffA);
            PG8_WAIT_V(8); PG8_WAIT_L(0); PG8_BAR; PG8_MMA(0, 0, At, B0); PG8_MMA(0, 1, At, B1); PG8_BAR; PG8_SCHED;
            PG8_LDA(At, 0, 1); PG8_STAGE(PG8_SB(0, 0), b2, voffB); PG8_STAGE(PG8_SB(0, 1), b2 + hstepB, voffB); PG8_STAGE(PG8_SA(0, 0), a2, voffA);
            PG8_WAIT_V(8); PG8_WAIT_L(0); PG8_BAR; PG8_MMA(1, 0, At, B0); PG8_MMA(1, 1, At, B1); PG8_BAR; PG8_SCHED;
            PG8_LDB(B0, 1, 0); PG8_LDB(B1, 1, 1); PG8_SCHED; PG8_LDA(At, 1, 0); PG8_STAGE(PG8_SA(0, 1), a2 + hstepA, voffA);
            PG8_WAIT_V(8); PG8_WAIT_L(0); PG8_BAR; PG8_MMA(0, 0, At, B0); PG8_MMA(0, 1, At, B1); PG8_BAR; PG8_SCHED;
            PG8_LDA(At, 1, 1); PG8_STAGE(PG8_SB(1, 0), b3, voffB); PG8_STAGE(PG8_SB(1, 1), b3 + hstepB, voffB); PG8_STAGE(PG8_SA(1, 0), a3, voffA);
            PG8_WAIT_V(8); PG8_WAIT_L(0); PG8_BAR; PG8_MMA(1, 0, At, B0); PG8_MMA(1, 1, At, B1); PG8_BAR; PG8_SCHED;
        }
        if constexpr (ALIGN_EPI) { if (wr == 0) PG8_BAR; }
        { const int t2 = fresh_tid(wv), w2 = __builtin_amdgcn_readfirstlane(t2 >> 6), l2 = t2 & 63; E(acc, cur, w2 >> 2, w2 & 3, l2 & 15, l2 >> 4); }
        if (!has_next) break;
#pragma unroll
        for (int a = 0; a < 2; ++a)
#pragma unroll
            for (int b = 0; b < 2; ++b)
#pragma unroll
                for (int m = 0; m < 4; ++m)
#pragma unroll
                    for (int n = 0; n < 2; ++n) acc[a][b][m][n] = (f32x4){0.f, 0.f, 0.f, 0.f};
        cur = nxt; cA = nA; cB = nB; ++ui;
        if constexpr (ALIGN_EPI) { if (wr == 1) PG8_BAR; }
    }
    PG8_WAIT_V(0);
    if constexpr (!ALIGN_EPI) { if (wr == 0) PG8_BAR; }
    PG8_BAR;
#undef PG8_SA
#undef PG8_SB
#undef PG8_STAGE
#undef PG8_LDA
#undef PG8_LDB
#undef PG8_MMA
#undef PG8_WAIT_V
#undef PG8_WAIT_L
#undef PG8_BAR
#undef PG8_SCHED
}
}

namespace att {
constexpr int D = 128, LD = 1024;
constexpr float SCALE = 0.08838834764831845f;
constexpr float THR = 8.f;
constexpr int NW = 8, QBLK = 32, KVBLK = 64, QB = NW * QBLK;
constexpr int SHM_V = KVBLK * D * 2, SHM_K = KVBLK * D * 2;
constexpr int OFF_WS = 2 * SHM_V + 2 * SHM_K, OFF_BIAS = OFF_WS + NW * 64 * 4, LDS_BYTES = OFF_BIAS + 512;
typedef bf16_t bf16;
#define KSWZ(row, colB) ((row) * 256 + ((colB) ^ (((row) & 7) << 4)))
#define SBAR() __builtin_amdgcn_sched_barrier(0)
__device__ __forceinline__ int v_st(int k, int c) { const int kk = (k & ~0xC) | ((k & 4) << 1) | ((k & 8) >> 1); return ((kk >> 3) * 4 + (c >> 5)) * 512 + ((kk & 7) * 32 + (c & 31)) * 2; }
__device__ __forceinline__ int v_rd_base(int lane) { return ((lane & 3) << 3) | (((lane >> 2) & 3) << 6) | (((lane >> 4) & 1) << 5) | (((lane >> 5) & 1) << 8); }
constexpr int v_rd_off(int d0, int ks, int half) { return d0 * 512 + ks * 4096 + half * 2048; }
__device__ __forceinline__ int crow(int r, int hi) { return (r & 3) + 8 * (r >> 2) + 4 * hi; }
__device__ __forceinline__ unsigned cvtpk(float lo, float hi) { unsigned r; asm volatile("v_cvt_pk_bf16_f32 %0, %1, %2" : "=v"(r) : "v"(lo), "v"(hi)); return r; }
__device__ __forceinline__ bf16x8 load8(const bf16* p) { return *reinterpret_cast<const bf16x8*>(p); }
__device__ __forceinline__ void mask_tile(f32x16& p0, f32x16& p1, int dq, unsigned W) {
    const float NEG = -__builtin_inff();
#pragma unroll
    for (int r = 0; r < 16; ++r) {
        const int c = (r & 3) + 8 * (r >> 2);
        if ((unsigned)(dq - c) >= W) p0[r] = NEG;
        if ((unsigned)(dq - c - 32) >= W) p1[r] = NEG;
    }
}
__device__ __forceinline__ void partialSM(f32x16& p0, f32x16& p1, float& m_reg, float& mn, float& alpha) {
    float pmax = p0[0]; for (int r = 1; r < 16; ++r) pmax = fmaxf(pmax, p0[r]); for (int r = 0; r < 16; ++r) pmax = fmaxf(pmax, p1[r]);
    { auto rr = __builtin_amdgcn_permlane32_swap(__float_as_uint(pmax), __float_as_uint(pmax), false, false);
      pmax = fmaxf(__uint_as_float(rr[0]), __uint_as_float(rr[1])); }
    constexpr float C2 = 1.4426950408889634f * SCALE;
    if (__builtin_expect(__all((pmax - m_reg) * SCALE <= THR), 1)) { mn = m_reg; alpha = 1.f; }
    else { mn = fmaxf(m_reg, pmax); alpha = __builtin_amdgcn_exp2f((m_reg - mn) * C2); m_reg = mn; }
    const float mnL = -mn * C2;
    for (int r = 0; r < 16; ++r) p0[r] = fmaf(p0[r], C2, mnL); for (int r = 0; r < 16; ++r) p1[r] = fmaf(p1[r], C2, mnL);
    for (int r = 0; r < 16; ++r) p0[r] = __builtin_amdgcn_exp2f(p0[r]);
}
__device__ __forceinline__ void finishSM(f32x16& p0, f32x16& p1, float alpha, float& l_reg, bf16x8& pa0, bf16x8& pa1, bf16x8& pa2, bf16x8& pa3) {
    for (int r = 0; r < 16; ++r) p1[r] = __builtin_amdgcn_exp2f(p1[r]);
    float ps = 0; for (int r = 0; r < 16; ++r) ps += p0[r]; for (int r = 0; r < 16; ++r) ps += p1[r];
    { auto rr = __builtin_amdgcn_permlane32_swap(__float_as_uint(ps), __float_as_uint(ps), false, false);
      ps = __uint_as_float(rr[0]) + __uint_as_float(rr[1]); }
    l_reg = l_reg * alpha + ps;
#define PK4(P, B_, OUT) do { unsigned a0 = cvtpk(P[B_+0], P[B_+1]), a1 = cvtpk(P[B_+2], P[B_+3]);                          \
        unsigned b0 = cvtpk(P[B_+4], P[B_+5]), b1 = cvtpk(P[B_+6], P[B_+7]);                                             \
        auto r0 = __builtin_amdgcn_permlane32_swap(a0, b0, false, false); auto r1 = __builtin_amdgcn_permlane32_swap(a1, b1, false, false); \
        u32x4 w = {r0[0], r1[0], r0[1], r1[1]}; OUT = *reinterpret_cast<bf16x8*>(&w); } while (0)
    PK4(p0, 0, pa0); PK4(p0, 8, pa1); PK4(p1, 0, pa2); PK4(p1, 8, pa3);
#undef PK4
}
template <int KB>
__device__ __forceinline__ void qkt(f32x16& p0, f32x16& p1, const char* K_lds, const char* B_lds, int r32, int hi, const bf16x8* qr) {
    const f32x4* bp = (const f32x4*)(B_lds + KB * 256 + hi * 16);
#pragma unroll
    for (int i = 0; i < 4; ++i) { const f32x4 a = bp[2 * i], b = bp[8 + 2 * i];
        p0[4 * i] = a[0]; p0[4 * i + 1] = a[1]; p0[4 * i + 2] = a[2]; p0[4 * i + 3] = a[3];
        p1[4 * i] = b[0]; p1[4 * i + 1] = b[1]; p1[4 * i + 2] = b[2]; p1[4 * i + 3] = b[3]; }
    const char* kb[4];
#pragma unroll
    for (int dd = 0; dd < 4; ++dd) kb[dd] = K_lds + KB * SHM_K + KSWZ(r32, (dd * 16 + hi * 8) * 2);
#pragma unroll
    for (int d0 = 0; d0 < 8; ++d0) { const char* a = kb[d0 & 3] + (d0 >> 2) * 128;
        bf16x8 b0 = *reinterpret_cast<const bf16x8*>(a);
        bf16x8 b1 = *reinterpret_cast<const bf16x8*>(a + 32 * 256);
        p0 = __builtin_amdgcn_mfma_f32_32x32x16_bf16(b0, qr[d0], p0, 0, 0, 0);
        p1 = __builtin_amdgcn_mfma_f32_32x32x16_bf16(b1, qr[d0], p1, 0, 0, 0); }
}
template <int VB>
__device__ __forceinline__ void pv_tile(f32x16* o, int vb0, bf16x8 pa0, bf16x8 pa1, bf16x8 pa2, bf16x8 pa3) {
#define TRRD(dst, off) asm volatile("ds_read_b64_tr_b16 %0, %1 offset:%2" : "=&v"(dst) : "v"(vb0), "i"(off) : "memory")
#define PV_D0(d0) do { s16x4 l0, l1, l2, l3, h0, h1, h2, h3; constexpr int b_ = VB * SHM_V + v_rd_off(d0, 0, 0); \
        TRRD(l0, b_); TRRD(h0, b_ + 2048); TRRD(l1, b_ + 4096); TRRD(h1, b_ + 6144); TRRD(l2, b_ + 8192); TRRD(h2, b_ + 10240); TRRD(l3, b_ + 12288); TRRD(h3, b_ + 14336); \
        asm volatile("s_waitcnt lgkmcnt(0)" ::: "memory"); SBAR();   \
        o[d0] = __builtin_amdgcn_mfma_f32_32x32x16_bf16(pa0, (bf16x8){l0[0], l0[1], l0[2], l0[3], h0[0], h0[1], h0[2], h0[3]}, o[d0], 0, 0, 0);   \
        o[d0] = __builtin_amdgcn_mfma_f32_32x32x16_bf16(pa1, (bf16x8){l1[0], l1[1], l1[2], l1[3], h1[0], h1[1], h1[2], h1[3]}, o[d0], 0, 0, 0);   \
        o[d0] = __builtin_amdgcn_mfma_f32_32x32x16_bf16(pa2, (bf16x8){l2[0], l2[1], l2[2], l2[3], h2[0], h2[1], h2[2], h2[3]}, o[d0], 0, 0, 0);   \
        o[d0] = __builtin_amdgcn_mfma_f32_32x32x16_bf16(pa3, (bf16x8){l3[0], l3[1], l3[2], l3[3], h3[0], h3[1], h3[2], h3[3]}, o[d0], 0, 0, 0); } while (0)
    PV_D0(0); PV_D0(1); PV_D0(2); PV_D0(3);
#undef PV_D0
#undef TRRD
}
struct BlockRef { const bf16* Q; const bf16* K; const bf16* V; const float* FB; bf16* O; int P0; };
struct Seam { bf16x8 qr[8]; bf16x8 st_v0, st_v1, st_k0, st_k1; float st_b; };
#define ROW(p, k0, rr) ((p) + (size_t)((k0) + (rr)) * LD + sc)
#define VMW() asm volatile("s_waitcnt vmcnt(0)" ::: "memory")
#define VMWN(n) asm volatile("s_waitcnt vmcnt(%0)" :: "i"(n) : "memory")
#define SLOAD_H(Kp, Vp, Fp, k0) do { S.st_v0 = load8(ROW(Vp, k0, sr)); S.st_v1 = load8(ROW(Vp, k0, 32 + sr));              \
                         S.st_k0 = load8(ROW(Kp, k0, sr)); S.st_k1 = load8(ROW(Kp, k0, 32 + sr)); S.st_b = (Fp)[(k0) + (tid & 63)]; } while (0)
#define SWRITE_HK(bf) do { *(bf16x8*)(K_lds + (bf) * SHM_K + kws) = S.st_k0; *(bf16x8*)(K_lds + (bf) * SHM_K + kws + 32 * 256) = S.st_k1; \
                           if (tid < 64) ((float*)B_lds)[(bf) * 64 + tid] = S.st_b; } while (0)
#define SWRITE_HV(bf) do { *(bf16x8*)(V_lds + (bf) * SHM_V + vst0) = S.st_v0; *(bf16x8*)(V_lds + (bf) * SHM_V + vst1) = S.st_v1; } while (0)
#define SWRITE_H(bf) do { SWRITE_HV(bf); SWRITE_HK(bf); } while (0)
__device__ __forceinline__ void prime(const BlockRef& cur, char* lds, Seam& S, int wv) {
    const int tid = fresh_tid(wv), wid = __builtin_amdgcn_readfirstlane(tid >> 6), lane = tid & 63, r32 = lane & 31, hi = lane >> 5;
    const int sr = tid >> 4, sc = (tid & 15) * 8, kws = KSWZ(sr, sc * 2); char* K_lds = lds + 2 * SHM_V; char* B_lds = lds + OFF_BIAS;
    for (int d0 = 0; d0 < 8; ++d0) S.qr[d0] = load8(cur.Q + (size_t)(wid * QBLK + r32) * LD + d0 * 16 + hi * 8);
    SLOAD_H(cur.K, cur.V, cur.FB, 0); VMW(); SWRITE_HK(0);
    __syncthreads();
}
__device__ __forceinline__ void block(const BlockRef& cur, const BlockRef& nxt, char* lds, Seam& S, int wv) {
    const int tid = fresh_tid(wv), wid = __builtin_amdgcn_readfirstlane(tid >> 6), lane = tid & 63, r32 = lane & 31, hi = lane >> 5;
    constexpr unsigned W = 1u << 30;
    const int NT = (cur.P0 + QB - 1) / KVBLK + 1;
    const int qlo = cur.P0 + wid * QBLK, qm = qlo + r32 - 4 * hi;
    char* V_lds = lds; char* K_lds = lds + 2 * SHM_V; char* B_lds = lds + OFF_BIAS;
    float* ws = (float*)(lds + OFF_WS) + wid * 64; float* li_l = ws, * al_l = ws + 32;
    float m_reg = -1e30f, l_reg = 0; f32x16 o[4] = {};
    const int sr = tid >> 4, sc = (tid & 15) * 8, vst0 = v_st(sr, sc), vst1 = v_st(32 + sr, sc), kws = KSWZ(sr, sc * 2);
    const int vb0 = (int)(uintptr_t)V_lds + v_rd_base(lane);
    const bf16* Kh = cur.K; const bf16* Vh = cur.V; const float* Fh = cur.FB;
#define RESC(a) do { if (__any((a) < 1.f)) { if (hi == 0) al_l[r32] = (a); asm volatile("s_waitcnt lgkmcnt(0)" ::: "memory");              \
                     for (int d_ = 0; d_ < 4; ++d_) for (int r = 0; r < 16; ++r) o[d_][r] *= al_l[crow(r, hi)]; } } while (0)
#define KBASE(t) ((t) * KVBLK)
#define MASKT(P0_, P1_, t) do { const int kb_ = KBASE(t); if (kb_ + KVBLK - 1 > qlo) mask_tile(P0_, P1_, qm - kb_, W); } while (0)
    constexpr int NQL = 8;
#define SEAM_K0() do { VMWN(NQL); SWRITE_HK(0); SBAR(); } while (0)
    f32x16 pA0, pA1, pB0, pB1; float mnA, mnB, alA, alB; bf16x8 pa0, pa1, pa2, pa3;
    SWRITE_HV(0); SBAR();
    if (NT > 1) SLOAD_H(Kh, Vh, Fh, KBASE(1));
    SBAR(); qkt<0>(pA0, pA1, K_lds, B_lds, r32, hi, S.qr);
    MASKT(pA0, pA1, 0); partialSM(pA0, pA1, m_reg, mnA, alA);
    if (NT > 1) { VMW(); SWRITE_H(1); }
    __syncthreads();
#define HALF_STEP(PX0, PX1, mnX, alX, PY0, PY1, alY, t, KB, VB, SB) do {                                                      \
        SBAR(); qkt<KB>(PX0, PX1, K_lds, B_lds, r32, hi, S.qr);                                                               \
        finishSM(PY0, PY1, alY, l_reg, pa0, pa1, pa2, pa3); SBAR();                                                           \
        if ((t) + 1 < NT) { SLOAD_H(Kh, Vh, Fh, KBASE((t) + 1)); SBAR(); }                                                    \
        pv_tile<VB>(o, vb0, pa0, pa1, pa2, pa3); MASKT(PX0, PX1, (t)); partialSM(PX0, PX1, m_reg, mnX, alX);                  \
        __syncthreads();                                                                                                      \
        if ((t) + 1 < NT) { VMW(); SWRITE_H(SB); }                                                                            \
        RESC(alX); __syncthreads(); } while (0)
    for (int t = 1; t + 1 < NT; t += 2) {
        HALF_STEP(pB0, pB1, mnB, alB, pA0, pA1, alA, t, 1, 0, 0);
        HALF_STEP(pA0, pA1, mnA, alA, pB0, pB1, alB, t + 1, 0, 1, 1);
    }
    const bool even = (NT & 1) == 0;
    if (even) { SBAR(); qkt<1>(pB0, pB1, K_lds, B_lds, r32, hi, S.qr); SBAR(); }
    SLOAD_H(nxt.K, nxt.V, nxt.FB, 0); SBAR();
#pragma unroll
    for (int d0 = 0; d0 < 8; ++d0) S.qr[d0] = load8(nxt.Q + (size_t)(wid * QBLK + r32) * LD + d0 * 16 + hi * 8);
    SBAR();
    finishSM(pA0, pA1, alA, l_reg, pa0, pa1, pa2, pa3); SBAR();
    pv_tile<0>(o, vb0, pa0, pa1, pa2, pa3);
    if (even) { MASKT(pB0, pB1, NT - 1); partialSM(pB0, pB1, m_reg, mnB, alB); __syncthreads(); RESC(alB);
        finishSM(pB0, pB1, alB, l_reg, pa0, pa1, pa2, pa3); SBAR(); pv_tile<1>(o, vb0, pa0, pa1, pa2, pa3); }
    SBAR(); SEAM_K0();
    if (hi == 0) li_l[r32] = l_reg; asm volatile("s_waitcnt lgkmcnt(0)" ::: "memory");
    float rli[16];
#pragma unroll
    for (int r = 0; r < 16; ++r) rli[r] = __builtin_amdgcn_rcpf(li_l[crow(r, hi)]);
    bf16* Ow = cur.O + (size_t)(wid * QBLK) * LD;
#pragma unroll
    for (int r = 0; r < 16; ++r) { const int orow = crow(r, hi);
#pragma unroll
        for (int d0 = 0; d0 < 4; ++d0) { const float v = o[d0][r] * rli[r];
            const float vn = __shfl_xor(v, 1);
            if ((r32 & 1) == 0) *(unsigned*)(Ow + (size_t)orow * LD + d0 * 32 + r32) = cvtpk(v, vn); } }
    __syncthreads();
#undef RESC
#undef KBASE
#undef MASKT
#undef SEAM_K0
#undef HALF_STEP
}
#undef ROW
#undef VMW
#undef VMWN
#undef SLOAD_H
#undef SWRITE_HK
#undef SWRITE_HV
#undef SWRITE_H
#undef SBAR
#undef KSWZ
}

#define XB_TMO      128
#define XB_XCNT(j)  (256  + 64 * (j))
#define XB_XSUB(j)  (1280 + 64 * (j))
#define XB_XGEN(j)  (2304 + 64 * (j))
#define XB_TOP      3328
#define XB_TOPGEN   3392
#define XCD_BAR_WORDS 3456
#define XB_SPIN_CAP (1u << 18)
__device__ __forceinline__ unsigned xb_ld(unsigned* p)              { return __hip_atomic_load(p, __ATOMIC_RELAXED, __HIP_MEMORY_SCOPE_AGENT); }
__device__ __forceinline__ unsigned xb_add(unsigned* p, unsigned v) { return __hip_atomic_fetch_add(p, v, __ATOMIC_RELAXED, __HIP_MEMORY_SCOPE_AGENT); }
__device__ __forceinline__ unsigned xb_xcc_id() { return (unsigned)__builtin_amdgcn_s_getreg((3 << 11) | 20) & 0xFu; }
#define XB_SPIN(cond, bar) do { unsigned _sp = 0; while (cond) { __builtin_amdgcn_s_sleep(1); \
    if ((++_sp & 255u) == 0u) { if (xb_ld(&(bar)[XB_TMO])) break; if (_sp > XB_SPIN_CAP) { atomicAdd(&(bar)[XB_TMO], 1u); break; } } } } while (0)
struct XcdBarrier { unsigned* bar; unsigned x; volatile LAS unsigned* st; };
__device__ __forceinline__ XcdBarrier xcd_barrier_post(unsigned* bar, volatile LAS unsigned* st, int tid) {
    XcdBarrier b; b.bar = bar; b.x = xb_xcc_id(); b.st = st;
    if (tid == 0) (void)xb_add(&bar[XB_XCNT(b.x)], 1u);
    return b;
}
__device__ __forceinline__ void xcd_barrier_complete(unsigned* bar, unsigned x, unsigned& nloc, unsigned& nx) {
    const unsigned G = gridDim.x * gridDim.y * gridDim.z;
    unsigned sum, cnt, mine, sp = 0u;
    for (;;) {
        sum = 0u; cnt = 0u; mine = 0u;
#pragma unroll
        for (unsigned j = 0; j < 16; ++j) { const unsigned c = xb_ld(&bar[XB_XCNT(j)]); sum += c; cnt += (c > 0u) ? 1u : 0u; mine = (j == x) ? c : mine; }
        if (sum == G) break;
        __builtin_amdgcn_s_sleep(1);
        if ((++sp & 255u) == 0u) { if (xb_ld(&bar[XB_TMO])) break; if (sp > XB_SPIN_CAP) { atomicAdd(&bar[XB_TMO], 1u); break; } }
    }
    nloc = mine > 0u ? mine : 1u; nx = cnt > 0u ? cnt : 1u;
}
__device__ __forceinline__ void xcd_barrier(const XcdBarrier& b, int tid) {
    asm volatile("s_waitcnt vmcnt(0)" ::: "memory");
    __syncthreads();
    if (tid == 0) {
        unsigned* bar = b.bar;
        __builtin_amdgcn_s_waitcnt(0);
        unsigned nloc = b.st[0], nx = b.st[1];
        if (nloc == 0u) { xcd_barrier_complete(bar, b.x, nloc, nx); b.st[0] = nloc; b.st[1] = nx; }
        const unsigned old = xb_add(&bar[XB_XSUB(b.x)], 1u);
        const unsigned gen = old / nloc;
        if (old + 1u == (gen + 1u) * nloc) {
            __builtin_amdgcn_fence(__ATOMIC_RELEASE, "agent");
            asm volatile("s_waitcnt vmcnt(0)" ::: "memory");
            const unsigned og = xb_add(&bar[XB_TOP], 1u);
            const unsigned tg = og / nx;
            if (og + 1u == (tg + 1u) * nx) xb_add(&bar[XB_TOPGEN], 1u);
            else XB_SPIN(xb_ld(&bar[XB_TOPGEN]) == tg, bar);
            __builtin_amdgcn_fence(__ATOMIC_ACQUIRE, "agent");
            xb_add(&bar[XB_XGEN(b.x)], 1u);
            asm volatile("s_waitcnt vmcnt(0)" ::: "memory");
        } else {
            XB_SPIN(xb_ld(&bar[XB_XGEN(b.x)]) == gen, bar);
            __builtin_amdgcn_fence(__ATOMIC_ACQUIRE, "agent");
            asm volatile("s_waitcnt vmcnt(0)" ::: "memory");
        }
    }
    __syncthreads();
}

#ifndef PROBE_PHASE
#define PROBE_PHASE -1
#endif
#ifndef PROBE_TS
#define PROBE_TS -1
#endif
#ifndef PROBE_OFF
#define PROBE_OFF 0
#endif
#ifndef PROBE_TSB
#define PROBE_TSB (PROBE_TS + 1)
#endif
#define PH(id) for (int rep_ = 0; rep_ < ((PROBE_PHASE == (id)) ? 2 : 1); ++rep_)
constexpr int NWAVES = 8, NTHREADS = 512;
constexpr int LDS_BYTES = 147456;
struct Args { const float* in[19]; float* out; unsigned char* ws; };
enum { I_X = 0, I_P, I_GPREMIX, I_WIN, I_BF, I_WPOOL, I_POOLSCALE, I_GPOOLOUT, I_GATTNOUT, I_WOUT, I_GPOSTMIX, I_GPREMLP, I_WUP, I_WDOWN, I_GPOSTMLP, I_GPLEGATE, I_WGATE, I_WPLE, I_GPOSTPLE };

constexpr int TR_PITCH = 68, TR_BYTES = 64 * TR_PITCH * 4;
__device__ __forceinline__ void p0_transpose_item(const float* W, int K, int N, int ldw, bf16_t* WT, int row_off, LAS float* scr, int item, int lane) {
    const int nkb = K / 64, kb = item % nkb, nb = item / nkb, k0 = 64 * kb, n0 = 64 * nb; (void)N;
    f32x4 v[16];
    const float* src = W + (size_t)(k0 + (lane >> 4)) * ldw + n0 + 4 * (lane & 15);
#pragma unroll
    for (int i = 0; i < 16; ++i) v[i] = __builtin_nontemporal_load((const f32x4*)(src + (size_t)(4 * i) * ldw));
#pragma unroll
    for (int i = 0; i < 16; ++i) *(LAS f32x4*)(scr + (4 * i + (lane >> 4)) * TR_PITCH + 4 * (lane & 15)) = v[i];
    asm volatile("s_waitcnt lgkmcnt(0)" ::: "memory");
    const int c = lane >> 3;
#pragma unroll
    for (int j = 0; j < 8; ++j) { const int n = (lane & 7) + 8 * j; const LAS float* sp = scr + (8 * c) * TR_PITCH + n;
        u32x4 o; o.x = cvt_pk_bf16(sp[0 * TR_PITCH], sp[1 * TR_PITCH]); o.y = cvt_pk_bf16(sp[2 * TR_PITCH], sp[3 * TR_PITCH]);
        o.z = cvt_pk_bf16(sp[4 * TR_PITCH], sp[5 * TR_PITCH]); o.w = cvt_pk_bf16(sp[6 * TR_PITCH], sp[7 * TR_PITCH]);
        *(u32x4*)(WT + (size_t)(row_off + n0 + n) * K + k0 + 8 * c) = o; }
    asm volatile("s_waitcnt lgkmcnt(0)" ::: "memory");
}

template <bool BIN, bool BOUT>
__device__ __forceinline__ void resnorm_phase(const void* base, const bf16_t* raw, const float* g_post, void* outp, const float* g_next, bf16_t* hn, int gw, int NGW, int lane) {
    u32x2 nraw[8]; f32x4 nbf[8]; u32x2 nbh[8];
#define RN_LOAD(mm) do { const u32x2* rp_ = (const u32x2*)(raw + (size_t)(mm) * DM) + lane; \
        _Pragma("unroll") for (int j = 0; j < 8; ++j) nraw[j] = rp_[64 * j]; \
        if (BIN) { const u32x2* bp_ = (const u32x2*)((const bf16_t*)base + (size_t)(mm) * DM) + lane; _Pragma("unroll") for (int j = 0; j < 8; ++j) nbh[j] = bp_[64 * j]; } \
        else { const f32x4* bp_ = (const f32x4*)((const float*)base + (size_t)(mm) * DM) + lane; _Pragma("unroll") for (int j = 0; j < 8; ++j) nbf[j] = __builtin_nontemporal_load(bp_ + 64 * j); } } while (0)
    int m = gw; if (m < M) RN_LOAD(m);
    for (; m < M; m += NGW) {
        f32x4 r[8], b[8]; float ss = 0.f;
#pragma unroll
        for (int j = 0; j < 8; ++j) { r[j] = (f32x4){bf_lo(nraw[j].x), bf_hi(nraw[j].x), bf_lo(nraw[j].y), bf_hi(nraw[j].y)};
            if (BIN) b[j] = (f32x4){bf_lo(nbh[j].x), bf_hi(nbh[j].x), bf_lo(nbh[j].y), bf_hi(nbh[j].y)}; else b[j] = nbf[j];
            ss += (r[j].x * r[j].x + r[j].y * r[j].y) + (r[j].z * r[j].z + r[j].w * r[j].w); }
        asm volatile("" ::: "memory");
        if (m + NGW < M) RN_LOAD(m + NGW);
        const float rs = 1.0f / sqrtf(wave_sum(ss) * (1.f / DM) + EPS);
        float ss2 = 0.f;
#pragma unroll
        for (int j = 0; j < 8; ++j) { const f32x4 g = *((const f32x4*)g_post + lane + 64 * j);
            r[j] = b[j] + r[j] * rs * g;
            if (BOUT) { u32x2 w; w.x = cvt_pk_bf16(r[j].x, r[j].y); w.y = cvt_pk_bf16(r[j].z, r[j].w); *((u32x2*)((bf16_t*)outp + (size_t)m * DM) + lane + 64 * j) = w; }
            else *((f32x4*)((float*)outp + (size_t)m * DM) + lane + 64 * j) = r[j];
            ss2 += (r[j].x * r[j].x + r[j].y * r[j].y) + (r[j].z * r[j].z + r[j].w * r[j].w); }
        if (g_next) {
            const float rs2 = 1.0f / sqrtf(wave_sum(ss2) * (1.f / DM) + EPS);
#pragma unroll
            for (int j = 0; j < 8; ++j) { const f32x4 g = *((const f32x4*)g_next + lane + 64 * j); const f32x4 h = r[j] * rs2 * g;
                u32x2 w; w.x = cvt_pk_bf16(h.x, h.y); w.y = cvt_pk_bf16(h.z, h.w); *((u32x2*)(hn + (size_t)m * DM) + lane + 64 * j) = w; }
        }
    }
#undef RN_LOAD
}
__device__ __forceinline__ void ynorm_phase(const bf16_t* yp, const bf16_t* ya, const float* gp, const float* ga, bf16_t* y, int gw, int NGW, int lane) {
    u32x4 np[2], na[2];
#define YN_LOAD(mm) do { _Pragma("unroll") for (int j = 0; j < 2; ++j) { np[j] = *((const u32x4*)(yp + (size_t)(mm) * 1024) + lane + 64 * j); na[j] = *((const u32x4*)(ya + (size_t)(mm) * 1024) + lane + 64 * j); } } while (0)
    int m = gw; if (m < M) YN_LOAD(m);
    for (; m < M; m += NGW) {
        float v[2][2][8]; float ss0 = 0.f, ss1 = 0.f;
#pragma unroll
        for (int j = 0; j < 2; ++j) { const u32x4 w = np[j], q = na[j];
            v[0][j][0] = bf_lo(w.x); v[0][j][1] = bf_hi(w.x); v[0][j][2] = bf_lo(w.y); v[0][j][3] = bf_hi(w.y); v[0][j][4] = bf_lo(w.z); v[0][j][5] = bf_hi(w.z); v[0][j][6] = bf_lo(w.w); v[0][j][7] = bf_hi(w.w);
            v[1][j][0] = bf_lo(q.x); v[1][j][1] = bf_hi(q.x); v[1][j][2] = bf_lo(q.y); v[1][j][3] = bf_hi(q.y); v[1][j][4] = bf_lo(q.z); v[1][j][5] = bf_hi(q.z); v[1][j][6] = bf_lo(q.w); v[1][j][7] = bf_hi(q.w);
#pragma unroll
            for (int e = 0; e < 8; ++e) { ss0 += v[0][j][e] * v[0][j][e]; ss1 += v[1][j][e] * v[1][j][e]; } }
        asm volatile("" ::: "memory");
        if (m + NGW < M) YN_LOAD(m + NGW);
        ss0 = wave_sum(ss0); ss1 = wave_sum(ss1);
        const float rs[2] = {1.0f / sqrtf(ss0 * (1.f / 1024.f) + EPS), 1.0f / sqrtf(ss1 * (1.f / 1024.f) + EPS)};
#pragma unroll
        for (int h = 0; h < 2; ++h) { const float* g = h ? ga : gp;
#pragma unroll
            for (int j = 0; j < 2; ++j) { const f32x4 g0 = *((const f32x4*)g + 2 * (lane + 64 * j)), g1 = *((const f32x4*)g + 2 * (lane + 64 * j) + 1); const float r_ = rs[h];
                u32x4 w; w.x = cvt_pk_bf16(v[h][j][0] * r_ * g0.x, v[h][j][1] * r_ * g0.y); w.y = cvt_pk_bf16(v[h][j][2] * r_ * g0.z, v[h][j][3] * r_ * g0.w);
                w.z = cvt_pk_bf16(v[h][j][4] * r_ * g1.x, v[h][j][5] * r_ * g1.y); w.w = cvt_pk_bf16(v[h][j][6] * r_ * g1.z, v[h][j][7] * r_ * g1.w);
                *((u32x4*)(y + (size_t)m * DM + h * 1024) + lane + 64 * j) = w; } }
    }
#undef YN_LOAD
}
__device__ __forceinline__ float log_sigmoid(float x) { return x < 0.f ? x - log1pf(expf(x)) : -log1pf(expf(-x)); }

__global__ void __launch_bounds__(NTHREADS, 2) mega_fwd(Args args) {
    extern __shared__ __attribute__((aligned(16))) unsigned char lds[];
    cg::grid_group grid = cg::this_grid();
    LAS unsigned char* ldsl = (LAS unsigned char*)lds;
    const int G = gridDim.x, bid = blockIdx.x, NGW = G * NWAVES;
    const int wave_s = __builtin_amdgcn_readfirstlane((int)(threadIdx.x >> 6));
#if PROBE_TS >= 0
#define STAMP(k) do { if (bid == 0 && fresh_tid(wave_s) == 0) { const unsigned long long t_ = __builtin_amdgcn_s_memrealtime(); MISC[16 + 2 * (k)] = (unsigned)t_; MISC[17 + 2 * (k)] = (unsigned)(t_ >> 32); } } while (0)
#else
#define STAMP(k) do {} while (0)
#endif
#define PHASE_IDS() const int tid = fresh_tid(wave_s), lane = tid & 63, wave = __builtin_amdgcn_readfirstlane(tid >> 6), gw = bid * NWAVES + wave; (void)lane; (void)gw
    unsigned char* ws = args.ws;
    unsigned* barw = (unsigned*)ws;
    volatile LAS unsigned* MISC = (volatile LAS unsigned*)(ldsl + LDS_BYTES - 256);
    { const int t0 = fresh_tid(wave_s); if (t0 < 64) MISC[t0] = 0u;
      if (t0 < 16 && bid * 16 + t0 < XCD_BAR_WORDS + 64) __hip_atomic_store(barw + bid * 16 + t0, 0u, __ATOMIC_RELAXED, __HIP_MEMORY_SCOPE_AGENT);
      __syncthreads(); }
    STAMP(0);
    const float* x = args.in[I_X];
    float* out = args.out;
    float* flog = (float*)(ws + WS_FLOG); float* fb = (float*)(ws + WS_FB);
    bf16_t* WinT = (bf16_t*)(ws + WS_WIN); bf16_t* WoutT = (bf16_t*)(ws + WS_WOUT); bf16_t* WupT = (bf16_t*)(ws + WS_WUP); bf16_t* WdownT = (bf16_t*)(ws + WS_WDOWN);
    bf16_t* WgateT = (bf16_t*)(ws + WS_WGATE); bf16_t* WpleT = (bf16_t*)(ws + WS_WPLE); bf16_t* WpoolT = (bf16_t*)(ws + WS_WPOOL);
    bf16_t* HN = (bf16_t*)(ws + WS_HN);
    bf16_t* U = (bf16_t*)(ws + AR_U); bf16_t* Qb = (bf16_t*)(ws + AR_Q); bf16_t* Kb = (bf16_t*)(ws + AR_K); bf16_t* Vb = (bf16_t*)(ws + AR_V);
    bf16_t* YP = (bf16_t*)(ws + AR_YP); bf16_t* YA = (bf16_t*)(ws + AR_YA); bf16_t* DP = (bf16_t*)(ws + AR_DP);
    bf16_t* Y = (bf16_t*)(ws + AR_Y); bf16_t* RAW1 = (bf16_t*)(ws + AR_RAW1); bf16_t* HID = (bf16_t*)(ws + AR_HID); bf16_t* Eb = (bf16_t*)((unsigned char*)args.out + 32 * MiB);
    bf16_t* RAW2 = (bf16_t*)(ws + WS_RAW2); bf16_t* PBF = (bf16_t*)(ws + WS_PBF);
    bf16_t* H1 = (bf16_t*)out;
    bf16_t* H2 = (bf16_t*)(ws + WS_ARENA + 32 * MiB);

    PH(0) {
    {
        PHASE_IDS();
        LAS float* wf = (LAS float*)ldsl;
        const float* w_in = args.in[I_WIN]; const float* gpm = args.in[I_GPREMIX];
        {
            f32x4 wa[4], wb[4]; float gk[4];
#pragma unroll
            for (int q = 0; q < 4; ++q) { const int k = tid + q * NTHREADS; const f32x4* wp = (const f32x4*)(w_in + (size_t)k * INW + 4096); wa[q] = wp[0]; wb[q] = wp[1]; gk[q] = gpm[k]; }
#pragma unroll
            for (int q = 0; q < 4; ++q) { const int k = tid + q * NTHREADS; const int l = (k & 255) >> 2, i = k & 3, j = k >> 8;
                LAS f32x4* dst = (LAS f32x4*)(wf + ((j * 4 + i) * 64 + l) * 8); dst[0] = wa[q] * gk[q]; dst[1] = wb[q] * gk[q]; }
        }
        __syncthreads();
        f32x4 nx[8];
        if (gw < M) {
#pragma unroll
            for (int j = 0; j < 8; ++j) nx[j] = __builtin_nontemporal_load((const f32x4*)(x + (size_t)gw * DM) + lane + 64 * j); }
        for (int m = gw; m < M; m += NGW) {
            f32x4 v[8]; float ss = 0.f;
#pragma unroll
            for (int j = 0; j < 8; ++j) { v[j] = nx[j]; ss += (v[j].x * v[j].x + v[j].y * v[j].y) + (v[j].z * v[j].z + v[j].w * v[j].w); }
            asm volatile("" ::: "memory");
            if (m + NGW < M) {
#pragma unroll
                for (int j = 0; j < 8; ++j) nx[j] = __builtin_nontemporal_load((const f32x4*)(x + (size_t)(m + NGW) * DM) + lane + 64 * j); }
            const float rs = 1.0f / sqrtf(wave_sum(ss) * (1.f / DM) + EPS);
            float fa[8] = {0.f, 0.f, 0.f, 0.f, 0.f, 0.f, 0.f, 0.f};
#pragma unroll
            for (int j = 0; j < 8; ++j)
#pragma unroll
                for (int i = 0; i < 4; ++i) { const LAS f32x4* wp = (const LAS f32x4*)(wf + ((j * 4 + i) * 64 + lane) * 8); const f32x4 w0 = wp[0], w1 = wp[1]; const float xv = v[j][i];
                    fa[0] += xv * w0.x; fa[1] += xv * w0.y; fa[2] += xv * w0.z; fa[3] += xv * w0.w; fa[4] += xv * w1.x; fa[5] += xv * w1.y; fa[6] += xv * w1.z; fa[7] += xv * w1.w; }
#pragma unroll
            for (int c = 0; c < 8; ++c) fa[c] = wave_sum(fa[c]) * rs;
            if (lane < 8) { float fv = fa[0];
#pragma unroll
                for (int c = 1; c < 8; ++c) fv = (lane == c) ? fa[c] : fv;
                flog[((size_t)(m >> 11) * NH + lane) * SEQ + (m & (SEQ - 1))] = log_sigmoid(fv + args.in[I_BF][lane]); }
            u32x2* o8 = (u32x2*)(HN + (size_t)m * DM) + lane;
#pragma unroll
            for (int j = 0; j < 8; ++j) { const f32x4 g = *((const f32x4*)gpm + lane + 64 * j); const f32x4 h = v[j] * rs * g;
                u32x2 w; w.x = cvt_pk_bf16(h.x, h.y); w.y = cvt_pk_bf16(h.z, h.w); o8[64 * j] = w; }
        }
        __syncthreads();
        LAS float* scr = (LAS float*)(ldsl + wave * TR_BYTES);
        constexpr int IT_IN = (DM / 64) * (4096 / 64), IT_POOL1 = (256 / 64) * (256 / 64);
        constexpr int IT_PLE = (PLE / 64) * (DM / 64);
        constexpr int NITEMS = IT_IN + 4 * IT_POOL1 + IT_PLE;
        for (int it = gw; it < NITEMS; it += NGW) {
            int r = it;
            if (r < IT_IN) { p0_transpose_item(args.in[I_WIN], DM, 4096, INW, WinT, 0, scr, r, lane); continue; } r -= IT_IN;
            if (r < IT_PLE) { p0_transpose_item(args.in[I_WPLE], PLE, DM, DM, WpleT, 0, scr, r, lane); continue; } r -= IT_PLE;
            { const int gi = r / IT_POOL1; p0_transpose_item(args.in[I_WPOOL] + (size_t)gi * 65536, 256, 256, 256, WpoolT, gi * 256, scr, r % IT_POOL1, lane); }
        }
        const float* p = args.in[I_P];
        for (int idx = bid * NTHREADS + tid; idx < M * PLE / 8; idx += G * NTHREADS) { const f32x4 a = __builtin_nontemporal_load((const f32x4*)p + 2 * idx), b = __builtin_nontemporal_load((const f32x4*)p + 2 * idx + 1);
            u32x4 w; w.x = cvt_pk_bf16(a.x, a.y); w.y = cvt_pk_bf16(a.z, a.w); w.z = cvt_pk_bf16(b.x, b.y); w.w = cvt_pk_bf16(b.z, b.w); *((u32x4*)PBF + idx) = w; }
    }
    grid.sync();
    }
    STAMP(1);
    const XcdBarrier bar = xcd_barrier_post(barw, MISC + 8, fresh_tid(wave_s));

#if PROBE_PHASE == 100
    for (int i_ = 0; i_ < 16; ++i_) xcd_barrier(bar, fresh_tid(wave_s));
#endif
    PH(1) {
    {
        { PHASE_IDS();
          if (bid < NB * NH && wave == 0) {
            const f32x4* fl = (const f32x4*)(flog + (size_t)bid * SEQ + 32 * lane); f32x4 v[8]; float run = 0.f;
#pragma unroll
            for (int j = 0; j < 8; ++j) v[j] = fl[j];
#pragma unroll
            for (int j = 0; j < 8; ++j) { v[j].x += run; v[j].y += v[j].x; v[j].z += v[j].y; v[j].w += v[j].z; run = v[j].w; }
            float incl = run;
#pragma unroll
            for (int o = 1; o < 64; o <<= 1) { const float t = __shfl_up(incl, o); if (lane >= o) incl += t; }
            const float excl = incl - run;
            f32x4* fo = (f32x4*)(fb + (size_t)bid * SEQ + 32 * lane);
#pragma unroll
            for (int j = 0; j < 8; ++j) fo[j] = (v[j] + excl) * -11.313708498984761f;
          } }
        pg8::Gemm g{HN, WinT, DM, DM, DM, 0}; pg8::StaticOrder S; S.init(M, 4096, G, bid);
        pg8::EpiG<0> E{U, 1024, 1024, (size_t)(AR_Q - AR_U) / 2, nullptr, nullptr};
        pg8::gemm_phase(ldsl, g, S, E, wave_s);
    }
    xcd_barrier(bar, fresh_tid(wave_s));
    }
    STAMP(2); STAMP(3);

    PH(3) {
    {
        const int xcd = bid & 7, ix = bid >> 3;
        const int bh = (xcd * 4 + (ix >> 3)) & 31, qb = ix & 7, b = bh >> 3, h = bh & 7;
        if (bid < 256) {
            att::BlockRef cur;
            const size_t rowb = (size_t)b * SEQ;
            cur.Q = Qb + (rowb + (size_t)qb * 256) * 1024 + h * HD; cur.K = Kb + rowb * 1024 + h * HD; cur.V = Vb + rowb * 1024 + h * HD;
            cur.FB = fb + (size_t)bh * SEQ; cur.O = YA + (rowb + (size_t)qb * 256) * 1024 + h * HD; cur.P0 = qb * 256;
            att::Seam S;
            att::prime(cur, (char*)lds, S, wave_s);
            att::block(cur, cur, (char*)lds, S, wave_s);
            asm volatile("s_waitcnt vmcnt(0)" ::: "memory");
            __syncthreads();
        }
        {
            pg8::SingleUnit S; const int id = bh * 4 + qb; S.valid = (bid < 256 && qb < 4) ? 1 : 0; S.pm = id >> 2; S.pn = id & 3;
            if (S.valid) {
                const int tid = fresh_tid(wave_s), cc = tid & 31, tg = tid >> 5, gi = S.pn, w = 2 << gi;
                const int t0 = S.pm * 256 + tg * 16, pos0 = t0 & (SEQ - 1), col = gi * 256 + cc * 8;
                const bf16_t* up = U + (size_t)t0 * POOLW + col; bf16_t* dp = DP + (size_t)t0 * POOLW + col;
                float sm[8] = {0.f, 0.f, 0.f, 0.f, 0.f, 0.f, 0.f, 0.f};
                for (int j = 1; j < w; ++j) if (pos0 - j >= 0) { const u32x4 v = *(const u32x4*)(up - (size_t)j * POOLW);
                    sm[0] += bf_lo(v.x); sm[1] += bf_hi(v.x); sm[2] += bf_lo(v.y); sm[3] += bf_hi(v.y); sm[4] += bf_lo(v.z); sm[5] += bf_hi(v.z); sm[6] += bf_lo(v.w); sm[7] += bf_hi(v.w); }
                for (int i = 0; i < 16; ++i) { const int pos = pos0 + i; const u32x4 v = *(const u32x4*)(up + (size_t)i * POOLW);
                    const float f[8] = {bf_lo(v.x), bf_hi(v.x), bf_lo(v.y), bf_hi(v.y), bf_lo(v.z), bf_hi(v.z), bf_lo(v.w), bf_hi(v.w)};
                    const float inv = 1.0f / (float)((pos + 1 < w) ? pos + 1 : w);
                    float d[8];
#pragma unroll
                    for (int e = 0; e < 8; ++e) { sm[e] += f[e]; d[e] = sm[e] * inv - f[e]; }
                    u32x4 o; o.x = cvt_pk_bf16(d[0], d[1]); o.y = cvt_pk_bf16(d[2], d[3]); o.z = cvt_pk_bf16(d[4], d[5]); o.w = cvt_pk_bf16(d[6], d[7]);
                    *(u32x4*)(dp + (size_t)i * POOLW) = o;
                    if (pos - w + 1 >= 0) { const u32x4 q = *(const u32x4*)(up + (size_t)(i - w + 1) * POOLW);
                        sm[0] -= bf_lo(q.x); sm[1] -= bf_hi(q.x); sm[2] -= bf_lo(q.y); sm[3] -= bf_hi(q.y); sm[4] -= bf_lo(q.z); sm[5] -= bf_hi(q.z); sm[6] -= bf_lo(q.w); sm[7] -= bf_hi(q.w); } }
                asm volatile("s_waitcnt vmcnt(0)" ::: "memory");
                __syncthreads();
            }
            pg8::Gemm g{DP, WpoolT, POOLW, 256, 256, 256};
            pg8::EpiG<4> E{YP, POOLW, 0, 0, args.in[I_POOLSCALE], nullptr};
            pg8::gemm_phase(ldsl, g, S, E, wave_s);
        }
        {
            pg8::ListSched S; S.id0 = __builtin_amdgcn_readfirstlane((bh * 4 + qb) * 2); S.n = __builtin_amdgcn_readfirstlane((bid < 256 && qb < 4) ? 2 : 0); S.nN = DM / 256;
            pg8::Gemm g{PBF, WpleT, PLE, PLE, PLE, 0}; pg8::EpiG<0> E{Eb, DM, 0, 0, nullptr, nullptr};
            pg8::gemm_phase(ldsl, g, S, E, wave_s);
        }
        __syncthreads();
        {
            const int tid = fresh_tid(wave_s), lane = tid & 63, wave = __builtin_amdgcn_readfirstlane(tid >> 6);
            LAS unsigned* T = (LAS unsigned*)ldsl;
            constexpr int T_OUT = 16 * 8, T_UP = 16 * 32, T_DOWN = 64 * 8, T_GATE = 16 * 8, NT2 = T_OUT + T_UP + T_DOWN + T_GATE, CH = 4;
            unsigned* ctr = barw + XCD_BAR_WORDS + 16;
            f32x4 va[16], vb[16];
            bf16_t* aWT = nullptr; int aK = 0, ak0 = 0, an0 = 0; bf16_t* bWT = nullptr; int bK = 0, bk0 = 0, bn0 = 0;
            unsigned cbase = 0; int ci = CH; int ta, tb;
#define TR_NEXT(dst) do { if (ci == CH) { if (tid == 0) MISC[12] = __hip_atomic_fetch_add(ctr, (unsigned)CH, __ATOMIC_RELAXED, __HIP_MEMORY_SCOPE_AGENT); \
                __syncthreads(); cbase = MISC[12]; __syncthreads(); ci = 0; } \
            dst = (int)cbase + ci; ++ci; if (dst >= NT2) dst = -1; } while (0)
#define TR_DECODE_LOAD(tt, V, xWT, xK, xk0, xn0) do { int r_ = (tt), nnb_, ldw_; const float* W_; \
            if (r_ < T_OUT) { W_ = args.in[I_WOUT]; ldw_ = DM; xK = DM; xWT = WoutT; nnb_ = 8; } \
            else if ((r_ -= T_OUT) < T_UP) { W_ = args.in[I_WUP]; ldw_ = DFF; xK = DM; xWT = WupT; nnb_ = 32; } \
            else if ((r_ -= T_UP) < T_DOWN) { W_ = args.in[I_WDOWN]; ldw_ = DM; xK = DFF; xWT = WdownT; nnb_ = 8; } \
            else { r_ -= T_DOWN; W_ = args.in[I_WGATE]; ldw_ = DM; xK = DM; xWT = WgateT; nnb_ = 8; } \
            xk0 = 128 * (r_ / nnb_); xn0 = 256 * (r_ % nnb_); \
            const float* src_ = W_ + (size_t)(xk0 + 16 * wave) * ldw_ + xn0 + 4 * lane; \
            _Pragma("unroll") for (int r = 0; r < 16; ++r) V[r] = __builtin_nontemporal_load((const f32x4*)(src_ + (size_t)r * ldw_)); } while (0)
#define TR_PROCESS(V, xWT, xK, xk0, xn0, tcur) do { \
                bf16_t* const sWT_ = xWT; const int sK_ = xK, sk0_ = xk0, sn0_ = xn0; \
                _Pragma("unroll") for (int rp = 0; rp < 8; ++rp) _Pragma("unroll") for (int j = 0; j < 4; ++j) T[(4 * lane + j) * 65 + 8 * wave + rp] = cvt_pk_bf16(V[2 * rp][j], V[2 * rp + 1][j]); \
                TR_NEXT(tcur); \
                __syncthreads(); \
                if (tcur >= 0) TR_DECODE_LOAD(tcur, V, xWT, xK, xk0, xn0); \
                {   const int c = lane & 15, nn = lane >> 4; \
                    _Pragma("unroll") for (int i = 0; i < 8; ++i) { const int n = 4 * (wave + 8 * i) + nn; const LAS unsigned* sp = T + n * 65 + 4 * c; \
                        u32x4 o; o.x = sp[0]; o.y = sp[1]; o.z = sp[2]; o.w = sp[3]; \
                        *(u32x4*)(sWT_ + (size_t)(sn0_ + n) * sK_ + sk0_ + 8 * c) = o; } } \
                __syncthreads(); } while (0)
            TR_NEXT(ta); TR_NEXT(tb);
            if (ta >= 0) TR_DECODE_LOAD(ta, va, aWT, aK, ak0, an0);
            if (tb >= 0) TR_DECODE_LOAD(tb, vb, bWT, bK, bk0, bn0);
            while (ta >= 0) {
                TR_PROCESS(va, aWT, aK, ak0, an0, ta);
                if (tb < 0) break;
                TR_PROCESS(vb, bWT, bK, bk0, bn0, tb);
            }
#undef TR_PROCESS
#undef TR_NEXT
#undef TR_DECODE_LOAD
        }
    }
    xcd_barrier(bar, fresh_tid(wave_s));
    }
    STAMP(4);

    PH(4) {
    { PHASE_IDS();
    ynorm_phase(YP, YA, args.in[I_GPOOLOUT], args.in[I_GATTNOUT], Y, gw, NGW, lane); }
    xcd_barrier(bar, fresh_tid(wave_s));
    }
    STAMP(5);

    PH(5) {
    {
        pg8::Gemm g{Y, WoutT, DM, DM, DM, 0}; pg8::StaticOrder S; S.init(M, DM, G, bid);
        pg8::EpiG<0> E{RAW1, DM, 0, 0, nullptr, nullptr};
        pg8::gemm_phase(ldsl, g, S, E, wave_s);
    }
    xcd_barrier(bar, fresh_tid(wave_s));
    }
    STAMP(6);

    PH(6) {
    { PHASE_IDS();
    resnorm_phase<false, true>(x, RAW1, args.in[I_GPOSTMIX], H1, args.in[I_GPREMLP], HN, gw, NGW, lane); }
    xcd_barrier(bar, fresh_tid(wave_s));
    }
    STAMP(7);

    PH(7) {
    {
        pg8::Gemm g{HN, WupT, DM, DM, DM, 0}; pg8::StaticOrder S; S.init(M, DFF, G, bid);
        pg8::EpiG<2> E{HID, DFF, 0, 0, nullptr, nullptr};
        pg8::gemm_phase(ldsl, g, S, E, wave_s);
    }
    xcd_barrier(bar, fresh_tid(wave_s));
    }
    STAMP(8);

    PH(8) {
    {
        pg8::Gemm g{HID, WdownT, DFF, DFF, DFF, 0}; pg8::StaticOrder S; S.init(M, DM, G, bid);
        pg8::EpiG<0> E{RAW2, DM, 0, 0, nullptr, nullptr};
        pg8::gemm_phase(ldsl, g, S, E, wave_s);
    }
    xcd_barrier(bar, fresh_tid(wave_s));
    }
    STAMP(9);

    PH(9) {
    { PHASE_IDS();
    resnorm_phase<true, true>(H1, RAW2, args.in[I_GPOSTMLP], H2, args.in[I_GPLEGATE], HN, gw, NGW, lane); }
    xcd_barrier(bar, fresh_tid(wave_s));
    }
    STAMP(10);

    PH(10) {
    {
        pg8::StaticOrder S; S.init(M, DM, G, bid);
        { pg8::Gemm g{HN, WgateT, DM, DM, DM, 0}; pg8::EpiG<3> E{RAW2, DM, 0, 0, nullptr, Eb}; pg8::gemm_phase(ldsl, g, S, E, wave_s); }
    }
    xcd_barrier(bar, fresh_tid(wave_s));
    }
    STAMP(11);

    PH(11) {
    { PHASE_IDS();
    resnorm_phase<true, false>(H2, RAW2, args.in[I_GPOSTPLE], out, nullptr, nullptr, gw, NGW, lane); }
    }
#if PROBE_TS >= 0
    STAMP(12);
    if (bid == 0 && fresh_tid(wave_s) == 0) { asm volatile("s_waitcnt vmcnt(0)" ::: "memory");
        const unsigned long long a_ = ((unsigned long long)MISC[17 + 2 * PROBE_TS] << 32) | MISC[16 + 2 * PROBE_TS], b_ = ((unsigned long long)MISC[17 + 2 * (PROBE_TSB)] << 32) | MISC[16 + 2 * (PROBE_TSB)];
        out[0] += (float)(b_ - a_) * 0.01f - (float)PROBE_OFF; }
#endif
}

extern "C" void kernel_launch(void* const* d_in, const int* in_sizes, int n_in, void* d_out, int out_size, void* d_ws, size_t ws_size, hipStream_t stream) {
    static int grid = 0;
    if (grid == 0) {
        if (n_in != 19 || in_sizes[0] != M * DM || out_size != M * DM || ws_size < WS_END) {
            fprintf(stderr, "kernel_launch: unexpected shapes (n_in %d in0 %d out %d ws %zu)\n", n_in, n_in > 0 ? in_sizes[0] : -1, out_size, ws_size); grid = -1; return; }
        int dev = 0, cus = 0, per_cu = 0;
        hipGetDevice(&dev); hipDeviceGetAttribute(&cus, hipDeviceAttributeMultiprocessorCount, dev);
        if (hipFuncSetAttribute((const void*)mega_fwd, hipFuncAttributeMaxDynamicSharedMemorySize, LDS_BYTES) != hipSuccess) { fprintf(stderr, "kernel_launch: hipFuncSetAttribute failed\n"); grid = -1; return; }
        if (hipOccupancyMaxActiveBlocksPerMultiprocessor(&per_cu, (const void*)mega_fwd, NTHREADS, LDS_BYTES) != hipSuccess || per_cu < 1) {
            fprintf(stderr, "kernel_launch: occupancy query says %d\n", per_cu); per_cu = 1; }
        (void)hipGetLastError();
        grid = cus * 1;
        if (grid != 256) fprintf(stderr, "kernel_launch: grid %d (expected 256)\n", grid);
    }
    if (grid < 0) return;
    Args a{};
    for (int i = 0; i < 19; ++i) a.in[i] = (const float*)d_in[i];
    a.out = (float*)d_out; a.ws = (unsigned char*)d_ws;
    void* kargs[] = {&a};
    hipError_t e = hipLaunchCooperativeKernel((const void*)mega_fwd, dim3(grid), dim3(NTHREADS), kargs, LDS_BYTES, stream);
    if (e != hipSuccess) fprintf(stderr, "kernel_launch: cooperative launch failed: %s (grid %d)\n", hipGetErrorString(e), grid);
}
```

```cpp
#include <hip/hip_runtime.h>
#include <hip/hip_bf16.h>
#include <hip/hip_cooperative_groups.h>
#include <cstdio>
#include <cstdint>
namespace cg = cooperative_groups;

#define LAS __attribute__((address_space(3)))
typedef unsigned short bf16_t;
typedef short bf16x8 __attribute__((ext_vector_type(8)));
typedef short s16x4 __attribute__((ext_vector_type(4)));
typedef float f32x4 __attribute__((ext_vector_type(4)));
typedef float f32x2 __attribute__((ext_vector_type(2)));
typedef float f32x16 __attribute__((ext_vector_type(16)));
typedef unsigned u32x4 __attribute__((ext_vector_type(4)));
typedef unsigned u32x2 __attribute__((ext_vector_type(2)));

constexpr int DM = 2048, SEQ = 2048, NB = 4, M = NB * SEQ, POOLW = 1024, ATTW = 1024, NH = 8, HD = 128, DFF = 8192, PLE = 256, INW = 4104;
constexpr float EPS = 1e-6f;

constexpr size_t MiB = 1u << 20;
constexpr size_t WS_FLOG = 1 * MiB;
constexpr size_t WS_FB = 1 * MiB + 512 * 1024;
constexpr size_t WS_WIN = 2 * MiB, WS_WOUT = 18 * MiB, WS_WUP = 26 * MiB, WS_WDOWN = 58 * MiB, WS_WGATE = 90 * MiB, WS_WPLE = 98 * MiB, WS_WPOOL = 99 * MiB;
constexpr size_t WS_HN = 100 * MiB;
constexpr size_t WS_ARENA = 132 * MiB;
constexpr size_t AR_U = WS_ARENA, AR_Q = WS_ARENA + 16 * MiB, AR_K = WS_ARENA + 32 * MiB, AR_V = WS_ARENA + 48 * MiB;
constexpr size_t AR_YP = WS_ARENA + 64 * MiB, AR_YA = WS_ARENA + 80 * MiB, AR_DP = WS_ARENA + 96 * MiB;
constexpr size_t AR_Y = WS_ARENA;
constexpr size_t AR_RAW1 = WS_ARENA + 32 * MiB;
constexpr size_t AR_HID = WS_ARENA;
constexpr size_t AR_E = WS_ARENA;
constexpr size_t WS_RAW2 = WS_WUP;
constexpr size_t WS_PBF = 260 * MiB;
constexpr size_t WS_END = 264 * MiB;

__device__ __forceinline__ unsigned cvt_pk_bf16(float lo, float hi) { unsigned r; asm volatile("v_cvt_pk_bf16_f32 %0, %1, %2" : "=v"(r) : "v"(lo), "v"(hi)); return r; }
__device__ __forceinline__ int fresh_tid(int wv) { int l; asm volatile("v_mbcnt_lo_u32_b32 %0, -1, 0\n\tv_mbcnt_hi_u32_b32 %0, -1, %0" : "=v"(l)); return (wv << 6) | l; }
__device__ __forceinline__ float bf_lo(unsigned w) { return __uint_as_float(w << 16); }
__device__ __forceinline__ float bf_hi(unsigned w) { return __uint_as_float(w & 0xffff0000u); }
__device__ __forceinline__ float wave_sum(float v) {
#define WS_SWZ(o) v += __int_as_float(__builtin_amdgcn_ds_swizzle(__float_as_int(v), 0x1f | ((o) << 10)))
    WS_SWZ(1); WS_SWZ(2); WS_SWZ(4); WS_SWZ(8); WS_SWZ(16);
#undef WS_SWZ
    const auto rr = __builtin_amdgcn_permlane32_swap(__float_as_uint(v), __float_as_uint(v), false, false);
    return __uint_as_float(rr[0]) + __uint_as_float(rr[1]);
}

namespace pg8 {
constexpr int BM = 256, BK = 64, HALF = 128, HTB = HALF * BK * 2, STAGE_BYTES = 8 * HTB, NXCD = 8, WGM = 8;
__host__ __device__ __forceinline__ int lds_byte(int r, int c) { const int st = (r >> 4) * 2 + (c >> 5), rr = r & 15, cc = c & 31, ob = rr * 64 + cc * 2; return st * 1024 + (ob ^ (((ob >> 9) & 1) << 5)); }
__host__ __device__ __forceinline__ void stage_rc(int b, int& R, int& C) { const int st = b / 1024, sb = b % 1024, swz = sb ^ (((sb >> 9) & 1) << 5); R = (st >> 1) * 16 + swz / 64; C = (st & 1) * 32 + (swz % 64) / 2; }
__host__ __device__ __forceinline__ int perm32(int rho) { const int n = rho >> 4, i = rho & 15; return 8 * (i >> 2) + 4 * n + (i & 3); }

struct Unit { int pm, pn; };
struct Gemm { const bf16_t* A; const bf16_t* Bt; int lda, ldb, K, a_pn_koff; };

struct StaticOrder {
    int nM, nN, nwg, G, c;
    __device__ void init(int M_, int N_, int G_, int c_) { nM = M_ / BM; nN = N_ / BM; nwg = nM * nN; G = G_; c = c_; }
    __device__ bool next(int i, Unit& u) const {
        const long L = (long)i * G + c; if (L >= nwg) return false;
        int wgid = (int)L; { const int q = nwg / NXCD, r = nwg % NXCD, xcd = wgid % NXCD, off = wgid / NXCD; wgid = (xcd < r ? xcd * (q + 1) : r * (q + 1) + (xcd - r) * q) + off; }
        const int nig = WGM * nN, gid = wgid / nig, fm = gid * WGM, gsz = (nM - fm) < WGM ? (nM - fm) : WGM;
        u.pm = fm + ((wgid % nig) % gsz); u.pn = (wgid % nig) / gsz; return true;
    }
};
struct ListSched {
    int id0, n, nN;
    __device__ bool next(int i, Unit& u) const { if (i >= n) return false; const int id = id0 + i; u.pm = id / nN; u.pn = id % nN; return true; }
};
struct SingleUnit {
    int pm, pn, valid;
    __device__ bool next(int i, Unit& u) const { if (i != 0 || !valid) return false; u.pm = pm; u.pn = pn; return true; }
};

template <int ACT> struct EpiG {
    static constexpr bool PERM = true;
    bf16_t* O; int ldc; int split_cols; size_t split_stride; const float* colscale; const bf16_t* aux;
    __device__ __forceinline__ void operator()(const f32x4 (&acc)[2][2][4][2], const Unit& u, int wr, int wc, int fr, int fq) const {
        const int row0 = u.pm * BM + wr * 64 + fr; int colt = u.pn * BM; bf16_t* base = O;
        if (split_cols) { const int t = colt / split_cols; base += (size_t)t * split_stride; colt -= t * split_cols; }
        const int col0 = colt + wc * 32 + 8 * fq, gcol0 = u.pn * BM + wc * 32 + 8 * fq;
        f32x4 cs[2][2];
        if (ACT == 4) {
#pragma unroll
            for (int bj = 0; bj < 2; ++bj)
#pragma unroll
                for (int n = 0; n < 2; ++n) cs[bj][n] = *(const f32x4*)(colscale + gcol0 + bj * HALF + 4 * n);
        }
#pragma unroll
        for (int ai = 0; ai < 2; ++ai)
#pragma unroll
            for (int m = 0; m < 4; ++m) { const size_t roff = (size_t)(row0 + ai * HALF + m * 16) * ldc + col0;
#pragma unroll
                for (int bj = 0; bj < 2; ++bj) { f32x4 v0 = acc[ai][bj][m][0], v1 = acc[ai][bj][m][1];
                    if (ACT == 2) {
#pragma unroll
                        for (int e = 0; e < 4; ++e) { float a = fmaxf(v0[e], 0.f), b = fmaxf(v1[e], 0.f); v0[e] = a * a; v1[e] = b * b; }
                    }
                    if (ACT == 3) { const u32x4 ev = *(const u32x4*)(aux + roff + bj * HALF);
                        const float e0[4] = {bf_lo(ev.x), bf_hi(ev.x), bf_lo(ev.y), bf_hi(ev.y)}, e1[4] = {bf_lo(ev.z), bf_hi(ev.z), bf_lo(ev.w), bf_hi(ev.w)};
#pragma unroll
                        for (int e = 0; e < 4; ++e) { v0[e] = __builtin_amdgcn_rcpf(1.f + __builtin_amdgcn_exp2f(-1.4426950408889634f * v0[e])) * e0[e];
                                                      v1[e] = __builtin_amdgcn_rcpf(1.f + __builtin_amdgcn_exp2f(-1.4426950408889634f * v1[e])) * e1[e]; }
                    }
                    if (ACT == 4) { v0 = v0 * cs[bj][0]; v1 = v1 * cs[bj][1]; }
                    u32x4 w; w.x = cvt_pk_bf16(v0[0], v0[1]); w.y = cvt_pk_bf16(v0[2], v0[3]); w.z = cvt_pk_bf16(v1[0], v1[1]); w.w = cvt_pk_bf16(v1[2], v1[3]);
                    *(u32x4*)(base + roff + bj * HALF) = w; } }
    }
};

template <class Epi, class Sched>
__device__ __forceinline__ void gemm_phase(LAS unsigned char* lds, const Gemm g, const Sched& S, const Epi& E, int wv) {
    constexpr bool ALIGN_EPI = true;
    const int tid = fresh_tid(wv), wid = __builtin_amdgcn_readfirstlane(tid >> 6), lane = tid & 63, wr = wid >> 2, wc = wid & 3, fr = lane & 15, fq = lane >> 4;
    const int K = g.K, nt = K / BK;
    unsigned voffA[2], voffB[2];
#pragma unroll
    for (int i = 0; i < 2; ++i) { int R, C; stage_rc(tid * 16 + i * 8192, R, C); const int Rb = Epi::PERM ? ((R & ~31) + perm32(R & 31)) : R;
        voffA[i] = (unsigned)(R * g.lda + C) * 2u; voffB[i] = (unsigned)(Rb * g.ldb + C) * 2u; }
    const size_t kstep = (size_t)(BK * 2);
    const size_t hstepA = (size_t)HALF * g.lda * 2, hstepB = (size_t)HALF * g.ldb * 2;
    const size_t tstepA = 2 * hstepA, tstepB = 2 * hstepB;
    const unsigned ldsw = (unsigned)wid * 1024u;
    const int aoff = lds_byte(wr * 64 + fr, fq * 8), boff = lds_byte(wc * 32 + fr, fq * 8);
#define PG8_SA(b, h) (((b) * 2 + (h)) * HTB)
#define PG8_SB(b, h) ((4 + (b) * 2 + (h)) * HTB)
#define PG8_STAGE(bufoff, gbase, voff) do { _Pragma("unroll") for (int _i = 0; _i < 2; ++_i) \
        __builtin_amdgcn_global_load_lds((const unsigned*)((const char*)(gbase) + (voff)[_i]), (LAS unsigned*)(lds + (bufoff) + ldsw + _i * 8192), 16, 0, 0); } while (0)
#define PG8_LDA(dst, b, h) do { _Pragma("unroll") for (int m = 0; m < 4; ++m) _Pragma("unroll") for (int k = 0; k < 2; ++k) dst[m][k] = *(const LAS bf16x8*)(lds + PG8_SA(b, h) + aoff + m * 2048 + k * 1024); } while (0)
#define PG8_LDB(dst, b, h) do { _Pragma("unroll") for (int n = 0; n < 2; ++n) _Pragma("unroll") for (int k = 0; k < 2; ++k) dst[n][k] = *(const LAS bf16x8*)(lds + PG8_SB(b, h) + boff + n * 2048 + k * 1024); } while (0)
#define PG8_MMA(ai, bj, At, Bt) do { __builtin_amdgcn_s_setprio(1); _Pragma("unroll") for (int m = 0; m < 4; ++m) _Pragma("unroll") for (int n = 0; n < 2; ++n) _Pragma("unroll") for (int k = 0; k < 2; ++k) \
        acc[ai][bj][m][n] = __builtin_amdgcn_mfma_f32_16x16x32_bf16(Bt[n][k], At[m][k], acc[ai][bj][m][n], 0, 0, 0); __builtin_amdgcn_s_setprio(0); } while (0)
#define PG8_WAIT_V(n) asm volatile("s_waitcnt vmcnt(" #n ")" ::: "memory")
#define PG8_WAIT_L(n) asm volatile("s_waitcnt lgkmcnt(" #n ")" ::: "memory")
#define PG8_BAR __builtin_amdgcn_s_barrier()
#define PG8_SCHED __builtin_amdgcn_sched_barrier(0)
    Unit cur, nxt; int ui = 0;
    if (!S.next(0, cur)) return;
    f32x4 acc[2][2][4][2];
#pragma unroll
    for (int a = 0; a < 2; ++a)
#pragma unroll
        for (int b = 0; b < 2; ++b)
#pragma unroll
            for (int m = 0; m < 4; ++m)
#pragma unroll
                for (int n = 0; n < 2; ++n) acc[a][b][m][n] = (f32x4){0.f, 0.f, 0.f, 0.f};
    bf16x8 At[4][2], B0[2][2], B1[2][2];
    const char* cA = (const char*)g.A + (size_t)cur.pm * tstepA + (size_t)cur.pn * g.a_pn_koff * 2; const char* cB = (const char*)g.Bt + (size_t)cur.pn * tstepB;
    PG8_STAGE(PG8_SB(0, 0), cB, voffB); PG8_STAGE(PG8_SB(0, 1), cB + hstepB, voffB); PG8_STAGE(PG8_SA(0, 0), cA, voffA); PG8_STAGE(PG8_SA(0, 1), cA + hstepA, voffA);
    if (wr == 1) PG8_BAR;
    PG8_WAIT_V(2); PG8_BAR;
    PG8_STAGE(PG8_SB(1, 0), cB + kstep, voffB); PG8_STAGE(PG8_SA(1, 0), cA + kstep, voffA); PG8_STAGE(PG8_SB(1, 1), cB + hstepB + kstep, voffB);
    PG8_WAIT_V(6); PG8_BAR;
    for (;;) {
        const bool has_next = S.next(ui + 1, nxt);
        const char* nA = has_next ? (const char*)g.A + (size_t)nxt.pm * tstepA + (size_t)nxt.pn * g.a_pn_koff * 2 : cA; const char* nB = has_next ? (const char*)g.Bt + (size_t)nxt.pn * tstepB : cB;
        asm volatile("" : "+s"(nA), "+s"(nB));
        for (int t = 0; t < nt; t += 2) {
            const bool last = (t == nt - 2);
            const char* a1 = cA + (size_t)(t + 1) * kstep;
            const char* a2 = last ? nA : cA + (size_t)(t + 2) * kstep; const char* b2 = last ? nB : cB + (size_t)(t + 2) * kstep;
            const char* a3 = a2 + kstep; const char* b3 = b2 + kstep;
            PG8_LDB(B0, 0, 0); PG8_LDB(B1, 0, 1); PG8_SCHED; PG8_LDA(At, 0, 0); PG8_STAGE(PG8_SA(1, 1), a1 + hstepA, voffA);
            PG8_WAIT_V(8); PG8_WAIT_L(0); PG8_BAR; PG8_MMA(0, 0, At, B0); PG8_MMA(0, 1, At, B1); PG8_BAR; PG8_SCHED;
            PG8_LDA(At, 0, 1); PG8_STAGE(PG8_SB(0, 0), b2, voffB); PG8_STAGE(PG8_SB(0, 1), b2 + hstepB, voffB); PG8_STAGE(PG8_SA(0, 0), a2, voffA);
            PG8_WAIT_V(8); PG8_WAIT_L(0); PG8_BAR; PG8_MMA(1, 0, At, B0); PG8_MMA(1, 1, At, B1); PG8_BAR; PG8_SCHED;
            PG8_LDB(B0, 1, 0); PG8_LDB(B1, 1, 1); PG8_SCHED; PG8_LDA(At, 1, 0); PG8_STAGE(PG8_SA(0, 1), a2 + hstepA, voffA);
            PG8_WAIT_V(8); PG8_WAIT_L(0); PG8_BAR; PG8_MMA(0, 0, At, B0); PG8_MMA(0, 1, At, B1); PG8_BAR; PG8_SCHED;
            PG8_LDA(At, 1, 1); PG8_STAGE(PG8_SB(1, 0), b3, voffB); PG8_STAGE(PG8_SB(1, 1), b3 + hstepB, voffB); PG8_STAGE(PG8_SA(1, 0), a3, voffA);
            PG8_WAIT_V(8); PG8_WAIT_L(0); PG8_BAR; PG8_MMA(1, 0, At, B0); PG8_MMA(1, 1, At, B1); PG8_BAR; PG8_SCHED;
        }
        if constexpr (ALIGN_EPI) { if (wr == 0) PG8_BAR; }
        { const int t2 = fresh_tid(wv), w2 = __builtin_amdgcn_readfirstlane(t2 >> 6), l2 = t2 & 63; E(acc, cur, w2 >> 2, w2 & 3, l2 & 15, l2 >> 4); }
        if (!has_next) break;
#pragma unroll
        for (int a = 0; a < 2; ++a)
#pragma unroll
            for (int b = 0; b < 2; ++b)
#pragma unroll
                for (int m = 0; m < 4; ++m)
#pragma unroll
                    for (int n = 0; n < 2; ++n) acc[a][b][m][n] = (f32x4){0.f, 0.f, 0.f, 0.f};
        cur = nxt; cA = nA; cB = nB; ++ui;
        if constexpr (ALIGN_EPI) { if (wr == 1) PG8_BAR; }
    }
    PG8_WAIT_V(0);
    if constexpr (!ALIGN_EPI) { if (wr == 0) PG8_BAR; }
    PG8_BAR;
#undef PG8_SA
#undef PG8_SB
#undef PG8_STAGE
#undef PG8_LDA
#undef PG8_LDB
#undef PG8_MMA
#undef PG8_WAIT_V
#undef PG8_WAIT_L
#undef PG8_BAR
#undef PG8_SCHED
}
}

namespace att {
constexpr int D = 128, LD = 1024;
constexpr float SCALE = 0.08838834764831845f;
constexpr float THR = 8.f;
constexpr int NW = 8, QBLK = 32, KVBLK = 64, QB = NW * QBLK;
constexpr int SHM_V = KVBLK * D * 2, SHM_K = KVBLK * D * 2;
constexpr int OFF_WS = 2 * SHM_V + 2 * SHM_K, OFF_BIAS = OFF_WS + NW * 64 * 4, LDS_BYTES = OFF_BIAS + 512;
typedef bf16_t bf16;
#define KSWZ(row, colB) ((row) * 256 + ((colB) ^ (((row) & 7) << 4)))
#define SBAR() __builtin_amdgcn_sched_barrier(0)
__device__ __forceinline__ int v_st(int k, int c) { const int kk = (k & ~0xC) | ((k & 4) << 1) | ((k & 8) >> 1); return ((kk >> 3) * 4 + (c >> 5)) * 512 + ((kk & 7) * 32 + (c & 31)) * 2; }
__device__ __forceinline__ int v_rd_base(int lane) { return ((lane & 3) << 3) | (((lane >> 2) & 3) << 6) | (((lane >> 4) & 1) << 5) | (((lane >> 5) & 1) << 8); }
constexpr int v_rd_off(int d0, int ks, int half) { return d0 * 512 + ks * 4096 + half * 2048; }
__device__ __forceinline__ int crow(int r, int hi) { return (r & 3) + 8 * (r >> 2) + 4 * hi; }
__device__ __forceinline__ unsigned cvtpk(float lo, float hi) { unsigned r; asm volatile("v_cvt_pk_bf16_f32 %0, %1, %2" : "=v"(r) : "v"(lo), "v"(hi)); return r; }
__device__ __forceinline__ bf16x8 load8(const bf16* p) { return *reinterpret_cast<const bf16x8*>(p); }
__device__ __forceinline__ void mask_tile(f32x16& p0, f32x16& p1, int dq, unsigned W) {
    const float NEG = -__builtin_inff();
#pragma unroll
    for (int r = 0; r < 16; ++r) {
        const int c = (r & 3) + 8 * (r >> 2);
        if ((unsigned)(dq - c) >= W) p0[r] = NEG;
        if ((unsigned)(dq - c - 32) >= W) p1[r] = NEG;
    }
}
__device__ __forceinline__ void partialSM(f32x16& p0, f32x16& p1, float& m_reg, float& mn, float& alpha) {
    float pmax = p0[0]; for (int r = 1; r < 16; ++r) pmax = fmaxf(pmax, p0[r]); for (int r = 0; r < 16; ++r) pmax = fmaxf(pmax, p1[r]);
    { auto rr = __builtin_amdgcn_permlane32_swap(__float_as_uint(pmax), __float_as_uint(pmax), false, false);
      pmax = fmaxf(__uint_as_float(rr[0]), __uint_as_float(rr[1])); }
    constexpr float C2 = 1.4426950408889634f * SCALE;
    if (__builtin_expect(__all((pmax - m_reg) * SCALE <= THR), 1)) { mn = m_reg; alpha = 1.f; }
    else { mn = fmaxf(m_reg, pmax); alpha = __builtin_amdgcn_exp2f((m_reg - mn) * C2); m_reg = mn; }
    const float mnL = -mn * C2;
    for (int r = 0; r < 16; ++r) p0[r] = fmaf(p0[r], C2, mnL); for (int r = 0; r < 16; ++r) p1[r] = fmaf(p1[r], C2, mnL);
    for (int r = 0; r < 16; ++r) p0[r] = __builtin_amdgcn_exp2f(p0[r]);
}
__device__ __forceinline__ void finishSM(f32x16& p0, f32x16& p1, float alpha, float& l_reg, bf16x8& pa0, bf16x8& pa1, bf16x8& pa2, bf16x8& pa3) {
    for (int r = 0; r < 16; ++r) p1[r] = __builtin_amdgcn_exp2f(p1[r]);
    float ps = 0; for (int r = 0; r < 16; ++r) ps += p0[r]; for (int r = 0; r < 16; ++r) ps += p1[r];
    { auto rr = __builtin_amdgcn_permlane32_swap(__float_as_uint(ps), __float_as_uint(ps), false, false);
      ps = __uint_as_float(rr[0]) + __uint_as_float(rr[1]); }
    l_reg = l_reg * alpha + ps;
#define PK4(P, B_, OUT) do { unsigned a0 = cvtpk(P[B_+0], P[B_+1]), a1 = cvtpk(P[B_+2], P[B_+3]);                          \
        unsigned b0 = cvtpk(P[B_+4], P[B_+5]), b1 = cvtpk(P[B_+6], P[B_+7]);                                             \
        auto r0 = __builtin_amdgcn_permlane32_swap(a0, b0, false, false); auto r1 = __builtin_amdgcn_permlane32_swap(a1, b1, false, false); \
        u32x4 w = {r0[0], r1[0], r0[1], r1[1]}; OUT = *reinterpret_cast<bf16x8*>(&w); } while (0)
    PK4(p0, 0, pa0); PK4(p0, 8, pa1); PK4(p1, 0, pa2); PK4(p1, 8, pa3);
#undef PK4
}
template <int KB>
__device__ __forceinline__ void qkt(f32x16& p0, f32x16& p1, const char* K_lds, const char* B_lds, int r32, int hi, const bf16x8* qr) {
    const f32x4* bp = (const f32x4*)(B_lds + KB * 256 + hi * 16);
#pragma unroll
    for (int i = 0; i < 4; ++i) { const f32x4 a = bp[2 * i], b = bp[8 + 2 * i];
        p0[4 * i] = a[0]; p0[4 * i + 1] = a[1]; p0[4 * i + 2] = a[2]; p0[4 * i + 3] = a[3];
        p1[4 * i] = b[0]; p1[4 * i + 1] = b[1]; p1[4 * i + 2] = b[2]; p1[4 * i + 3] = b[3]; }
    const char* kb[4];
#pragma unroll
    for (int dd = 0; dd < 4; ++dd) kb[dd] = K_lds + KB * SHM_K + KSWZ(r32, (dd * 16 + hi * 8) * 2);
#pragma unroll
    for (int d0 = 0; d0 < 8; ++d0) { const char* a = kb[d0 & 3] + (d0 >> 2) * 128;
        bf16x8 b0 = *reinterpret_cast<const bf16x8*>(a);
        bf16x8 b1 = *reinterpret_cast<const bf16x8*>(a + 32 * 256);
        p0 = __builtin_amdgcn_mfma_f32_32x32x16_bf16(b0, qr[d0], p0, 0, 0, 0);
        p1 = __builtin_amdgcn_mfma_f32_32x32x16_bf16(b1, qr[d0], p1, 0, 0, 0); }
}
template <int VB>
__device__ __forceinline__ void pv_tile(f32x16* o, int vb0, bf16x8 pa0, bf16x8 pa1, bf16x8 pa2, bf16x8 pa3) {
#define TRRD(dst, off) asm volatile("ds_read_b64_tr_b16 %0, %1 offset:%2" : "=&v"(dst) : "v"(vb0), "i"(off) : "memory")
#define PV_D0(d0) do { s16x4 l0, l1, l2, l3, h0, h1, h2, h3; constexpr int b_ = VB * SHM_V + v_rd_off(d0, 0, 0); \
        TRRD(l0, b_); TRRD(h0, b_ + 2048); TRRD(l1, b_ + 4096); TRRD(h1, b_ + 6144); TRRD(l2, b_ + 8192); TRRD(h2, b_ + 10240); TRRD(l3, b_ + 12288); TRRD(h3, b_ + 14336); \
        asm volatile("s_waitcnt lgkmcnt(0)" ::: "memory"); SBAR();   \
        o[d0] = __builtin_amdgcn_mfma_f32_32x32x16_bf16(pa0, (bf16x8){l0[0], l0[1], l0[2], l0[3], h0[0], h0[1], h0[2], h0[3]}, o[d0], 0, 0, 0);   \
        o[d0] = __builtin_amdgcn_mfma_f32_32x32x16_bf16(pa1, (bf16x8){l1[0], l1[1], l1[2], l1[3], h1[0], h1[1], h1[2], h1[3]}, o[d0], 0, 0, 0);   \
        o[d0] = __builtin_amdgcn_mfma_f32_32x32x16_bf16(pa2, (bf16x8){l2[0], l2[1], l2[2], l2[3], h2[0], h2[1], h2[2], h2[3]}, o[d0], 0, 0, 0);   \
        o[d0] = __builtin_amdgcn_mfma_f32_32x32x16_bf16(pa3, (bf16x8){l3[0], l3[1], l3[2], l3[3], h3[0], h3[1], h3[2], h3[3]}, o[d0], 0, 0, 0); } while (0)
    PV_D0(0); PV_D0(1); PV_D0(2); PV_D0(3);
#undef PV_D0
#undef TRRD
}
struct BlockRef { const bf16* Q; const bf16* K; const bf16* V; const float* FB; bf16* O; int P0; };
struct Seam { bf16x8 qr[8]; bf16x8 st_v0, st_v1, st_k0, st_k1; float st_b; };
#define ROW(p, k0, rr) ((p) + (size_t)((k0) + (rr)) * LD + sc)
#define VMW() asm volatile("s_waitcnt vmcnt(0)" ::: "memory")
#define VMWN(n) asm volatile("s_waitcnt vmcnt(%0)" :: "i"(n) : "memory")
#define SLOAD_H(Kp, Vp, Fp, k0) do { S.st_v0 = load8(ROW(Vp, k0, sr)); S.st_v1 = load8(ROW(Vp, k0, 32 + sr));              \
                         S.st_k0 = load8(ROW(Kp, k0, sr)); S.st_k1 = load8(ROW(Kp, k0, 32 + sr)); S.st_b = (Fp)[(k0) + (tid & 63)]; } while (0)
#define SWRITE_HK(bf) do { *(bf16x8*)(K_lds + (bf) * SHM_K + kws) = S.st_k0; *(bf16x8*)(K_lds + (bf) * SHM_K + kws + 32 * 256) = S.st_k1; \
                           if (tid < 64) ((float*)B_lds)[(bf) * 64 + tid] = S.st_b; } while (0)
#define SWRITE_HV(bf) do { *(bf16x8*)(V_lds + (bf) * SHM_V + vst0) = S.st_v0; *(bf16x8*)(V_lds + (bf) * SHM_V + vst1) = S.st_v1; } while (0)
#define SWRITE_H(bf) do { SWRITE_HV(bf); SWRITE_HK(bf); } while (0)
__device__ __forceinline__ void prime(const BlockRef& cur, char* lds, Seam& S, int wv) {
    const int tid = fresh_tid(wv), wid = __builtin_amdgcn_readfirstlane(tid >> 6), lane = tid & 63, r32 = lane & 31, hi = lane >> 5;
    const int sr = tid >> 4, sc = (tid & 15) * 8, kws = KSWZ(sr, sc * 2); char* K_lds = lds + 2 * SHM_V; char* B_lds = lds + OFF_BIAS;
    for (int d0 = 0; d0 < 8; ++d0) S.qr[d0] = load8(cur.Q + (size_t)(wid * QBLK + r32) * LD + d0 * 16 + hi * 8);
    SLOAD_H(cur.K, cur.V, cur.FB, 0); VMW(); SWRITE_HK(0);
    __syncthreads();
}
__device__ __forceinline__ void block(const BlockRef& cur, const BlockRef& nxt, char* lds, Seam& S, int wv) {
    const int tid = fresh_tid(wv), wid = __builtin_amdgcn_readfirstlane(tid >> 6), lane = tid & 63, r32 = lane & 31, hi = lane >> 5;
    constexpr unsigned W = 1u << 30;
    const int NT = (cur.P0 + QB - 1) / KVBLK + 1;
    const int qlo = cur.P0 + wid * QBLK, qm = qlo + r32 - 4 * hi;
    char* V_lds = lds; char* K_lds = lds + 2 * SHM_V; char* B_lds = lds + OFF_BIAS;
    float* ws = (float*)(lds + OFF_WS) + wid * 64; float* li_l = ws, * al_l = ws + 32;
    float m_reg = -1e30f, l_reg = 0; f32x16 o[4] = {};
    const int sr = tid >> 4, sc = (tid & 15) * 8, vst0 = v_st(sr, sc), vst1 = v_st(32 + sr, sc), kws = KSWZ(sr, sc * 2);
    const int vb0 = (int)(uintptr_t)V_lds + v_rd_base(lane);
    const bf16* Kh = cur.K; const bf16* Vh = cur.V; const float* Fh = cur.FB;
#define RESC(a) do { if (__any((a) < 1.f)) { if (hi == 0) al_l[r32] = (a); asm volatile("s_waitcnt lgkmcnt(0)" ::: "memory");              \
                     for (int d_ = 0; d_ < 4; ++d_) for (int r = 0; r < 16; ++r) o[d_][r] *= al_l[crow(r, hi)]; } } while (0)
#define KBASE(t) ((t) * KVBLK)
#define MASKT(P0_, P1_, t) do { const int kb_ = KBASE(t); if (kb_ + KVBLK - 1 > qlo) mask_tile(P0_, P1_, qm - kb_, W); } while (0)
    constexpr int NQL = 8;
#define SEAM_K0() do { VMWN(NQL); SWRITE_HK(0); SBAR(); } while (0)
    f32x16 pA0, pA1, pB0, pB1; float mnA, mnB, alA, alB; bf16x8 pa0, pa1, pa2, pa3;
    SWRITE_HV(0); SBAR();
    if (NT > 1) SLOAD_H(Kh, Vh, Fh, KBASE(1));
    SBAR(); qkt<0>(pA0, pA1, K_lds, B_lds, r32, hi, S.qr);
    MASKT(pA0, pA1, 0); partialSM(pA0, pA1, m_reg, mnA, alA);
    if (NT > 1) { VMW(); SWRITE_H(1); }
    __syncthreads();
#define HALF_STEP(PX0, PX1, mnX, alX, PY0, PY1, alY, t, KB, VB, SB) do {                                                      \
        SBAR(); qkt<KB>(PX0, PX1, K_lds, B_lds, r32, hi, S.qr);                                                               \
        finishSM(PY0, PY1, alY, l_reg, pa0, pa1, pa2, pa3); SBAR();                                                           \
        if ((t) + 1 < NT) { SLOAD_H(Kh, Vh, Fh, KBASE((t) + 1)); SBAR(); }                                                    \
        pv_tile<VB>(o, vb0, pa0, pa1, pa2, pa3); MASKT(PX0, PX1, (t)); partialSM(PX0, PX1, m_reg, mnX, alX);                  \
        __syncthreads();                                                                                                      \
        if ((t) + 1 < NT) { VMW(); SWRITE_H(SB); }                                                                            \
        RESC(alX); __syncthreads(); } while (0)
    for (int t = 1; t + 1 < NT; t += 2) {
        HALF_STEP(pB0, pB1, mnB, alB, pA0, pA1, alA, t, 1, 0, 0);
        HALF_STEP(pA0, pA1, mnA, alA, pB0, pB1, alB, t + 1, 0, 1, 1);
    }
    const bool even = (NT & 1) == 0;
    if (even) { SBAR(); qkt<1>(pB0, pB1, K_lds, B_lds, r32, hi, S.qr); SBAR(); }
    SLOAD_H(nxt.K, nxt.V, nxt.FB, 0); SBAR();
#pragma unroll
    for (int d0 = 0; d0 < 8; ++d0) S.qr[d0] = load8(nxt.Q + (size_t)(wid * QBLK + r32) * LD + d0 * 16 + hi * 8);
    SBAR();
    finishSM(pA0, pA1, alA, l_reg, pa0, pa1, pa2, pa3); SBAR();
    pv_tile<0>(o, vb0, pa0, pa1, pa2, pa3);
    if (even) { MASKT(pB0, pB1, NT - 1); partialSM(pB0, pB1, m_reg, mnB, alB); __syncthreads(); RESC(alB);
        finishSM(pB0, pB1, alB, l_reg, pa0, pa1, pa2, pa3); SBAR(); pv_tile<1>(o, vb0, pa0, pa1, pa2, pa3); }
    SBAR(); SEAM_K0();
    if (hi == 0) li_l[r32] = l_reg; asm volatile("s_waitcnt lgkmcnt(0)" ::: "memory");
    float rli[16];
#pragma unroll
    for (int r = 0; r < 16; ++r) rli[r] = __builtin_amdgcn_rcpf(li_l[crow(r, hi)]);
    bf16* Ow = cur.O + (size_t)(wid * QBLK) * LD;
#pragma unroll
    for (int r = 0; r < 16; ++r) { const int orow = crow(r, hi);
#pragma unroll
        for (int d0 = 0; d0 < 4; ++d0) { const float v = o[d0][r] * rli[r];
            const float vn = __shfl_xor(v, 1);
            if ((r32 & 1) == 0) *(unsigned*)(Ow + (size_t)orow * LD + d0 * 32 + r32) = cvtpk(v, vn); } }
    __syncthreads();
#undef RESC
#undef KBASE
#undef MASKT
#undef SEAM_K0
#undef HALF_STEP
}
#undef ROW
#undef VMW
#undef VMWN
#undef SLOAD_H
#undef SWRITE_HK
#undef SWRITE_HV
#undef SWRITE_H
#undef SBAR
#undef KSWZ
}

#define XB_TMO      128
#define XB_XCNT(j)  (256  + 64 * (j))
#define XB_XSUB(j)  (1280 + 64 * (j))
#define XB_XGEN(j)  (2304 + 64 * (j))
#define XB_TOP      3328
#define XB_TOPGEN   3392
#define XCD_BAR_WORDS 3456
#define XB_SPIN_CAP (1u << 18)
__device__ __forceinline__ unsigned xb_ld(unsigned* p)              { return __hip_atomic_load(p, __ATOMIC_RELAXED, __HIP_MEMORY_SCOPE_AGENT); }
__device__ __forceinline__ unsigned xb_add(unsigned* p, unsigned v) { return __hip_atomic_fetch_add(p, v, __ATOMIC_RELAXED, __HIP_MEMORY_SCOPE_AGENT); }
__device__ __forceinline__ unsigned xb_xcc_id() { return (unsigned)__builtin_amdgcn_s_getreg((3 << 11) | 20) & 0xFu; }
#define XB_SPIN(cond, bar) do { unsigned _sp = 0; while (cond) { __builtin_amdgcn_s_sleep(1); \
    if ((++_sp & 255u) == 0u) { if (xb_ld(&(bar)[XB_TMO])) break; if (_sp > XB_SPIN_CAP) { atomicAdd(&(bar)[XB_TMO], 1u); break; } } } } while (0)
struct XcdBarrier { unsigned* bar; unsigned x; volatile LAS unsigned* st; };
__device__ __forceinline__ XcdBarrier xcd_barrier_post(unsigned* bar, volatile LAS unsigned* st, int tid) {
    XcdBarrier b; b.bar = bar; b.x = xb_xcc_id(); b.st = st;
    if (tid == 0) (void)xb_add(&bar[XB_XCNT(b.x)], 1u);
    return b;
}
__device__ __forceinline__ void xcd_barrier_complete(unsigned* bar, unsigned x, unsigned& nloc, unsigned& nx) {
    const unsigned G = gridDim.x * gridDim.y * gridDim.z;
    unsigned sum, cnt, mine, sp = 0u;
    for (;;) {
        sum = 0u; cnt = 0u; mine = 0u;
#pragma unroll
        for (unsigned j = 0; j < 16; ++j) { const unsigned c = xb_ld(&bar[XB_XCNT(j)]); sum += c; cnt += (c > 0u) ? 1u : 0u; mine = (j == x) ? c : mine; }
        if (sum == G) break;
        __builtin_amdgcn_s_sleep(1);
        if ((++sp & 255u) == 0u) { if (xb_ld(&bar[XB_TMO])) break; if (sp > XB_SPIN_CAP) { atomicAdd(&bar[XB_TMO], 1u); break; } }
    }
    nloc = mine > 0u ? mine : 1u; nx = cnt > 0u ? cnt : 1u;
}
__device__ __forceinline__ void xcd_barrier(const XcdBarrier& b, int tid) {
    asm volatile("s_waitcnt vmcnt(0)" ::: "memory");
    __syncthreads();
    if (tid == 0) {
        unsigned* bar = b.bar;
        __builtin_amdgcn_s_waitcnt(0);
        unsigned nloc = b.st[0], nx = b.st[1];
        if (nloc == 0u) { xcd_barrier_complete(bar, b.x, nloc, nx); b.st[0] = nloc; b.st[1] = nx; }
        const unsigned old = xb_add(&bar[XB_XSUB(b.x)], 1u);
        const unsigned gen = old / nloc;
        if (old + 1u == (gen + 1u) * nloc) {
            __builtin_amdgcn_fence(__ATOMIC_RELEASE, "agent");
            asm volatile("s_waitcnt vmcnt(0)" ::: "memory");
            const unsigned og = xb_add(&bar[XB_TOP], 1u);
            const unsigned tg = og / nx;
            if (og + 1u == (tg + 1u) * nx) xb_add(&bar[XB_TOPGEN], 1u);
            else XB_SPIN(xb_ld(&bar[XB_TOPGEN]) == tg, bar);
            __builtin_amdgcn_fence(__ATOMIC_ACQUIRE, "agent");
            xb_add(&bar[XB_XGEN(b.x)], 1u);
            asm volatile("s_waitcnt vmcnt(0)" ::: "memory");
        } else {
            XB_SPIN(xb_ld(&bar[XB_XGEN(b.x)]) == gen, bar);
            __builtin_amdgcn_fence(__ATOMIC_ACQUIRE, "agent");
            asm volatile("s_waitcnt vmcnt(0)" ::: "memory");
        }
    }
    __syncthreads();
}

#ifndef PROBE_PHASE
#define PROBE_PHASE -1
#endif
#ifndef PROBE_TS
#define PROBE_TS -1
#endif
#ifndef PROBE_OFF
#define PROBE_OFF 0
#endif
#ifndef PROBE_TSB
#define PROBE_TSB (PROBE_TS + 1)
#endif
#define PH(id) for (int rep_ = 0; rep_ < ((PROBE_PHASE == (id)) ? 2 : 1); ++rep_)
constexpr int NWAVES = 8, NTHREADS = 512;
constexpr int LDS_BYTES = 147456;
struct Args { const float* in[19]; float* out; unsigned char* ws; unsigned long long cg_rounds; };
enum { I_X = 0, I_P, I_GPREMIX, I_WIN, I_BF, I_WPOOL, I_POOLSCALE, I_GPOOLOUT, I_GATTNOUT, I_WOUT, I_GPOSTMIX, I_GPREMLP, I_WUP, I_WDOWN, I_GPOSTMLP, I_GPLEGATE, I_WGATE, I_WPLE, I_GPOSTPLE };

constexpr int TR_PITCH = 68, TR_BYTES = 64 * TR_PITCH * 4;
__device__ __forceinline__ void p0_transpose_item(const float* W, int K, int N, int ldw, bf16_t* WT, int row_off, LAS float* scr, int item, int lane) {
    const int nkb = K / 64, kb = item % nkb, nb = item / nkb, k0 = 64 * kb, n0 = 64 * nb; (void)N;
    f32x4 v[16];
    const float* src = W + (size_t)(k0 + (lane >> 4)) * ldw + n0 + 4 * (lane & 15);
#pragma unroll
    for (int i = 0; i < 16; ++i) v[i] = __builtin_nontemporal_load((const f32x4*)(src + (size_t)(4 * i) * ldw));
#pragma unroll
    for (int i = 0; i < 16; ++i) *(LAS f32x4*)(scr + (4 * i + (lane >> 4)) * TR_PITCH + 4 * (lane & 15)) = v[i];
    asm volatile("s_waitcnt lgkmcnt(0)" ::: "memory");
    const int c = lane >> 3;
#pragma unroll
    for (int j = 0; j < 8; ++j) { const int n = (lane & 7) + 8 * j; const LAS float* sp = scr + (8 * c) * TR_PITCH + n;
        u32x4 o; o.x = cvt_pk_bf16(sp[0 * TR_PITCH], sp[1 * TR_PITCH]); o.y = cvt_pk_bf16(sp[2 * TR_PITCH], sp[3 * TR_PITCH]);
        o.z = cvt_pk_bf16(sp[4 * TR_PITCH], sp[5 * TR_PITCH]); o.w = cvt_pk_bf16(sp[6 * TR_PITCH], sp[7 * TR_PITCH]);
        *(u32x4*)(WT + (size_t)(row_off + n0 + n) * K + k0 + 8 * c) = o; }
    asm volatile("s_waitcnt lgkmcnt(0)" ::: "memory");
}

template <bool BIN, bool BOUT>
__device__ __forceinline__ void resnorm_phase(const void* base, const bf16_t* raw, const float* g_post, void* outp, const float* g_next, bf16_t* hn, int gw, int NGW, int lane) {
    u32x2 nraw[8]; f32x4 nbf[8]; u32x2 nbh[8];
#define RN_LOAD(mm) do { const u32x2* rp_ = (const u32x2*)(raw + (size_t)(mm) * DM) + lane; \
        _Pragma("unroll") for (int j = 0; j < 8; ++j) nraw[j] = rp_[64 * j]; \
        if (BIN) { const u32x2* bp_ = (const u32x2*)((const bf16_t*)base + (size_t)(mm) * DM) + lane; _Pragma("unroll") for (int j = 0; j < 8; ++j) nbh[j] = bp_[64 * j]; } \
        else { const f32x4* bp_ = (const f32x4*)((const float*)base + (size_t)(mm) * DM) + lane; _Pragma("unroll") for (int j = 0; j < 8; ++j) nbf[j] = __builtin_nontemporal_load(bp_ + 64 * j); } } while (0)
    int m = gw; if (m < M) RN_LOAD(m);
    for (; m < M; m += NGW) {
        f32x4 r[8], b[8]; float ss = 0.f;
#pragma unroll
        for (int j = 0; j < 8; ++j) { r[j] = (f32x4){bf_lo(nraw[j].x), bf_hi(nraw[j].x), bf_lo(nraw[j].y), bf_hi(nraw[j].y)};
            if (BIN) b[j] = (f32x4){bf_lo(nbh[j].x), bf_hi(nbh[j].x), bf_lo(nbh[j].y), bf_hi(nbh[j].y)}; else b[j] = nbf[j];
            ss += (r[j].x * r[j].x + r[j].y * r[j].y) + (r[j].z * r[j].z + r[j].w * r[j].w); }
        asm volatile("" ::: "memory");
        if (m + NGW < M) RN_LOAD(m + NGW);
        const float rs = 1.0f / sqrtf(wave_sum(ss) * (1.f / DM) + EPS);
        float ss2 = 0.f;
#pragma unroll
        for (int j = 0; j < 8; ++j) { const f32x4 g = *((const f32x4*)g_post + lane + 64 * j);
            r[j] = b[j] + r[j] * rs * g;
            if (BOUT) { u32x2 w; w.x = cvt_pk_bf16(r[j].x, r[j].y); w.y = cvt_pk_bf16(r[j].z, r[j].w); *((u32x2*)((bf16_t*)outp + (size_t)m * DM) + lane + 64 * j) = w; }
            else *((f32x4*)((float*)outp + (size_t)m * DM) + lane + 64 * j) = r[j];
            ss2 += (r[j].x * r[j].x + r[j].y * r[j].y) + (r[j].z * r[j].z + r[j].w * r[j].w); }
        if (g_next) {
            const float rs2 = 1.0f / sqrtf(wave_sum(ss2) * (1.f / DM) + EPS);
#pragma unroll
            for (int j = 0; j < 8; ++j) { const f32x4 g = *((const f32x4*)g_next + lane + 64 * j); const f32x4 h = r[j] * rs2 * g;
                u32x2 w; w.x = cvt_pk_bf16(h.x, h.y); w.y = cvt_pk_bf16(h.z, h.w); *((u32x2*)(hn + (size_t)m * DM) + lane + 64 * j) = w; }
        }
    }
#undef RN_LOAD
}
__device__ __forceinline__ void ynorm_phase(const bf16_t* yp, const bf16_t* ya, const float* gp, const float* ga, bf16_t* y, int gw, int NGW, int lane) {
    u32x4 np[2], na[2];
#define YN_LOAD(mm) do { _Pragma("unroll") for (int j = 0; j < 2; ++j) { np[j] = *((const u32x4*)(yp + (size_t)(mm) * 1024) + lane + 64 * j); na[j] = *((const u32x4*)(ya + (size_t)(mm) * 1024) + lane + 64 * j); } } while (0)
    int m = gw; if (m < M) YN_LOAD(m);
    for (; m < M; m += NGW) {
        float v[2][2][8]; float ss0 = 0.f, ss1 = 0.f;
#pragma unroll
        for (int j = 0; j < 2; ++j) { const u32x4 w = np[j], q = na[j];
            v[0][j][0] = bf_lo(w.x); v[0][j][1] = bf_hi(w.x); v[0][j][2] = bf_lo(w.y); v[0][j][3] = bf_hi(w.y); v[0][j][4] = bf_lo(w.z); v[0][j][5] = bf_hi(w.z); v[0][j][6] = bf_lo(w.w); v[0][j][7] = bf_hi(w.w);
            v[1][j][0] = bf_lo(q.x); v[1][j][1] = bf_hi(q.x); v[1][j][2] = bf_lo(q.y); v[1][j][3] = bf_hi(q.y); v[1][j][4] = bf_lo(q.z); v[1][j][5] = bf_hi(q.z); v[1][j][6] = bf_lo(q.w); v[1][j][7] = bf_hi(q.w);
#pragma unroll
            for (int e = 0; e < 8; ++e) { ss0 += v[0][j][e] * v[0][j][e]; ss1 += v[1][j][e] * v[1][j][e]; } }
        asm volatile("" ::: "memory");
        if (m + NGW < M) YN_LOAD(m + NGW);
        ss0 = wave_sum(ss0); ss1 = wave_sum(ss1);
        const float rs[2] = {1.0f / sqrtf(ss0 * (1.f / 1024.f) + EPS), 1.0f / sqrtf(ss1 * (1.f / 1024.f) + EPS)};
#pragma unroll
        for (int h = 0; h < 2; ++h) { const float* g = h ? ga : gp;
#pragma unroll
            for (int j = 0; j < 2; ++j) { const f32x4 g0 = *((const f32x4*)g + 2 * (lane + 64 * j)), g1 = *((const f32x4*)g + 2 * (lane + 64 * j) + 1); const float r_ = rs[h];
                u32x4 w; w.x = cvt_pk_bf16(v[h][j][0] * r_ * g0.x, v[h][j][1] * r_ * g0.y); w.y = cvt_pk_bf16(v[h][j][2] * r_ * g0.z, v[h][j][3] * r_ * g0.w);
                w.z = cvt_pk_bf16(v[h][j][4] * r_ * g1.x, v[h][j][5] * r_ * g1.y); w.w = cvt_pk_bf16(v[h][j][6] * r_ * g1.z, v[h][j][7] * r_ * g1.w);
                *((u32x4*)(y + (size_t)m * DM + h * 1024) + lane + 64 * j) = w; } }
    }
#undef YN_LOAD
}
__device__ __forceinline__ float log_sigmoid(float x) { return x < 0.f ? x - log1pf(expf(x)) : -log1pf(expf(-x)); }

__global__ void __launch_bounds__(NTHREADS, 2) mega_fwd(Args args) {
    extern __shared__ __attribute__((aligned(16))) unsigned char lds[];
    cg::grid_group grid = cg::this_grid();
    for (unsigned long long i_ = 0; i_ < args.cg_rounds; ++i_) grid.sync();
    LAS unsigned char* ldsl = (LAS unsigned char*)lds;
    const int G = gridDim.x, bid = blockIdx.x, NGW = G * NWAVES;
    const int wave_s = __builtin_amdgcn_readfirstlane((int)(threadIdx.x >> 6));
#if PROBE_TS >= 0
#define STAMP(k) do { if (bid == 0 && fresh_tid(wave_s) == 0) { const unsigned long long t_ = __builtin_amdgcn_s_memrealtime(); MISC[16 + 2 * (k)] = (unsigned)t_; MISC[17 + 2 * (k)] = (unsigned)(t_ >> 32); } } while (0)
#else
#define STAMP(k) do {} while (0)
#endif
#define PHASE_IDS() const int tid = fresh_tid(wave_s), lane = tid & 63, wave = __builtin_amdgcn_readfirstlane(tid >> 6), gw = bid * NWAVES + wave; (void)lane; (void)gw
    unsigned char* ws = args.ws;
    unsigned* barw = (unsigned*)ws;
    volatile LAS unsigned* MISC = (volatile LAS unsigned*)(ldsl + LDS_BYTES - 256);
    { const int t0 = fresh_tid(wave_s); if (t0 < 64) MISC[t0] = 0u;
      __syncthreads(); }
    const XcdBarrier bar = xcd_barrier_post(barw, MISC + 8, fresh_tid(wave_s));
    STAMP(0);
#define WSP(off) ((bf16_t*)(args.ws + (off)))
#define XIN (args.in[I_X])
#define OUTP (args.out)
#define flog ((float*)(args.ws + WS_FLOG))
#define fb ((float*)(args.ws + WS_FB))
#define WinT WSP(WS_WIN)
#define WoutT WSP(WS_WOUT)
#define WupT WSP(WS_WUP)
#define WdownT WSP(WS_WDOWN)
#define WgateT WSP(WS_WGATE)
#define WpleT WSP(WS_WPLE)
#define WpoolT WSP(WS_WPOOL)
#define HN WSP(WS_HN)
#define U WSP(AR_U)
#define Qb WSP(AR_Q)
#define Kb WSP(AR_K)
#define Vb WSP(AR_V)
#define YP WSP(AR_YP)
#define YA WSP(AR_YA)
#define DP WSP(AR_DP)
#define Y WSP(AR_Y)
#define RAW1 WSP(AR_RAW1)
#define HID WSP(AR_HID)
#define Eb ((bf16_t*)((unsigned char*)args.out + 32 * MiB))
#define RAW2 WSP(WS_RAW2)
#define PBF WSP(WS_PBF)
#define H1 ((bf16_t*)args.out)
#define H2 WSP(WS_ARENA + 32 * MiB)

    PH(0) {
    {
        PHASE_IDS();
        LAS float* wf = (LAS float*)ldsl;
        const float* w_in = args.in[I_WIN]; const float* gpm = args.in[I_GPREMIX];
        {
            f32x4 wa[4], wb[4]; float gk[4];
#pragma unroll
            for (int q = 0; q < 4; ++q) { const int k = tid + q * NTHREADS; const f32x4* wp = (const f32x4*)(w_in + (size_t)k * INW + 4096); wa[q] = wp[0]; wb[q] = wp[1]; gk[q] = gpm[k]; }
#pragma unroll
            for (int q = 0; q < 4; ++q) { const int k = tid + q * NTHREADS; const int l = (k & 255) >> 2, i = k & 3, j = k >> 8;
                LAS f32x4* dst = (LAS f32x4*)(wf + ((j * 4 + i) * 64 + l) * 8); dst[0] = wa[q] * gk[q]; dst[1] = wb[q] * gk[q]; }
        }
        __syncthreads();
        f32x4 nx[8];
        if (gw < M) {
#pragma unroll
            for (int j = 0; j < 8; ++j) nx[j] = __builtin_nontemporal_load((const f32x4*)(XIN + (size_t)gw * DM) + lane + 64 * j); }
        for (int m = gw; m < M; m += NGW) {
            f32x4 v[8]; float ss = 0.f;
#pragma unroll
            for (int j = 0; j < 8; ++j) { v[j] = nx[j]; ss += (v[j].x * v[j].x + v[j].y * v[j].y) + (v[j].z * v[j].z + v[j].w * v[j].w); }
            asm volatile("" ::: "memory");
            if (m + NGW < M) {
#pragma unroll
                for (int j = 0; j < 8; ++j) nx[j] = __builtin_nontemporal_load((const f32x4*)(XIN + (size_t)(m + NGW) * DM) + lane + 64 * j); }
            const float rs = 1.0f / sqrtf(wave_sum(ss) * (1.f / DM) + EPS);
            float fa[8] = {0.f, 0.f, 0.f, 0.f, 0.f, 0.f, 0.f, 0.f};
#pragma unroll
            for (int j = 0; j < 8; ++j)
#pragma unroll
                for (int i = 0; i < 4; ++i) { const LAS f32x4* wp = (const LAS f32x4*)(wf + ((j * 4 + i) * 64 + lane) * 8); const f32x4 w0 = wp[0], w1 = wp[1]; const float xv = v[j][i];
                    fa[0] += xv * w0.x; fa[1] += xv * w0.y; fa[2] += xv * w0.z; fa[3] += xv * w0.w; fa[4] += xv * w1.x; fa[5] += xv * w1.y; fa[6] += xv * w1.z; fa[7] += xv * w1.w; }
#pragma unroll
            for (int c = 0; c < 8; ++c) fa[c] = wave_sum(fa[c]) * rs;
            if (lane < 8) { float fv = fa[0];
#pragma unroll
                for (int c = 1; c < 8; ++c) fv = (lane == c) ? fa[c] : fv;
                flog[((size_t)(m >> 11) * NH + lane) * SEQ + (m & (SEQ - 1))] = log_sigmoid(fv + args.in[I_BF][lane]); }
            u32x2* o8 = (u32x2*)(HN + (size_t)m * DM) + lane;
#pragma unroll
            for (int j = 0; j < 8; ++j) { const f32x4 g = *((const f32x4*)gpm + lane + 64 * j); const f32x4 h = v[j] * rs * g;
                u32x2 w; w.x = cvt_pk_bf16(h.x, h.y); w.y = cvt_pk_bf16(h.z, h.w); o8[64 * j] = w; }
        }
        __syncthreads();
        LAS float* scr = (LAS float*)(ldsl + wave * TR_BYTES);
        constexpr int IT_IN = (DM / 64) * (4096 / 64), IT_POOL1 = (256 / 64) * (256 / 64);
        constexpr int IT_PLE = (PLE / 64) * (DM / 64);
        constexpr int NITEMS = IT_IN + 4 * IT_POOL1 + IT_PLE;
        for (int it = gw; it < NITEMS; it += NGW) {
            int r = it;
            if (r < IT_IN) { p0_transpose_item(args.in[I_WIN], DM, 4096, INW, WinT, 0, scr, r, lane); continue; } r -= IT_IN;
            if (r < IT_PLE) { p0_transpose_item(args.in[I_WPLE], PLE, DM, DM, WpleT, 0, scr, r, lane); continue; } r -= IT_PLE;
            { const int gi = r / IT_POOL1; p0_transpose_item(args.in[I_WPOOL] + (size_t)gi * 65536, 256, 256, 256, WpoolT, gi * 256, scr, r % IT_POOL1, lane); }
        }
        const float* p = args.in[I_P];
        for (int idx = bid * NTHREADS + tid; idx < M * PLE / 8; idx += G * NTHREADS) { const f32x4 a = __builtin_nontemporal_load((const f32x4*)p + 2 * idx), b = __builtin_nontemporal_load((const f32x4*)p + 2 * idx + 1);
            u32x4 w; w.x = cvt_pk_bf16(a.x, a.y); w.y = cvt_pk_bf16(a.z, a.w); w.z = cvt_pk_bf16(b.x, b.y); w.w = cvt_pk_bf16(b.z, b.w); *((u32x4*)PBF + idx) = w; }
    }
    xcd_barrier(bar, fresh_tid(wave_s));
    }
    STAMP(1);

#if PROBE_PHASE == 100
    for (int i_ = 0; i_ < 16; ++i_) xcd_barrier(bar, fresh_tid(wave_s));
#endif
    PH(1) {
    {
        { PHASE_IDS();
          if (bid < NB * NH && wave == 0) {
            const f32x4* fl = (const f32x4*)(flog + (size_t)bid * SEQ + 32 * lane); f32x4 v[8]; float run = 0.f;
#pragma unroll
            for (int j = 0; j < 8; ++j) v[j] = fl[j];
#pragma unroll
            for (int j = 0; j < 8; ++j) { v[j].x += run; v[j].y += v[j].x; v[j].z += v[j].y; v[j].w += v[j].z; run = v[j].w; }
            float incl = run;
#pragma unroll
            for (int o = 1; o < 64; o <<= 1) { const float t = __shfl_up(incl, o); if (lane >= o) incl += t; }
            const float excl = incl - run;
            f32x4* fo = (f32x4*)(fb + (size_t)bid * SEQ + 32 * lane);
#pragma unroll
            for (int j = 0; j < 8; ++j) fo[j] = (v[j] + excl) * -11.313708498984761f;
          } }
        pg8::Gemm g{HN, WinT, DM, DM, DM, 0}; pg8::StaticOrder S; S.init(M, 4096, G, bid);
        pg8::EpiG<0> E{U, 1024, 1024, (size_t)(AR_Q - AR_U) / 2, nullptr, nullptr};
        pg8::gemm_phase(ldsl, g, S, E, wave_s);
    }
    xcd_barrier(bar, fresh_tid(wave_s));
    }
    STAMP(2); STAMP(3);

    PH(3) {
    {
        const int xcd = bid & 7, ix = bid >> 3;
        const int bh = (xcd * 4 + (ix >> 3)) & 31, qb = ix & 7, b = bh >> 3, h = bh & 7;
        if (bid < 256) {
            att::BlockRef cur;
            const size_t rowb = (size_t)b * SEQ;
            cur.Q = Qb + (rowb + (size_t)qb * 256) * 1024 + h * HD; cur.K = Kb + rowb * 1024 + h * HD; cur.V = Vb + rowb * 1024 + h * HD;
            cur.FB = fb + (size_t)bh * SEQ; cur.O = YA + (rowb + (size_t)qb * 256) * 1024 + h * HD; cur.P0 = qb * 256;
            att::Seam S;
            att::prime(cur, (char*)lds, S, wave_s);
            att::block(cur, cur, (char*)lds, S, wave_s);
            asm volatile("s_waitcnt vmcnt(0)" ::: "memory");
            __syncthreads();
        }
        {
            pg8::SingleUnit S; const int id = bh * 4 + qb; S.valid = (bid < 256 && qb < 4) ? 1 : 0; S.pm = id >> 2; S.pn = id & 3;
            if (S.valid) {
                const int tid = fresh_tid(wave_s), cc = tid & 31, tg = tid >> 5, gi = S.pn, w = 2 << gi;
                const int t0 = S.pm * 256 + tg * 16, pos0 = t0 & (SEQ - 1), col = gi * 256 + cc * 8;
                const bf16_t* up = U + (size_t)t0 * POOLW + col; bf16_t* dp = DP + (size_t)t0 * POOLW + col;
                float sm[8] = {0.f, 0.f, 0.f, 0.f, 0.f, 0.f, 0.f, 0.f};
                for (int j = 1; j < w; ++j) if (pos0 - j >= 0) { const u32x4 v = *(const u32x4*)(up - (size_t)j * POOLW);
                    sm[0] += bf_lo(v.x); sm[1] += bf_hi(v.x); sm[2] += bf_lo(v.y); sm[3] += bf_hi(v.y); sm[4] += bf_lo(v.z); sm[5] += bf_hi(v.z); sm[6] += bf_lo(v.w); sm[7] += bf_hi(v.w); }
                for (int i = 0; i < 16; ++i) { const int pos = pos0 + i; const u32x4 v = *(const u32x4*)(up + (size_t)i * POOLW);
                    const float f[8] = {bf_lo(v.x), bf_hi(v.x), bf_lo(v.y), bf_hi(v.y), bf_lo(v.z), bf_hi(v.z), bf_lo(v.w), bf_hi(v.w)};
                    const float inv = 1.0f / (float)((pos + 1 < w) ? pos + 1 : w);
                    float d[8];
#pragma unroll
                    for (int e = 0; e < 8; ++e) { sm[e] += f[e]; d[e] = sm[e] * inv - f[e]; }
                    u32x4 o; o.x = cvt_pk_bf16(d[0], d[1]); o.y = cvt_pk_bf16(d[2], d[3]); o.z = cvt_pk_bf16(d[4], d[5]); o.w = cvt_pk_bf16(d[6], d[7]);
                    *(u32x4*)(dp + (size_t)i * POOLW) = o;
                    if (pos - w + 1 >= 0) { const u32x4 q = *(const u32x4*)(up + (size_t)(i - w + 1) * POOLW);
                        sm[0] -= bf_lo(q.x); sm[1] -= bf_hi(q.x); sm[2] -= bf_lo(q.y); sm[3] -= bf_hi(q.y); sm[4] -= bf_lo(q.z); sm[5] -= bf_hi(q.z); sm[6] -= bf_lo(q.w); sm[7] -= bf_hi(q.w); } }
                asm volatile("s_waitcnt vmcnt(0)" ::: "memory");
                __syncthreads();
            }
            pg8::Gemm g{DP, WpoolT, POOLW, 256, 256, 256};
            pg8::EpiG<4> E{YP, POOLW, 0, 0, args.in[I_POOLSCALE], nullptr};
            pg8::gemm_phase(ldsl, g, S, E, wave_s);
        }
        {
            pg8::ListSched S; S.id0 = __builtin_amdgcn_readfirstlane((bh * 4 + qb) * 2); S.n = __builtin_amdgcn_readfirstlane((bid < 256 && qb < 4) ? 2 : 0); S.nN = DM / 256;
            pg8::Gemm g{PBF, WpleT, PLE, PLE, PLE, 0}; pg8::EpiG<0> E{Eb, DM, 0, 0, nullptr, nullptr};
            pg8::gemm_phase(ldsl, g, S, E, wave_s);
        }
        __syncthreads();
        {
            const int tid = fresh_tid(wave_s), lane = tid & 63, wave = __builtin_amdgcn_readfirstlane(tid >> 6);
            LAS unsigned* T = (LAS unsigned*)ldsl;
            constexpr int T_OUT = 16 * 8, T_UP = 16 * 32, T_DOWN = 64 * 8, T_GATE = 16 * 8, NT2 = T_OUT + T_UP + T_DOWN + T_GATE, CH = 4;
            unsigned* ctr = barw + XCD_BAR_WORDS + 16;
            f32x4 va[16], vb[16];
            bf16_t* aWT = nullptr; int aK = 0, ak0 = 0, an0 = 0; bf16_t* bWT = nullptr; int bK = 0, bk0 = 0, bn0 = 0;
            unsigned cbase = 0; int ci = CH; int ta, tb;
#define TR_NEXT(dst) do { if (ci == CH) { if (tid == 0) MISC[12] = __hip_atomic_fetch_add(ctr, (unsigned)CH, __ATOMIC_RELAXED, __HIP_MEMORY_SCOPE_AGENT); \
                __syncthreads(); cbase = MISC[12]; __syncthreads(); ci = 0; } \
            dst = (int)cbase + ci; ++ci; if (dst >= NT2) dst = -1; } while (0)
#define TR_DECODE_LOAD(tt, V, xWT, xK, xk0, xn0) do { int r_ = (tt), nnb_, ldw_; const float* W_; \
            if (r_ < T_OUT) { W_ = args.in[I_WOUT]; ldw_ = DM; xK = DM; xWT = WoutT; nnb_ = 8; } \
            else if ((r_ -= T_OUT) < T_UP) { W_ = args.in[I_WUP]; ldw_ = DFF; xK = DM; xWT = WupT; nnb_ = 32; } \
            else if ((r_ -= T_UP) < T_DOWN) { W_ = args.in[I_WDOWN]; ldw_ = DM; xK = DFF; xWT = WdownT; nnb_ = 8; } \
            else { r_ -= T_DOWN; W_ = args.in[I_WGATE]; ldw_ = DM; xK = DM; xWT = WgateT; nnb_ = 8; } \
            xk0 = 128 * (r_ / nnb_); xn0 = 256 * (r_ % nnb_); \
            const float* src_ = W_ + (size_t)(xk0 + 16 * wave) * ldw_ + xn0 + 4 * lane; \
            _Pragma("unroll") for (int r = 0; r < 16; ++r) V[r] = __builtin_nontemporal_load((const f32x4*)(src_ + (size_t)r * ldw_)); } while (0)
#define TR_PROCESS(V, xWT, xK, xk0, xn0, tcur) do { \
                bf16_t* const sWT_ = xWT; const int sK_ = xK, sk0_ = xk0, sn0_ = xn0; \
                _Pragma("unroll") for (int rp = 0; rp < 8; ++rp) _Pragma("unroll") for (int j = 0; j < 4; ++j) T[(4 * lane + j) * 65 + 8 * wave + rp] = cvt_pk_bf16(V[2 * rp][j], V[2 * rp + 1][j]); \
                TR_NEXT(tcur); \
                __syncthreads(); \
                if (tcur >= 0) TR_DECODE_LOAD(tcur, V, xWT, xK, xk0, xn0); \
                {   const int c = lane & 15, nn = lane >> 4; \
                    _Pragma("unroll") for (int i = 0; i < 8; ++i) { const int n = 4 * (wave + 8 * i) + nn; const LAS unsigned* sp = T + n * 65 + 4 * c; \
                        u32x4 o; o.x = sp[0]; o.y = sp[1]; o.z = sp[2]; o.w = sp[3]; \
                        *(u32x4*)(sWT_ + (size_t)(sn0_ + n) * sK_ + sk0_ + 8 * c) = o; } } \
                __syncthreads(); } while (0)
            TR_NEXT(ta); TR_NEXT(tb);
            if (ta >= 0) TR_DECODE_LOAD(ta, va, aWT, aK, ak0, an0);
            if (tb >= 0) TR_DECODE_LOAD(tb, vb, bWT, bK, bk0, bn0);
            while (ta >= 0) {
                TR_PROCESS(va, aWT, aK, ak0, an0, ta);
                if (tb < 0) break;
                TR_PROCESS(vb, bWT, bK, bk0, bn0, tb);
            }
#undef TR_PROCESS
#undef TR_NEXT
#undef TR_DECODE_LOAD
        }
    }
    xcd_barrier(bar, fresh_tid(wave_s));
    }
    STAMP(4);

    PH(4) {
    { PHASE_IDS();
    ynorm_phase(YP, YA, args.in[I_GPOOLOUT], args.in[I_GATTNOUT], Y, gw, NGW, lane); }
    xcd_barrier(bar, fresh_tid(wave_s));
    }
    STAMP(5);

    PH(5) {
    {
        pg8::Gemm g{Y, WoutT, DM, DM, DM, 0}; pg8::StaticOrder S; S.init(M, DM, G, bid);
        pg8::EpiG<0> E{RAW1, DM, 0, 0, nullptr, nullptr};
        pg8::gemm_phase(ldsl, g, S, E, wave_s);
    }
    xcd_barrier(bar, fresh_tid(wave_s));
    }
    STAMP(6);

    PH(6) {
    { PHASE_IDS();
    resnorm_phase<false, true>(XIN, RAW1, args.in[I_GPOSTMIX], H1, args.in[I_GPREMLP], HN, gw, NGW, lane); }
    xcd_barrier(bar, fresh_tid(wave_s));
    }
    STAMP(7);

    PH(7) {
    {
        pg8::Gemm g{HN, WupT, DM, DM, DM, 0}; pg8::StaticOrder S; S.init(M, DFF, G, bid);
        pg8::EpiG<2> E{HID, DFF, 0, 0, nullptr, nullptr};
        pg8::gemm_phase(ldsl, g, S, E, wave_s);
    }
    xcd_barrier(bar, fresh_tid(wave_s));
    }
    STAMP(8);

    PH(8) {
    {
        pg8::Gemm g{HID, WdownT, DFF, DFF, DFF, 0}; pg8::StaticOrder S; S.init(M, DM, G, bid);
        pg8::EpiG<0> E{RAW2, DM, 0, 0, nullptr, nullptr};
        pg8::gemm_phase(ldsl, g, S, E, wave_s);
    }
    xcd_barrier(bar, fresh_tid(wave_s));
    }
    STAMP(9);

    PH(9) {
    { PHASE_IDS();
    resnorm_phase<true, true>(H1, RAW2, args.in[I_GPOSTMLP], H2, args.in[I_GPLEGATE], HN, gw, NGW, lane); }
    xcd_barrier(bar, fresh_tid(wave_s));
    }
    STAMP(10);

    PH(10) {
    {
        pg8::StaticOrder S; S.init(M, DM, G, bid);
        { pg8::Gemm g{HN, WgateT, DM, DM, DM, 0}; pg8::EpiG<3> E{RAW2, DM, 0, 0, nullptr, Eb}; pg8::gemm_phase(ldsl, g, S, E, wave_s); }
    }
    xcd_barrier(bar, fresh_tid(wave_s));
    }
    STAMP(11);

    PH(11) {
    { PHASE_IDS();
    resnorm_phase<true, false>(H2, RAW2, args.in[I_GPOSTPLE], OUTP, nullptr, nullptr, gw, NGW, lane); }
    }
#if PROBE_TS >= 0
    STAMP(12);
    if (bid == 0 && fresh_tid(wave_s) == 0) { asm volatile("s_waitcnt vmcnt(0)" ::: "memory");
        const unsigned long long a_ = ((unsigned long long)MISC[17 + 2 * PROBE_TS] << 32) | MISC[16 + 2 * PROBE_TS], b_ = ((unsigned long long)MISC[17 + 2 * (PROBE_TSB)] << 32) | MISC[16 + 2 * (PROBE_TSB)];
        OUTP[0] += (float)(b_ - a_) * 0.01f - (float)PROBE_OFF; }
#endif
}

#undef WSP
#undef XIN
#undef OUTP
#undef flog
#undef fb
#undef WinT
#undef WoutT
#undef WupT
#undef WdownT
#undef WgateT
#undef WpleT
#undef WpoolT
#undef HN
#undef U
#undef Qb
#undef Kb
#undef Vb
#undef YP
#undef YA
#undef DP
#undef Y
#undef RAW1
#undef HID
#undef Eb
#undef RAW2
#undef PBF
#undef H1
#undef H2

extern "C" void kernel_launch(void* const* d_in, const int* in_sizes, int n_in, void* d_out, int out_size, void* d_ws, size_t ws_size, hipStream_t stream) {
    static int grid = 0;
    if (grid == 0) {
        if (n_in != 19 || in_sizes[0] != M * DM || out_size != M * DM || ws_size < WS_END) {
            fprintf(stderr, "kernel_launch: unexpected shapes (n_in %d in0 %d out %d ws %zu)\n", n_in, n_in > 0 ? in_sizes[0] : -1, out_size, ws_size); grid = -1; return; }
        int dev = 0, cus = 0, per_cu = 0;
        hipGetDevice(&dev); hipDeviceGetAttribute(&cus, hipDeviceAttributeMultiprocessorCount, dev);
        if (hipFuncSetAttribute((const void*)mega_fwd, hipFuncAttributeMaxDynamicSharedMemorySize, LDS_BYTES) != hipSuccess) { fprintf(stderr, "kernel_launch: hipFuncSetAttribute failed\n"); grid = -1; return; }
        if (hipOccupancyMaxActiveBlocksPerMultiprocessor(&per_cu, (const void*)mega_fwd, NTHREADS, LDS_BYTES) != hipSuccess || per_cu < 1) {
            fprintf(stderr, "kernel_launch: occupancy query says %d\n", per_cu); per_cu = 1; }
        (void)hipGetLastError();
        grid = cus * 1;
        if (grid != 256) fprintf(stderr, "kernel_launch: grid %d (expected 256)\n", grid);
    }
    if (grid < 0) return;
    if (hipMemsetAsync(d_ws, 0, (XCD_BAR_WORDS + 64) * sizeof(unsigned), stream) != hipSuccess) { fprintf(stderr, "kernel_launch: hipMemsetAsync failed\n"); return; }
    Args a{};
    for (int i = 0; i < 19; ++i) a.in[i] = (const float*)d_in[i];
    a.out = (float*)d_out; a.ws = (unsigned char*)d_ws;
    void* kargs[] = {&a};
    hipError_t e = hipLaunchCooperativeKernel((const void*)mega_fwd, dim3(grid), dim3(NTHREADS), kargs, LDS_BYTES, stream);
    if (e != hipSuccess) fprintf(stderr, "kernel_launch: cooperative launch failed: %s (grid %d)\n", hipGetErrorString(e), grid);
}
```

```cpp
#include <hip/hip_runtime.h>
#include <hip/hip_bf16.h>
#include <hip/hip_cooperative_groups.h>
#include <cstdio>
#include <cstdint>
namespace cg = cooperative_groups;

#define LAS __attribute__((address_space(3)))
typedef unsigned short bf16_t;
typedef short bf16x8 __attribute__((ext_vector_type(8)));
typedef short s16x4 __attribute__((ext_vector_type(4)));
typedef float f32x4 __attribute__((ext_vector_type(4)));
typedef float f32x2 __attribute__((ext_vector_type(2)));
typedef float f32x16 __attribute__((ext_vector_type(16)));
typedef unsigned u32x4 __attribute__((ext_vector_type(4)));
typedef unsigned u32x2 __attribute__((ext_vector_type(2)));

constexpr int DM = 2048, SEQ = 2048, NB = 4, M = NB * SEQ, POOLW = 1024, ATTW = 1024, NH = 8, HD = 128, DFF = 8192, PLE = 256, INW = 4104;
constexpr float EPS = 1e-6f;

constexpr size_t MiB = 1u << 20;
constexpr size_t WS_FLOG = 1 * MiB;
constexpr size_t WS_FB = 1 * MiB + 512 * 1024;
constexpr size_t WS_WIN = 2 * MiB, WS_WOUT = 18 * MiB, WS_WUP = 26 * MiB, WS_WDOWN = 58 * MiB, WS_WGATE = 90 * MiB, WS_WPLE = 98 * MiB, WS_WPOOL = 99 * MiB;
constexpr size_t WS_HN = 100 * MiB;
constexpr size_t WS_ARENA = 132 * MiB;
constexpr size_t AR_U = WS_ARENA, AR_Q = WS_ARENA + 16 * MiB, AR_K = WS_ARENA + 32 * MiB, AR_V = WS_ARENA + 48 * MiB;
constexpr size_t AR_YP = WS_ARENA + 64 * MiB, AR_YA = WS_ARENA + 80 * MiB, AR_DP = WS_ARENA + 96 * MiB;
constexpr size_t AR_Y = AR_YP;
constexpr size_t AR_RAW1 = WS_ARENA + 32 * MiB;
constexpr size_t AR_HID = WS_ARENA;
constexpr size_t AR_E = WS_ARENA;
constexpr size_t WS_RAW2 = WS_WUP;
constexpr size_t WS_PBF = 260 * MiB;
constexpr size_t WS_STA = 1 * MiB + 256 * 1024;
constexpr size_t WS_STP = 264 * MiB;
constexpr size_t WS_END = 265 * MiB;

__device__ __forceinline__ unsigned cvt_pk_bf16(float lo, float hi) { unsigned r; asm volatile("v_cvt_pk_bf16_f32 %0, %1, %2" : "=v"(r) : "v"(lo), "v"(hi)); return r; }
__device__ __forceinline__ int fresh_tid(int wv) { int l; asm volatile("v_mbcnt_lo_u32_b32 %0, -1, 0\n\tv_mbcnt_hi_u32_b32 %0, -1, %0" : "=v"(l)); return (wv << 6) | l; }
__device__ __forceinline__ float bf_lo(unsigned w) { return __uint_as_float(w << 16); }
__device__ __forceinline__ float bf_hi(unsigned w) { return __uint_as_float(w & 0xffff0000u); }
__device__ __forceinline__ float wave_sum(float v) {
#define WS_SWZ(o) v += __int_as_float(__builtin_amdgcn_ds_swizzle(__float_as_int(v), 0x1f | ((o) << 10)))
    WS_SWZ(1); WS_SWZ(2); WS_SWZ(4); WS_SWZ(8); WS_SWZ(16);
#undef WS_SWZ
    const auto rr = __builtin_amdgcn_permlane32_swap(__float_as_uint(v), __float_as_uint(v), false, false);
    return __uint_as_float(rr[0]) + __uint_as_float(rr[1]);
}

namespace pg8 {
constexpr int BM = 256, BK = 64, HALF = 128, HTB = HALF * BK * 2, STAGE_BYTES = 8 * HTB, NXCD = 8, WGM = 8;
__host__ __device__ __forceinline__ int lds_byte(int r, int c) { const int st = (r >> 4) * 2 + (c >> 5), rr = r & 15, cc = c & 31, ob = rr * 64 + cc * 2; return st * 1024 + (ob ^ (((ob >> 9) & 1) << 5)); }
__host__ __device__ __forceinline__ void stage_rc(int b, int& R, int& C) { const int st = b / 1024, sb = b % 1024, swz = sb ^ (((sb >> 9) & 1) << 5); R = (st >> 1) * 16 + swz / 64; C = (st & 1) * 32 + (swz % 64) / 2; }
__host__ __device__ __forceinline__ int perm32(int rho) { const int n = rho >> 4, i = rho & 15; return 8 * (i >> 2) + 4 * n + (i & 3); }

struct Unit { int pm, pn; };
struct Gemm { const bf16_t* A; const bf16_t* Bt; int lda, ldb, K, a_pn_koff; };

struct StaticOrder {
    int nM, nN, nwg, G, c;
    __device__ void init(int M_, int N_, int G_, int c_) { nM = M_ / BM; nN = N_ / BM; nwg = nM * nN; G = G_; c = c_; }
    __device__ bool next(int i, Unit& u) const {
        const long L = (long)i * G + c; if (L >= nwg) return false;
        int wgid = (int)L; { const int q = nwg / NXCD, r = nwg % NXCD, xcd = wgid % NXCD, off = wgid / NXCD; wgid = (xcd < r ? xcd * (q + 1) : r * (q + 1) + (xcd - r) * q) + off; }
        const int nig = WGM * nN, gid = wgid / nig, fm = gid * WGM, gsz = (nM - fm) < WGM ? (nM - fm) : WGM;
        u.pm = fm + ((wgid % nig) % gsz); u.pn = (wgid % nig) / gsz; return true;
    }
};
struct ListSched {
    int id0, n, nN;
    __device__ bool next(int i, Unit& u) const { if (i >= n) return false; const int id = id0 + i; u.pm = id / nN; u.pn = id % nN; return true; }
};
struct SingleUnit {
    int pm, pn, valid;
    __device__ bool next(int i, Unit& u) const { if (i != 0 || !valid) return false; u.pm = pm; u.pn = pn; return true; }
};

template <int ACT> struct EpiG {
    static constexpr bool PERM = true;
    bf16_t* O; int ldc; int split_cols; size_t split_stride; const float* colscale; const bf16_t* aux; float* stats;
    __device__ __forceinline__ void operator()(const f32x4 (&acc)[2][2][4][2], const Unit& u, int wr, int wc, int fr, int fq) const {
        const int row0 = u.pm * BM + wr * 64 + fr; int colt = u.pn * BM; bf16_t* base = O;
        if (split_cols) { const int t = colt / split_cols; base += (size_t)t * split_stride; colt -= t * split_cols; }
        const int col0 = colt + wc * 32 + 8 * fq, gcol0 = u.pn * BM + wc * 32 + 8 * fq;
        f32x4 cs[2][2];
        if (ACT == 4) {
#pragma unroll
            for (int bj = 0; bj < 2; ++bj)
#pragma unroll
                for (int n = 0; n < 2; ++n) cs[bj][n] = *(const f32x4*)(colscale + gcol0 + bj * HALF + 4 * n);
        }
        u32x4 evs[2][4][2];
        if (ACT == 3) {
#pragma unroll
            for (int ai = 0; ai < 2; ++ai)
#pragma unroll
                for (int m = 0; m < 4; ++m)
#pragma unroll
                    for (int bj = 0; bj < 2; ++bj) evs[ai][m][bj] = *(const u32x4*)(aux + (size_t)(row0 + ai * HALF + m * 16) * ldc + col0 + bj * HALF);
        }
#pragma unroll
        for (int ai = 0; ai < 2; ++ai)
#pragma unroll
            for (int m = 0; m < 4; ++m) { const size_t roff = (size_t)(row0 + ai * HALF + m * 16) * ldc + col0; float ssq = 0.f; (void)ssq;
#pragma unroll
                for (int bj = 0; bj < 2; ++bj) { f32x4 v0 = acc[ai][bj][m][0], v1 = acc[ai][bj][m][1];
                    if (ACT == 2) {
#pragma unroll
                        for (int e = 0; e < 4; ++e) { float a = fmaxf(v0[e], 0.f), b = fmaxf(v1[e], 0.f); v0[e] = a * a; v1[e] = b * b; }
                    }
                    if (ACT == 3) { const u32x4 ev = evs[ai][m][bj];
                        const float e0[4] = {bf_lo(ev.x), bf_hi(ev.x), bf_lo(ev.y), bf_hi(ev.y)}, e1[4] = {bf_lo(ev.z), bf_hi(ev.z), bf_lo(ev.w), bf_hi(ev.w)};
#pragma unroll
                        for (int e = 0; e < 4; ++e) { v0[e] = __builtin_amdgcn_rcpf(1.f + __builtin_amdgcn_exp2f(-1.4426950408889634f * v0[e])) * e0[e];
                                                      v1[e] = __builtin_amdgcn_rcpf(1.f + __builtin_amdgcn_exp2f(-1.4426950408889634f * v1[e])) * e1[e]; }
                    }
                    if (ACT == 4) { v0 = v0 * cs[bj][0]; v1 = v1 * cs[bj][1];
                        ssq += (v0[0] * v0[0] + v0[1] * v0[1]) + (v0[2] * v0[2] + v0[3] * v0[3]) + (v1[0] * v1[0] + v1[1] * v1[1]) + (v1[2] * v1[2] + v1[3] * v1[3]); }
                    u32x4 w; w.x = cvt_pk_bf16(v0[0], v0[1]); w.y = cvt_pk_bf16(v0[2], v0[3]); w.z = cvt_pk_bf16(v1[0], v1[1]); w.w = cvt_pk_bf16(v1[2], v1[3]);
                    *(u32x4*)(base + roff + bj * HALF) = w; }
                if (ACT == 4) {
                    ssq += __int_as_float(__builtin_amdgcn_ds_swizzle(__float_as_int(ssq), 0x1f | (16 << 10)));
                    const auto rr = __builtin_amdgcn_permlane32_swap(__float_as_uint(ssq), __float_as_uint(ssq), false, false);
                    ssq = __uint_as_float(rr[0]) + __uint_as_float(rr[1]);
                    if (fq == 0) stats[(size_t)(row0 + ai * HALF + m * 16) * 16 + u.pn * 4 + wc] = ssq; } }
    }
};

template <bool MID = false, class Epi, class Sched>
__device__ __forceinline__ void gemm_phase(LAS unsigned char* lds, const Gemm g, const Sched& S, const Epi& E, int wv, const LAS float* rho = nullptr) {
    constexpr bool ALIGN_EPI = true;
    const int tid = fresh_tid(wv), wid = __builtin_amdgcn_readfirstlane(tid >> 6), lane = tid & 63, wr = wid >> 2, wc = wid & 3, fr = lane & 15, fq = lane >> 4;
    const int K = g.K, nt = K / BK;
    unsigned voffA[2], voffB[2];
#pragma unroll
    for (int i = 0; i < 2; ++i) { int R, C; stage_rc(tid * 16 + i * 8192, R, C); const int Rb = Epi::PERM ? ((R & ~31) + perm32(R & 31)) : R;
        voffA[i] = (unsigned)(R * g.lda + C) * 2u; voffB[i] = (unsigned)(Rb * g.ldb + C) * 2u; }
    const size_t kstep = (size_t)(BK * 2);
    const size_t hstepA = (size_t)HALF * g.lda * 2, hstepB = (size_t)HALF * g.ldb * 2;
    const size_t tstepA = 2 * hstepA, tstepB = 2 * hstepB;
    const unsigned ldsw = (unsigned)wid * 1024u;
    const int aoff = lds_byte(wr * 64 + fr, fq * 8), boff = lds_byte(wc * 32 + fr, fq * 8);
#define PG8_SA(b, h) (((b) * 2 + (h)) * HTB)
#define PG8_SB(b, h) ((4 + (b) * 2 + (h)) * HTB)
#define PG8_STAGE(bufoff, gbase, voff) do { _Pragma("unroll") for (int _i = 0; _i < 2; ++_i) \
        __builtin_amdgcn_global_load_lds((const unsigned*)((const char*)(gbase) + (voff)[_i]), (LAS unsigned*)(lds + (bufoff) + ldsw + _i * 8192), 16, 0, 0); } while (0)
#define PG8_LDA(dst, b, h) do { _Pragma("unroll") for (int m = 0; m < 4; ++m) _Pragma("unroll") for (int k = 0; k < 2; ++k) dst[m][k] = *(const LAS bf16x8*)(lds + PG8_SA(b, h) + aoff + m * 2048 + k * 1024); } while (0)
#define PG8_LDB(dst, b, h) do { _Pragma("unroll") for (int n = 0; n < 2; ++n) _Pragma("unroll") for (int k = 0; k < 2; ++k) dst[n][k] = *(const LAS bf16x8*)(lds + PG8_SB(b, h) + boff + n * 2048 + k * 1024); } while (0)
#define PG8_MMA(ai, bj, At, Bt) do { __builtin_amdgcn_s_setprio(1); _Pragma("unroll") for (int m = 0; m < 4; ++m) _Pragma("unroll") for (int n = 0; n < 2; ++n) _Pragma("unroll") for (int k = 0; k < 2; ++k) \
        acc[ai][bj][m][n] = __builtin_amdgcn_mfma_f32_16x16x32_bf16(Bt[n][k], At[m][k], acc[ai][bj][m][n], 0, 0, 0); __builtin_amdgcn_s_setprio(0); } while (0)
#define PG8_WAIT_V(n) asm volatile("s_waitcnt vmcnt(" #n ")" ::: "memory")
#define PG8_WAIT_L(n) asm volatile("s_waitcnt lgkmcnt(" #n ")" ::: "memory")
#define PG8_BAR __builtin_amdgcn_s_barrier()
#define PG8_SCHED __builtin_amdgcn_sched_barrier(0)
    Unit cur, nxt; int ui = 0;
    if (!S.next(0, cur)) return;
    f32x4 acc[2][2][4][2];
#pragma unroll
    for (int a = 0; a < 2; ++a)
#pragma unroll
        for (int b = 0; b < 2; ++b)
#pragma unroll
            for (int m = 0; m < 4; ++m)
#pragma unroll
                for (int n = 0; n < 2; ++n) acc[a][b][m][n] = (f32x4){0.f, 0.f, 0.f, 0.f};
    bf16x8 At[4][2], B0[2][2], B1[2][2];
    const char* cA = (const char*)g.A + (size_t)cur.pm * tstepA + (size_t)cur.pn * g.a_pn_koff * 2; const char* cB = (const char*)g.Bt + (size_t)cur.pn * tstepB;
    PG8_STAGE(PG8_SB(0, 0), cB, voffB); PG8_STAGE(PG8_SB(0, 1), cB + hstepB, voffB); PG8_STAGE(PG8_SA(0, 0), cA, voffA); PG8_STAGE(PG8_SA(0, 1), cA + hstepA, voffA);
    if (wr == 1) PG8_BAR;
    PG8_WAIT_V(2); PG8_BAR;
    PG8_STAGE(PG8_SB(1, 0), cB + kstep, voffB); PG8_STAGE(PG8_SA(1, 0), cA + kstep, voffA); PG8_STAGE(PG8_SB(1, 1), cB + hstepB + kstep, voffB);
    PG8_WAIT_V(6); PG8_BAR;
    for (;;) {
        const bool has_next = S.next(ui + 1, nxt);
        const char* nA = has_next ? (const char*)g.A + (size_t)nxt.pm * tstepA + (size_t)nxt.pn * g.a_pn_koff * 2 : cA; const char* nB = has_next ? (const char*)g.Bt + (size_t)nxt.pn * tstepB : cB;
        asm volatile("" : "+s"(nA), "+s"(nB));
        for (int t = 0; t < nt; t += 2) {
            const bool last = (t == nt - 2);
            if (MID && t == (nt >> 1)) {
#pragma unroll
                for (int a = 0; a < 2; ++a)
#pragma unroll
                    for (int m = 0; m < 4; ++m) { const float rh = rho[a * HALF + wr * 64 + m * 16 + fr];
#pragma unroll
                        for (int b = 0; b < 2; ++b)
#pragma unroll
                            for (int n = 0; n < 2; ++n) acc[a][b][m][n] = acc[a][b][m][n] * rh; }
            }
            const char* a1 = cA + (size_t)(t + 1) * kstep;
            const char* a2 = last ? nA : cA + (size_t)(t + 2) * kstep; const char* b2 = last ? nB : cB + (size_t)(t + 2) * kstep;
            const char* a3 = a2 + kstep; const char* b3 = b2 + kstep;
            PG8_LDB(B0, 0, 0); PG8_LDB(B1, 0, 1); PG8_SCHED; PG8_LDA(At, 0, 0); PG8_STAGE(PG8_SA(1, 1), a1 + hstepA, voffA);
            PG8_WAIT_V(8); PG8_WAIT_L(0); PG8_BAR; PG8_MMA(0, 0, At, B0); PG8_MMA(0, 1, At, B1); PG8_BAR; PG8_SCHED;
            PG8_LDA(At, 0, 1); PG8_STAGE(PG8_SB(0, 0), b2, voffB); PG8_STAGE(PG8_SB(0, 1), b2 + hstepB, voffB); PG8_STAGE(PG8_SA(0, 0), a2, voffA);
            PG8_WAIT_V(8); PG8_WAIT_L(0); PG8_BAR; PG8_MMA(1, 0, At, B0); PG8_MMA(1, 1, At, B1); PG8_BAR; PG8_SCHED;
            PG8_LDB(B0, 1, 0); PG8_LDB(B1, 1, 1); PG8_SCHED; PG8_LDA(At, 1, 0); PG8_STAGE(PG8_SA(0, 1), a2 + hstepA, voffA);
            PG8_WAIT_V(8); PG8_WAIT_L(0); PG8_BAR; PG8_MMA(0, 0, At, B0); PG8_MMA(0, 1, At, B1); PG8_BAR; PG8_SCHED;
            PG8_LDA(At, 1, 1); PG8_STAGE(PG8_SB(1, 0), b3, voffB); PG8_STAGE(PG8_SB(1, 1), b3 + hstepB, voffB); PG8_STAGE(PG8_SA(1, 0), a3, voffA);
            PG8_WAIT_V(8); PG8_WAIT_L(0); PG8_BAR; PG8_MMA(1, 0, At, B0); PG8_MMA(1, 1, At, B1); PG8_BAR; PG8_SCHED;
        }
        if constexpr (ALIGN_EPI) { if (wr == 0) PG8_BAR; }
        { const int t2 = fresh_tid(wv), w2 = __builtin_amdgcn_readfirstlane(t2 >> 6), l2 = t2 & 63; E(acc, cur, w2 >> 2, w2 & 3, l2 & 15, l2 >> 4); }
        if (!has_next) break;
#pragma unroll
        for (int a = 0; a < 2; ++a)
#pragma unroll
            for (int b = 0; b < 2; ++b)
#pragma unroll
                for (int m = 0; m < 4; ++m)
#pragma unroll
                    for (int n = 0; n < 2; ++n) acc[a][b][m][n] = (f32x4){0.f, 0.f, 0.f, 0.f};
        cur = nxt; cA = nA; cB = nB; ++ui;
        if constexpr (ALIGN_EPI) { if (wr == 1) PG8_BAR; }
    }
    PG8_WAIT_V(0);
    if constexpr (!ALIGN_EPI) { if (wr == 0) PG8_BAR; }
    PG8_BAR;
#undef PG8_SA
#undef PG8_SB
#undef PG8_STAGE
#undef PG8_LDA
#undef PG8_LDB
#undef PG8_MMA
#undef PG8_WAIT_V
#undef PG8_WAIT_L
#undef PG8_BAR
#undef PG8_SCHED
}
}

namespace att {
constexpr int D = 128, LD = 1024, LDO = 2048;
constexpr float SCALE = 0.08838834764831845f;
constexpr float THR = 8.f;
constexpr int NW = 8, QBLK = 32, KVBLK = 64, QB = NW * QBLK;
constexpr int SHM_V = KVBLK * D * 2, SHM_K = KVBLK * D * 2;
constexpr int OFF_WS = 2 * SHM_V + 2 * SHM_K, OFF_BIAS = OFF_WS + NW * 64 * 4, LDS_BYTES = OFF_BIAS + 512;
typedef bf16_t bf16;
#define KSWZ(row, colB) ((row) * 256 + ((colB) ^ (((row) & 7) << 4)))
#define SBAR() __builtin_amdgcn_sched_barrier(0)
__device__ __forceinline__ int v_st(int k, int c) { const int kk = (k & ~0xC) | ((k & 4) << 1) | ((k & 8) >> 1); return ((kk >> 3) * 4 + (c >> 5)) * 512 + ((kk & 7) * 32 + (c & 31)) * 2; }
__device__ __forceinline__ int v_rd_base(int lane) { return ((lane & 3) << 3) | (((lane >> 2) & 3) << 6) | (((lane >> 4) & 1) << 5) | (((lane >> 5) & 1) << 8); }
constexpr int v_rd_off(int d0, int ks, int half) { return d0 * 512 + ks * 4096 + half * 2048; }
__device__ __forceinline__ int crow(int r, int hi) { return (r & 3) + 8 * (r >> 2) + 4 * hi; }
__device__ __forceinline__ unsigned cvtpk(float lo, float hi) { unsigned r; asm volatile("v_cvt_pk_bf16_f32 %0, %1, %2" : "=v"(r) : "v"(lo), "v"(hi)); return r; }
__device__ __forceinline__ bf16x8 load8(const bf16* p) { return *reinterpret_cast<const bf16x8*>(p); }
__device__ __forceinline__ void mask_tile(f32x16& p0, f32x16& p1, int dq, unsigned W) {
    const float NEG = -__builtin_inff();
#pragma unroll
    for (int r = 0; r < 16; ++r) {
        const int c = (r & 3) + 8 * (r >> 2);
        if ((unsigned)(dq - c) >= W) p0[r] = NEG;
        if ((unsigned)(dq - c - 32) >= W) p1[r] = NEG;
    }
}
__device__ __forceinline__ void partialSM(f32x16& p0, f32x16& p1, float& m_reg, float& mn, float& alpha) {
    float pmax = p0[0]; for (int r = 1; r < 16; ++r) pmax = fmaxf(pmax, p0[r]); for (int r = 0; r < 16; ++r) pmax = fmaxf(pmax, p1[r]);
    { auto rr = __builtin_amdgcn_permlane32_swap(__float_as_uint(pmax), __float_as_uint(pmax), false, false);
      pmax = fmaxf(__uint_as_float(rr[0]), __uint_as_float(rr[1])); }
    constexpr float C2 = 1.4426950408889634f * SCALE;
    if (__builtin_expect(__all((pmax - m_reg) * SCALE <= THR), 1)) { mn = m_reg; alpha = 1.f; }
    else { mn = fmaxf(m_reg, pmax); alpha = __builtin_amdgcn_exp2f((m_reg - mn) * C2); m_reg = mn; }
    const float mnL = -mn * C2;
    for (int r = 0; r < 16; ++r) p0[r] = fmaf(p0[r], C2, mnL); for (int r = 0; r < 16; ++r) p1[r] = fmaf(p1[r], C2, mnL);
    for (int r = 0; r < 16; ++r) p0[r] = __builtin_amdgcn_exp2f(p0[r]);
}
__device__ __forceinline__ void finishSM(f32x16& p0, f32x16& p1, float alpha, float& l_reg, bf16x8& pa0, bf16x8& pa1, bf16x8& pa2, bf16x8& pa3) {
    for (int r = 0; r < 16; ++r) p1[r] = __builtin_amdgcn_exp2f(p1[r]);
    float ps = 0; for (int r = 0; r < 16; ++r) ps += p0[r]; for (int r = 0; r < 16; ++r) ps += p1[r];
    { auto rr = __builtin_amdgcn_permlane32_swap(__float_as_uint(ps), __float_as_uint(ps), false, false);
      ps = __uint_as_float(rr[0]) + __uint_as_float(rr[1]); }
    l_reg = l_reg * alpha + ps;
#define PK4(P, B_, OUT) do { unsigned a0 = cvtpk(P[B_+0], P[B_+1]), a1 = cvtpk(P[B_+2], P[B_+3]);                          \
        unsigned b0 = cvtpk(P[B_+4], P[B_+5]), b1 = cvtpk(P[B_+6], P[B_+7]);                                             \
        auto r0 = __builtin_amdgcn_permlane32_swap(a0, b0, false, false); auto r1 = __builtin_amdgcn_permlane32_swap(a1, b1, false, false); \
        u32x4 w = {r0[0], r1[0], r0[1], r1[1]}; OUT = *reinterpret_cast<bf16x8*>(&w); } while (0)
    PK4(p0, 0, pa0); PK4(p0, 8, pa1); PK4(p1, 0, pa2); PK4(p1, 8, pa3);
#undef PK4
}
template <int KB>
__device__ __forceinline__ void qkt(f32x16& p0, f32x16& p1, const char* K_lds, const char* B_lds, int r32, int hi, const bf16x8* qr) {
    const f32x4* bp = (const f32x4*)(B_lds + KB * 256 + hi * 16);
#pragma unroll
    for (int i = 0; i < 4; ++i) { const f32x4 a = bp[2 * i], b = bp[8 + 2 * i];
        p0[4 * i] = a[0]; p0[4 * i + 1] = a[1]; p0[4 * i + 2] = a[2]; p0[4 * i + 3] = a[3];
        p1[4 * i] = b[0]; p1[4 * i + 1] = b[1]; p1[4 * i + 2] = b[2]; p1[4 * i + 3] = b[3]; }
    const char* kb[4];
#pragma unroll
    for (int dd = 0; dd < 4; ++dd) kb[dd] = K_lds + KB * SHM_K + KSWZ(r32, (dd * 16 + hi * 8) * 2);
#pragma unroll
    for (int d0 = 0; d0 < 8; ++d0) { const char* a = kb[d0 & 3] + (d0 >> 2) * 128;
        bf16x8 b0 = *reinterpret_cast<const bf16x8*>(a);
        bf16x8 b1 = *reinterpret_cast<const bf16x8*>(a + 32 * 256);
        p0 = __builtin_amdgcn_mfma_f32_32x32x16_bf16(b0, qr[d0], p0, 0, 0, 0);
        p1 = __builtin_amdgcn_mfma_f32_32x32x16_bf16(b1, qr[d0], p1, 0, 0, 0); }
}
template <int VB>
__device__ __forceinline__ void pv_tile(f32x16* o, int vb0, bf16x8 pa0, bf16x8 pa1, bf16x8 pa2, bf16x8 pa3) {
#define TRRD(dst, off) asm volatile("ds_read_b64_tr_b16 %0, %1 offset:%2" : "=&v"(dst) : "v"(vb0), "i"(off) : "memory")
#define PV_D0(d0) do { s16x4 l0, l1, l2, l3, h0, h1, h2, h3; constexpr int b_ = VB * SHM_V + v_rd_off(d0, 0, 0); \
        TRRD(l0, b_); TRRD(h0, b_ + 2048); TRRD(l1, b_ + 4096); TRRD(h1, b_ + 6144); TRRD(l2, b_ + 8192); TRRD(h2, b_ + 10240); TRRD(l3, b_ + 12288); TRRD(h3, b_ + 14336); \
        asm volatile("s_waitcnt lgkmcnt(0)" ::: "memory"); SBAR();   \
        o[d0] = __builtin_amdgcn_mfma_f32_32x32x16_bf16(pa0, (bf16x8){l0[0], l0[1], l0[2], l0[3], h0[0], h0[1], h0[2], h0[3]}, o[d0], 0, 0, 0);   \
        o[d0] = __builtin_amdgcn_mfma_f32_32x32x16_bf16(pa1, (bf16x8){l1[0], l1[1], l1[2], l1[3], h1[0], h1[1], h1[2], h1[3]}, o[d0], 0, 0, 0);   \
        o[d0] = __builtin_amdgcn_mfma_f32_32x32x16_bf16(pa2, (bf16x8){l2[0], l2[1], l2[2], l2[3], h2[0], h2[1], h2[2], h2[3]}, o[d0], 0, 0, 0);   \
        o[d0] = __builtin_amdgcn_mfma_f32_32x32x16_bf16(pa3, (bf16x8){l3[0], l3[1], l3[2], l3[3], h3[0], h3[1], h3[2], h3[3]}, o[d0], 0, 0, 0); } while (0)
    PV_D0(0); PV_D0(1); PV_D0(2); PV_D0(3);
#undef PV_D0
#undef TRRD
}
struct BlockRef { const bf16* Q; const bf16* K; const bf16* V; const float* FB; bf16* O; float* ST; int P0; };
struct Seam { bf16x8 qr[8]; bf16x8 st_v0, st_v1, st_k0, st_k1; float st_b; };
#define ROW(p, k0, rr) ((p) + (size_t)((k0) + (rr)) * LD + sc)
#define VMW() asm volatile("s_waitcnt vmcnt(0)" ::: "memory")
#define VMWN(n) asm volatile("s_waitcnt vmcnt(%0)" :: "i"(n) : "memory")
#define SLOAD_H(Kp, Vp, Fp, k0) do { S.st_v0 = load8(ROW(Vp, k0, sr)); S.st_v1 = load8(ROW(Vp, k0, 32 + sr));              \
                         S.st_k0 = load8(ROW(Kp, k0, sr)); S.st_k1 = load8(ROW(Kp, k0, 32 + sr)); S.st_b = (Fp)[(k0) + (tid & 63)]; } while (0)
#define SWRITE_HK(bf) do { *(bf16x8*)(K_lds + (bf) * SHM_K + kws) = S.st_k0; *(bf16x8*)(K_lds + (bf) * SHM_K + kws + 32 * 256) = S.st_k1; \
                           if (tid < 64) ((float*)B_lds)[(bf) * 64 + tid] = S.st_b; } while (0)
#define SWRITE_HV(bf) do { *(bf16x8*)(V_lds + (bf) * SHM_V + vst0) = S.st_v0; *(bf16x8*)(V_lds + (bf) * SHM_V + vst1) = S.st_v1; } while (0)
#define SWRITE_H(bf) do { SWRITE_HV(bf); SWRITE_HK(bf); } while (0)
__device__ __forceinline__ void prime(const BlockRef& cur, char* lds, Seam& S, int wv) {
    const int tid = fresh_tid(wv), wid = __builtin_amdgcn_readfirstlane(tid >> 6), lane = tid & 63, r32 = lane & 31, hi = lane >> 5;
    const int sr = tid >> 4, sc = (tid & 15) * 8, kws = KSWZ(sr, sc * 2); char* K_lds = lds + 2 * SHM_V; char* B_lds = lds + OFF_BIAS;
    for (int d0 = 0; d0 < 8; ++d0) S.qr[d0] = load8(cur.Q + (size_t)(wid * QBLK + r32) * LD + d0 * 16 + hi * 8);
    SLOAD_H(cur.K, cur.V, cur.FB, 0); VMW(); SWRITE_HK(0);
    __syncthreads();
}
__device__ __forceinline__ void block(const BlockRef& cur, const BlockRef& nxt, char* lds, Seam& S, int wv) {
    const int tid = fresh_tid(wv), wid = __builtin_amdgcn_readfirstlane(tid >> 6), lane = tid & 63, r32 = lane & 31, hi = lane >> 5;
    constexpr unsigned W = 1u << 30;
    const int NT = (cur.P0 + QB - 1) / KVBLK + 1;
    const int qlo = cur.P0 + wid * QBLK, qm = qlo + r32 - 4 * hi;
    char* V_lds = lds; char* K_lds = lds + 2 * SHM_V; char* B_lds = lds + OFF_BIAS;
    float* ws = (float*)(lds + OFF_WS) + wid * 64; float* li_l = ws, * al_l = ws + 32;
    float m_reg = -1e30f, l_reg = 0; f32x16 o[4] = {};
    const int sr = tid >> 4, sc = (tid & 15) * 8, vst0 = v_st(sr, sc), vst1 = v_st(32 + sr, sc), kws = KSWZ(sr, sc * 2);
    const int vb0 = (int)(uintptr_t)V_lds + v_rd_base(lane);
    const bf16* Kh = cur.K; const bf16* Vh = cur.V; const float* Fh = cur.FB;
#define RESC(a) do { if (__any((a) < 1.f)) { if (hi == 0) al_l[r32] = (a); asm volatile("s_waitcnt lgkmcnt(0)" ::: "memory");              \
                     for (int d_ = 0; d_ < 4; ++d_) for (int r = 0; r < 16; ++r) o[d_][r] *= al_l[crow(r, hi)]; } } while (0)
#define KBASE(t) ((t) * KVBLK)
#define MASKT(P0_, P1_, t) do { const int kb_ = KBASE(t); if (kb_ + KVBLK - 1 > qlo) mask_tile(P0_, P1_, qm - kb_, W); } while (0)
    constexpr int NQL = 8;
#define SEAM_K0() do { VMWN(NQL); SWRITE_HK(0); SBAR(); } while (0)
    f32x16 pA0, pA1, pB0, pB1; float mnA, mnB, alA, alB; bf16x8 pa0, pa1, pa2, pa3;
    SWRITE_HV(0); SBAR();
    if (NT > 1) SLOAD_H(Kh, Vh, Fh, KBASE(1));
    SBAR(); qkt<0>(pA0, pA1, K_lds, B_lds, r32, hi, S.qr);
    MASKT(pA0, pA1, 0); partialSM(pA0, pA1, m_reg, mnA, alA);
    if (NT > 1) { VMW(); SWRITE_H(1); }
    __syncthreads();
#define HALF_STEP(PX0, PX1, mnX, alX, PY0, PY1, alY, t, KB, VB, SB) do {                                                      \
        SBAR(); qkt<KB>(PX0, PX1, K_lds, B_lds, r32, hi, S.qr);                                                               \
        finishSM(PY0, PY1, alY, l_reg, pa0, pa1, pa2, pa3); SBAR();                                                           \
        if ((t) + 1 < NT) { SLOAD_H(Kh, Vh, Fh, KBASE((t) + 1)); SBAR(); }                                                    \
        pv_tile<VB>(o, vb0, pa0, pa1, pa2, pa3); MASKT(PX0, PX1, (t)); partialSM(PX0, PX1, m_reg, mnX, alX);                  \
        __syncthreads();                                                                                                      \
        if ((t) + 1 < NT) { VMW(); SWRITE_H(SB); }                                                                            \
        RESC(alX); __syncthreads(); } while (0)
    for (int t = 1; t + 1 < NT; t += 2) {
        HALF_STEP(pB0, pB1, mnB, alB, pA0, pA1, alA, t, 1, 0, 0);
        HALF_STEP(pA0, pA1, mnA, alA, pB0, pB1, alB, t + 1, 0, 1, 1);
    }
    const bool even = (NT & 1) == 0;
    if (even) { SBAR(); qkt<1>(pB0, pB1, K_lds, B_lds, r32, hi, S.qr); SBAR(); }
    SLOAD_H(nxt.K, nxt.V, nxt.FB, 0); SBAR();
#pragma unroll
    for (int d0 = 0; d0 < 8; ++d0) S.qr[d0] = load8(nxt.Q + (size_t)(wid * QBLK + r32) * LD + d0 * 16 + hi * 8);
    SBAR();
    finishSM(pA0, pA1, alA, l_reg, pa0, pa1, pa2, pa3); SBAR();
    pv_tile<0>(o, vb0, pa0, pa1, pa2, pa3);
    if (even) { MASKT(pB0, pB1, NT - 1); partialSM(pB0, pB1, m_reg, mnB, alB); __syncthreads(); RESC(alB);
        finishSM(pB0, pB1, alB, l_reg, pa0, pa1, pa2, pa3); SBAR(); pv_tile<1>(o, vb0, pa0, pa1, pa2, pa3); }
    SBAR(); SEAM_K0();
    if (hi == 0) li_l[r32] = l_reg; asm volatile("s_waitcnt lgkmcnt(0)" ::: "memory");
    float rli[16];
#pragma unroll
    for (int r = 0; r < 16; ++r) rli[r] = __builtin_amdgcn_rcpf(li_l[crow(r, hi)]);
    bf16* Ow = cur.O + (size_t)(wid * QBLK) * LDO;
    float sq[16];
#pragma unroll
    for (int r = 0; r < 16; ++r) { const int orow = crow(r, hi); float s_ = 0.f;
#pragma unroll
        for (int d0 = 0; d0 < 4; ++d0) { const float v = o[d0][r] * rli[r]; s_ += v * v;
            const float vn = __shfl_xor(v, 1);
            if ((r32 & 1) == 0) *(unsigned*)(Ow + (size_t)orow * LDO + d0 * 32 + r32) = cvtpk(v, vn); }
        sq[r] = s_; }
#pragma unroll
    for (int r = 0; r < 16; ++r) {
#define SQ_SWZ(o_) sq[r] += __int_as_float(__builtin_amdgcn_ds_swizzle(__float_as_int(sq[r]), 0x1f | ((o_) << 10)))
        SQ_SWZ(1); SQ_SWZ(2); SQ_SWZ(4); SQ_SWZ(8); SQ_SWZ(16);
#undef SQ_SWZ
    }
    if (r32 == 0) {
#pragma unroll
        for (int r = 0; r < 16; ++r) cur.ST[(size_t)(wid * QBLK + crow(r, hi)) * 8] = sq[r]; }
    __syncthreads();
#undef RESC
#undef KBASE
#undef MASKT
#undef SEAM_K0
#undef HALF_STEP
}
#undef ROW
#undef VMW
#undef VMWN
#undef SLOAD_H
#undef SWRITE_HK
#undef SWRITE_HV
#undef SWRITE_H
#undef SBAR
#undef KSWZ
}

#define XB_TMO      128
#define XB_XCNT(j)  (256  + 64 * (j))
#define XB_XSUB(j)  (1280 + 64 * (j))
#define XB_XGEN(j)  (2304 + 64 * (j))
#define XB_TOP      3328
#define XB_TOPGEN   3392
#define XCD_BAR_WORDS 3456
#define XB_SPIN_CAP (1u << 18)
__device__ __forceinline__ unsigned xb_ld(unsigned* p)              { return __hip_atomic_load(p, __ATOMIC_RELAXED, __HIP_MEMORY_SCOPE_AGENT); }
__device__ __forceinline__ unsigned xb_add(unsigned* p, unsigned v) { return __hip_atomic_fetch_add(p, v, __ATOMIC_RELAXED, __HIP_MEMORY_SCOPE_AGENT); }
__device__ __forceinline__ unsigned xb_xcc_id() { return (unsigned)__builtin_amdgcn_s_getreg((3 << 11) | 20) & 0xFu; }
#define XB_SPIN(cond, bar) do { unsigned _sp = 0; while (cond) { __builtin_amdgcn_s_sleep(1); \
    if ((++_sp & 255u) == 0u) { if (xb_ld(&(bar)[XB_TMO])) break; if (_sp > XB_SPIN_CAP) { atomicAdd(&(bar)[XB_TMO], 1u); break; } } } } while (0)
struct XcdBarrier { unsigned* bar; unsigned x; volatile LAS unsigned* st; };
__device__ __forceinline__ XcdBarrier xcd_barrier_post(unsigned* bar, volatile LAS unsigned* st, int tid) {
    XcdBarrier b; b.bar = bar; b.x = xb_xcc_id(); b.st = st;
    if (tid == 0) (void)xb_add(&bar[XB_XCNT(b.x)], 1u);
    return b;
}
__device__ __forceinline__ void xcd_barrier_complete(unsigned* bar, unsigned x, unsigned& nloc, unsigned& nx) {
    const unsigned G = gridDim.x * gridDim.y * gridDim.z;
    unsigned sum, cnt, mine, sp = 0u;
    for (;;) {
        sum = 0u; cnt = 0u; mine = 0u;
#pragma unroll
        for (unsigned j = 0; j < 16; ++j) { const unsigned c = xb_ld(&bar[XB_XCNT(j)]); sum += c; cnt += (c > 0u) ? 1u : 0u; mine = (j == x) ? c : mine; }
        if (sum == G) break;
        __builtin_amdgcn_s_sleep(1);
        if ((++sp & 255u) == 0u) { if (xb_ld(&bar[XB_TMO])) break; if (sp > XB_SPIN_CAP) { atomicAdd(&bar[XB_TMO], 1u); break; } }
    }
    nloc = mine > 0u ? mine : 1u; nx = cnt > 0u ? cnt : 1u;
}
__device__ __forceinline__ void xcd_barrier(const XcdBarrier& b, int tid) {
    asm volatile("s_waitcnt vmcnt(0)" ::: "memory");
    __syncthreads();
    if (tid == 0) {
        unsigned* bar = b.bar;
        __builtin_amdgcn_s_waitcnt(0);
        unsigned nloc = b.st[0], nx = b.st[1];
        if (nloc == 0u) { xcd_barrier_complete(bar, b.x, nloc, nx); b.st[0] = nloc; b.st[1] = nx; }
        const unsigned old = xb_add(&bar[XB_XSUB(b.x)], 1u);
        const unsigned gen = old / nloc;
        if (old + 1u == (gen + 1u) * nloc) {
            __builtin_amdgcn_fence(__ATOMIC_RELEASE, "agent");
            asm volatile("s_waitcnt vmcnt(0)" ::: "memory");
            const unsigned og = xb_add(&bar[XB_TOP], 1u);
            const unsigned tg = og / nx;
            if (og + 1u == (tg + 1u) * nx) xb_add(&bar[XB_TOPGEN], 1u);
            else XB_SPIN(xb_ld(&bar[XB_TOPGEN]) == tg, bar);
            __builtin_amdgcn_fence(__ATOMIC_ACQUIRE, "agent");
            xb_add(&bar[XB_XGEN(b.x)], 1u);
            asm volatile("s_waitcnt vmcnt(0)" ::: "memory");
        } else {
            XB_SPIN(xb_ld(&bar[XB_XGEN(b.x)]) == gen, bar);
            __builtin_amdgcn_fence(__ATOMIC_ACQUIRE, "agent");
            asm volatile("s_waitcnt vmcnt(0)" ::: "memory");
        }
    }
    __syncthreads();
}

#ifndef PROBE_PHASE
#define PROBE_PHASE -1
#endif
#ifndef PROBE_TS
#define PROBE_TS -1
#endif
#ifndef PROBE_OFF
#define PROBE_OFF 0
#endif
#ifndef PROBE_TSB
#define PROBE_TSB (PROBE_TS + 1)
#endif
#define PH(id) for (int rep_ = 0; rep_ < ((PROBE_PHASE == (id)) ? 2 : 1); ++rep_)
constexpr int NWAVES = 8, NTHREADS = 512;
constexpr int LDS_BYTES = 147456;
struct Args { const float* in[19]; float* out; unsigned char* ws; unsigned long long cg_rounds; };
enum { I_X = 0, I_P, I_GPREMIX, I_WIN, I_BF, I_WPOOL, I_POOLSCALE, I_GPOOLOUT, I_GATTNOUT, I_WOUT, I_GPOSTMIX, I_GPREMLP, I_WUP, I_WDOWN, I_GPOSTMLP, I_GPLEGATE, I_WGATE, I_WPLE, I_GPOSTPLE };

constexpr int TR_PITCH = 68, TR_BYTES = 64 * TR_PITCH * 4;
__device__ __forceinline__ void p0_transpose_item(const float* W, int K, int N, int ldw, bf16_t* WT, int row_off, LAS float* scr, int item, int lane) {
    const int nkb = K / 64, kb = item % nkb, nb = item / nkb, k0 = 64 * kb, n0 = 64 * nb; (void)N;
    f32x4 v[16];
    const float* src = W + (size_t)(k0 + (lane >> 4)) * ldw + n0 + 4 * (lane & 15);
#pragma unroll
    for (int i = 0; i < 16; ++i) v[i] = __builtin_nontemporal_load((const f32x4*)(src + (size_t)(4 * i) * ldw));
#pragma unroll
    for (int i = 0; i < 16; ++i) *(LAS f32x4*)(scr + (4 * i + (lane >> 4)) * TR_PITCH + 4 * (lane & 15)) = v[i];
    asm volatile("s_waitcnt lgkmcnt(0)" ::: "memory");
    const int c = lane >> 3;
#pragma unroll
    for (int j = 0; j < 8; ++j) { const int n = (lane & 7) + 8 * j; const LAS float* sp = scr + (8 * c) * TR_PITCH + n;
        u32x4 o; o.x = cvt_pk_bf16(sp[0 * TR_PITCH], sp[1 * TR_PITCH]); o.y = cvt_pk_bf16(sp[2 * TR_PITCH], sp[3 * TR_PITCH]);
        o.z = cvt_pk_bf16(sp[4 * TR_PITCH], sp[5 * TR_PITCH]); o.w = cvt_pk_bf16(sp[6 * TR_PITCH], sp[7 * TR_PITCH]);
        *(u32x4*)(WT + (size_t)(row_off + n0 + n) * K + k0 + 8 * c) = o; }
    asm volatile("s_waitcnt lgkmcnt(0)" ::: "memory");
}

template <bool BIN, bool BOUT>
__device__ __forceinline__ void resnorm_phase(const void* base, const bf16_t* raw, const float* g_post, void* outp, const float* g_next, bf16_t* hn, int gw, int NGW, int lane) {
    u32x2 nraw[8]; f32x4 nbf[8]; u32x2 nbh[8];
#define RN_LOAD(mm) do { const u32x2* rp_ = (const u32x2*)(raw + (size_t)(mm) * DM) + lane; \
        _Pragma("unroll") for (int j = 0; j < 8; ++j) nraw[j] = rp_[64 * j]; \
        if (BIN) { const u32x2* bp_ = (const u32x2*)((const bf16_t*)base + (size_t)(mm) * DM) + lane; _Pragma("unroll") for (int j = 0; j < 8; ++j) nbh[j] = bp_[64 * j]; } \
        else { const f32x4* bp_ = (const f32x4*)((const float*)base + (size_t)(mm) * DM) + lane; _Pragma("unroll") for (int j = 0; j < 8; ++j) nbf[j] = __builtin_nontemporal_load(bp_ + 64 * j); } } while (0)
    int m = gw; if (m < M) RN_LOAD(m);
    for (; m < M; m += NGW) {
        f32x4 r[8], b[8]; float ss = 0.f;
#pragma unroll
        for (int j = 0; j < 8; ++j) { r[j] = (f32x4){bf_lo(nraw[j].x), bf_hi(nraw[j].x), bf_lo(nraw[j].y), bf_hi(nraw[j].y)};
            if (BIN) b[j] = (f32x4){bf_lo(nbh[j].x), bf_hi(nbh[j].x), bf_lo(nbh[j].y), bf_hi(nbh[j].y)}; else b[j] = nbf[j];
            ss += (r[j].x * r[j].x + r[j].y * r[j].y) + (r[j].z * r[j].z + r[j].w * r[j].w); }
        asm volatile("" ::: "memory");
        if (m + NGW < M) RN_LOAD(m + NGW);
        const float rs = 1.0f / sqrtf(wave_sum(ss) * (1.f / DM) + EPS);
        float ss2 = 0.f;
#pragma unroll
        for (int j = 0; j < 8; ++j) { const f32x4 g = *((const f32x4*)g_post + lane + 64 * j);
            r[j] = b[j] + r[j] * rs * g;
            if (BOUT) { u32x2 w; w.x = cvt_pk_bf16(r[j].x, r[j].y); w.y = cvt_pk_bf16(r[j].z, r[j].w); *((u32x2*)((bf16_t*)outp + (size_t)m * DM) + lane + 64 * j) = w; }
            else *((f32x4*)((float*)outp + (size_t)m * DM) + lane + 64 * j) = r[j];
            ss2 += (r[j].x * r[j].x + r[j].y * r[j].y) + (r[j].z * r[j].z + r[j].w * r[j].w); }
        if (g_next) {
            const float rs2 = 1.0f / sqrtf(wave_sum(ss2) * (1.f / DM) + EPS);
#pragma unroll
            for (int j = 0; j < 8; ++j) { const f32x4 g = *((const f32x4*)g_next + lane + 64 * j); const f32x4 h = r[j] * rs2 * g;
                u32x2 w; w.x = cvt_pk_bf16(h.x, h.y); w.y = cvt_pk_bf16(h.z, h.w); *((u32x2*)(hn + (size_t)m * DM) + lane + 64 * j) = w; }
        }
    }
#undef RN_LOAD
}
__device__ __forceinline__ void ynorm_phase(const bf16_t* yp, const bf16_t* ya, const float* gp, const float* ga, bf16_t* y, int gw, int NGW, int lane) {
    u32x4 np[2], na[2];
#define YN_LOAD(mm) do { _Pragma("unroll") for (int j = 0; j < 2; ++j) { np[j] = *((const u32x4*)(yp + (size_t)(mm) * 1024) + lane + 64 * j); na[j] = *((const u32x4*)(ya + (size_t)(mm) * 1024) + lane + 64 * j); } } while (0)
    int m = gw; if (m < M) YN_LOAD(m);
    for (; m < M; m += NGW) {
        float v[2][2][8]; float ss0 = 0.f, ss1 = 0.f;
#pragma unroll
        for (int j = 0; j < 2; ++j) { const u32x4 w = np[j], q = na[j];
            v[0][j][0] = bf_lo(w.x); v[0][j][1] = bf_hi(w.x); v[0][j][2] = bf_lo(w.y); v[0][j][3] = bf_hi(w.y); v[0][j][4] = bf_lo(w.z); v[0][j][5] = bf_hi(w.z); v[0][j][6] = bf_lo(w.w); v[0][j][7] = bf_hi(w.w);
            v[1][j][0] = bf_lo(q.x); v[1][j][1] = bf_hi(q.x); v[1][j][2] = bf_lo(q.y); v[1][j][3] = bf_hi(q.y); v[1][j][4] = bf_lo(q.z); v[1][j][5] = bf_hi(q.z); v[1][j][6] = bf_lo(q.w); v[1][j][7] = bf_hi(q.w);
#pragma unroll
            for (int e = 0; e < 8; ++e) { ss0 += v[0][j][e] * v[0][j][e]; ss1 += v[1][j][e] * v[1][j][e]; } }
        asm volatile("" ::: "memory");
        if (m + NGW < M) YN_LOAD(m + NGW);
        ss0 = wave_sum(ss0); ss1 = wave_sum(ss1);
        const float rs[2] = {1.0f / sqrtf(ss0 * (1.f / 1024.f) + EPS), 1.0f / sqrtf(ss1 * (1.f / 1024.f) + EPS)};
#pragma unroll
        for (int h = 0; h < 2; ++h) { const float* g = h ? ga : gp;
#pragma unroll
            for (int j = 0; j < 2; ++j) { const f32x4 g0 = *((const f32x4*)g + 2 * (lane + 64 * j)), g1 = *((const f32x4*)g + 2 * (lane + 64 * j) + 1); const float r_ = rs[h];
                u32x4 w; w.x = cvt_pk_bf16(v[h][j][0] * r_ * g0.x, v[h][j][1] * r_ * g0.y); w.y = cvt_pk_bf16(v[h][j][2] * r_ * g0.z, v[h][j][3] * r_ * g0.w);
                w.z = cvt_pk_bf16(v[h][j][4] * r_ * g1.x, v[h][j][5] * r_ * g1.y); w.w = cvt_pk_bf16(v[h][j][6] * r_ * g1.z, v[h][j][7] * r_ * g1.w);
                *((u32x4*)(y + (size_t)m * DM + h * 1024) + lane + 64 * j) = w; } }
    }
#undef YN_LOAD
}
__device__ __forceinline__ float log_sigmoid(float x) { return x < 0.f ? x - log1pf(expf(x)) : -log1pf(expf(-x)); }

__global__ void __launch_bounds__(NTHREADS, 2) mega_fwd(Args args) {
    extern __shared__ __attribute__((aligned(16))) unsigned char lds[];
    cg::grid_group grid = cg::this_grid();
    for (unsigned long long i_ = 0; i_ < args.cg_rounds; ++i_) grid.sync();
    LAS unsigned char* ldsl = (LAS unsigned char*)lds;
    const int G = gridDim.x, bid = blockIdx.x, NGW = G * NWAVES;
    const int wave_s = __builtin_amdgcn_readfirstlane((int)(threadIdx.x >> 6));
#if PROBE_TS >= 0
#define STAMP(k) do { if (bid == 0 && fresh_tid(wave_s) == 0) { const unsigned long long t_ = __builtin_amdgcn_s_memrealtime(); MISC[16 + 2 * (k)] = (unsigned)t_; MISC[17 + 2 * (k)] = (unsigned)(t_ >> 32); } } while (0)
#else
#define STAMP(k) do {} while (0)
#endif
#define PHASE_IDS() const int tid = fresh_tid(wave_s), lane = tid & 63, wave = __builtin_amdgcn_readfirstlane(tid >> 6), gw = bid * NWAVES + wave; (void)lane; (void)gw
    unsigned char* ws = args.ws;
    unsigned* barw = (unsigned*)ws;
    volatile LAS unsigned* MISC = (volatile LAS unsigned*)(ldsl + LDS_BYTES - 256);
    { const int t0 = fresh_tid(wave_s); if (t0 < 64) MISC[t0] = 0u;
      __syncthreads(); }
    const XcdBarrier bar = xcd_barrier_post(barw, MISC + 8, fresh_tid(wave_s));
    STAMP(0);
#define WSP(off) ((bf16_t*)(args.ws + (off)))
#define XIN (args.in[I_X])
#define OUTP (args.out)
#define flog ((float*)(args.ws + WS_FLOG))
#define fb ((float*)(args.ws + WS_FB))
#define WinT WSP(WS_WIN)
#define WoutT WSP(WS_WOUT)
#define WupT WSP(WS_WUP)
#define WdownT WSP(WS_WDOWN)
#define WgateT WSP(WS_WGATE)
#define WpleT WSP(WS_WPLE)
#define WpoolT WSP(WS_WPOOL)
#define HN WSP(WS_HN)
#define U WSP(AR_U)
#define Qb WSP(AR_Q)
#define Kb WSP(AR_K)
#define Vb WSP(AR_V)
#define YP WSP(AR_YP)
#define YA WSP(AR_YA)
#define DP WSP(AR_DP)
#define Y WSP(AR_Y)
#define RAW1 WSP(AR_RAW1)
#define HID WSP(AR_HID)
#define Eb ((bf16_t*)((unsigned char*)args.out + 32 * MiB))
#define RAW2 WSP(WS_RAW2)
#define PBF WSP(WS_PBF)
#define STA ((float*)(args.ws + WS_STA))
#define STP ((float*)(args.ws + WS_STP))
#define H1 ((bf16_t*)args.out)
#define H2 WSP(WS_ARENA + 32 * MiB)

    PH(0) {
    {
        PHASE_IDS();
        LAS float* wf = (LAS float*)ldsl;
        const float* w_in = args.in[I_WIN]; const float* gpm = args.in[I_GPREMIX];
        {
            f32x4 wa[4], wb[4]; float gk[4];
#pragma unroll
            for (int q = 0; q < 4; ++q) { const int k = tid + q * NTHREADS; const f32x4* wp = (const f32x4*)(w_in + (size_t)k * INW + 4096); wa[q] = wp[0]; wb[q] = wp[1]; gk[q] = gpm[k]; }
#pragma unroll
            for (int q = 0; q < 4; ++q) { const int k = tid + q * NTHREADS; const int l = (k & 255) >> 2, i = k & 3, j = k >> 8;
                LAS f32x4* dst = (LAS f32x4*)(wf + ((j * 4 + i) * 64 + l) * 8); dst[0] = wa[q] * gk[q]; dst[1] = wb[q] * gk[q]; }
        }
        __syncthreads();
        f32x4 nx[8];
        if (gw < M) {
#pragma unroll
            for (int j = 0; j < 8; ++j) nx[j] = __builtin_nontemporal_load((const f32x4*)(XIN + (size_t)gw * DM) + lane + 64 * j); }
        for (int m = gw; m < M; m += NGW) {
            f32x4 v[8]; float ss = 0.f;
#pragma unroll
            for (int j = 0; j < 8; ++j) { v[j] = nx[j]; ss += (v[j].x * v[j].x + v[j].y * v[j].y) + (v[j].z * v[j].z + v[j].w * v[j].w); }
            asm volatile("" ::: "memory");
            if (m + NGW < M) {
#pragma unroll
                for (int j = 0; j < 8; ++j) nx[j] = __builtin_nontemporal_load((const f32x4*)(XIN + (size_t)(m + NGW) * DM) + lane + 64 * j); }
            const float rs = 1.0f / sqrtf(wave_sum(ss) * (1.f / DM) + EPS);
            float fa[8] = {0.f, 0.f, 0.f, 0.f, 0.f, 0.f, 0.f, 0.f};
#pragma unroll
            for (int j = 0; j < 8; ++j)
#pragma unroll
                for (int i = 0; i < 4; ++i) { const LAS f32x4* wp = (const LAS f32x4*)(wf + ((j * 4 + i) * 64 + lane) * 8); const f32x4 w0 = wp[0], w1 = wp[1]; const float xv = v[j][i];
                    fa[0] += xv * w0.x; fa[1] += xv * w0.y; fa[2] += xv * w0.z; fa[3] += xv * w0.w; fa[4] += xv * w1.x; fa[5] += xv * w1.y; fa[6] += xv * w1.z; fa[7] += xv * w1.w; }
#pragma unroll
            for (int c = 0; c < 8; ++c) fa[c] = wave_sum(fa[c]) * rs;
            if (lane < 8) { float fv = fa[0];
#pragma unroll
                for (int c = 1; c < 8; ++c) fv = (lane == c) ? fa[c] : fv;
                flog[((size_t)(m >> 11) * NH + lane) * SEQ + (m & (SEQ - 1))] = log_sigmoid(fv + args.in[I_BF][lane]); }
            u32x2* o8 = (u32x2*)(HN + (size_t)m * DM) + lane;
#pragma unroll
            for (int j = 0; j < 8; ++j) { const f32x4 g = *((const f32x4*)gpm + lane + 64 * j); const f32x4 h = v[j] * rs * g;
                u32x2 w; w.x = cvt_pk_bf16(h.x, h.y); w.y = cvt_pk_bf16(h.z, h.w); o8[64 * j] = w; }
        }
        __syncthreads();
        LAS float* scr = (LAS float*)(ldsl + wave * TR_BYTES);
        constexpr int IT_IN = (DM / 64) * (4096 / 64), IT_POOL1 = (256 / 64) * (256 / 64);
        constexpr int IT_PLE = (PLE / 64) * (DM / 64);
        constexpr int NITEMS = IT_IN + 4 * IT_POOL1 + IT_PLE;
        for (int it = gw; it < NITEMS; it += NGW) {
            int r = it;
            if (r < IT_IN) { p0_transpose_item(args.in[I_WIN], DM, 4096, INW, WinT, 0, scr, r, lane); continue; } r -= IT_IN;
            if (r < IT_PLE) { p0_transpose_item(args.in[I_WPLE], PLE, DM, DM, WpleT, 0, scr, r, lane); continue; } r -= IT_PLE;
            { const int gi = r / IT_POOL1; p0_transpose_item(args.in[I_WPOOL] + (size_t)gi * 65536, 256, 256, 256, WpoolT, gi * 256, scr, r % IT_POOL1, lane); }
        }
        const float* p = args.in[I_P];
        for (int idx = bid * NTHREADS + tid; idx < M * PLE / 8; idx += G * NTHREADS) { const f32x4 a = __builtin_nontemporal_load((const f32x4*)p + 2 * idx), b = __builtin_nontemporal_load((const f32x4*)p + 2 * idx + 1);
            u32x4 w; w.x = cvt_pk_bf16(a.x, a.y); w.y = cvt_pk_bf16(a.z, a.w); w.z = cvt_pk_bf16(b.x, b.y); w.w = cvt_pk_bf16(b.z, b.w); *((u32x4*)PBF + idx) = w; }
    }
    xcd_barrier(bar, fresh_tid(wave_s));
    }
    STAMP(1);

#if PROBE_PHASE == 100
    for (int i_ = 0; i_ < 16; ++i_) xcd_barrier(bar, fresh_tid(wave_s));
#endif
    PH(1) {
    {
        { PHASE_IDS();
          if (bid < NB * NH && wave == 0) {
            const f32x4* fl = (const f32x4*)(flog + (size_t)bid * SEQ + 32 * lane); f32x4 v[8]; float run = 0.f;
#pragma unroll
            for (int j = 0; j < 8; ++j) v[j] = fl[j];
#pragma unroll
            for (int j = 0; j < 8; ++j) { v[j].x += run; v[j].y += v[j].x; v[j].z += v[j].y; v[j].w += v[j].z; run = v[j].w; }
            float incl = run;
#pragma unroll
            for (int o = 1; o < 64; o <<= 1) { const float t = __shfl_up(incl, o); if (lane >= o) incl += t; }
            const float excl = incl - run;
            f32x4* fo = (f32x4*)(fb + (size_t)bid * SEQ + 32 * lane);
#pragma unroll
            for (int j = 0; j < 8; ++j) fo[j] = (v[j] + excl) * -11.313708498984761f;
          } }
        pg8::Gemm g{HN, WinT, DM, DM, DM, 0}; pg8::StaticOrder S; S.init(M, 4096, G, bid);
        pg8::EpiG<0> E{U, 1024, 1024, (size_t)(AR_Q - AR_U) / 2, nullptr, nullptr, nullptr};
        pg8::gemm_phase(ldsl, g, S, E, wave_s);
    }
    xcd_barrier(bar, fresh_tid(wave_s));
    }
    STAMP(2); STAMP(3);

    PH(3) {
    {
        const int xcd = bid & 7, ix = bid >> 3;
        const int bh = (xcd * 4 + (ix >> 3)) & 31, qb = ix & 7, b = bh >> 3, h = bh & 7;
        if (bid < 256) {
            att::BlockRef cur;
            const size_t rowb = (size_t)b * SEQ;
            cur.Q = Qb + (rowb + (size_t)qb * 256) * 1024 + h * HD; cur.K = Kb + rowb * 1024 + h * HD; cur.V = Vb + rowb * 1024 + h * HD;
            cur.FB = fb + (size_t)bh * SEQ; cur.O = Y + (rowb + (size_t)qb * 256) * DM + POOLW + h * HD; cur.ST = STA + (rowb + (size_t)qb * 256) * 8 + h; cur.P0 = qb * 256;
            att::Seam S;
            att::prime(cur, (char*)lds, S, wave_s);
            att::block(cur, cur, (char*)lds, S, wave_s);
            asm volatile("s_waitcnt vmcnt(0)" ::: "memory");
            __syncthreads();
        }
        {
            pg8::SingleUnit S; const int id = bh * 4 + qb; S.valid = (bid < 256 && qb < 4) ? 1 : 0; S.pm = id >> 2; S.pn = id & 3;
            if (S.valid) {
                const int tid = fresh_tid(wave_s), cc = tid & 31, tg = tid >> 5, gi = S.pn, w = 2 << gi;
                const int t0 = S.pm * 256 + tg * 16, pos0 = t0 & (SEQ - 1), col = gi * 256 + cc * 8;
                const bf16_t* up = U + (size_t)t0 * POOLW + col; bf16_t* dp = DP + (size_t)t0 * POOLW + col;
                float sm[8] = {0.f, 0.f, 0.f, 0.f, 0.f, 0.f, 0.f, 0.f};
                for (int j = 1; j < w; ++j) if (pos0 - j >= 0) { const u32x4 v = *(const u32x4*)(up - (size_t)j * POOLW);
                    sm[0] += bf_lo(v.x); sm[1] += bf_hi(v.x); sm[2] += bf_lo(v.y); sm[3] += bf_hi(v.y); sm[4] += bf_lo(v.z); sm[5] += bf_hi(v.z); sm[6] += bf_lo(v.w); sm[7] += bf_hi(v.w); }
                for (int i = 0; i < 16; ++i) { const int pos = pos0 + i; const u32x4 v = *(const u32x4*)(up + (size_t)i * POOLW);
                    const float f[8] = {bf_lo(v.x), bf_hi(v.x), bf_lo(v.y), bf_hi(v.y), bf_lo(v.z), bf_hi(v.z), bf_lo(v.w), bf_hi(v.w)};
                    const float inv = 1.0f / (float)((pos + 1 < w) ? pos + 1 : w);
                    float d[8];
#pragma unroll
                    for (int e = 0; e < 8; ++e) { sm[e] += f[e]; d[e] = sm[e] * inv - f[e]; }
                    u32x4 o; o.x = cvt_pk_bf16(d[0], d[1]); o.y = cvt_pk_bf16(d[2], d[3]); o.z = cvt_pk_bf16(d[4], d[5]); o.w = cvt_pk_bf16(d[6], d[7]);
                    *(u32x4*)(dp + (size_t)i * POOLW) = o;
                    if (pos - w + 1 >= 0) { const u32x4 q = *(const u32x4*)(up + (size_t)(i - w + 1) * POOLW);
                        sm[0] -= bf_lo(q.x); sm[1] -= bf_hi(q.x); sm[2] -= bf_lo(q.y); sm[3] -= bf_hi(q.y); sm[4] -= bf_lo(q.z); sm[5] -= bf_hi(q.z); sm[6] -= bf_lo(q.w); sm[7] -= bf_hi(q.w); } }
                asm volatile("s_waitcnt vmcnt(0)" ::: "memory");
                __syncthreads();
            }
            pg8::Gemm g{DP, WpoolT, POOLW, 256, 256, 256};
            pg8::EpiG<4> E{Y, DM, 0, 0, args.in[I_POOLSCALE], nullptr, STP};
            pg8::gemm_phase(ldsl, g, S, E, wave_s);
        }
        {
            pg8::ListSched S; S.id0 = __builtin_amdgcn_readfirstlane((bh * 4 + qb) * 2); S.n = __builtin_amdgcn_readfirstlane((bid < 256 && qb < 4) ? 2 : 0); S.nN = DM / 256;
            pg8::Gemm g{PBF, WpleT, PLE, PLE, PLE, 0}; pg8::EpiG<0> E{Eb, DM, 0, 0, nullptr, nullptr, nullptr};
            pg8::gemm_phase(ldsl, g, S, E, wave_s);
        }
        __syncthreads();
        {
            const int tid = fresh_tid(wave_s), lane = tid & 63, wave = __builtin_amdgcn_readfirstlane(tid >> 6);
            LAS unsigned* T = (LAS unsigned*)ldsl;
            constexpr int T_OUT = 16 * 8, T_UP = 16 * 32, T_DOWN = 64 * 8, T_GATE = 16 * 8, NT2 = T_OUT + T_UP + T_DOWN + T_GATE, CH = 4;
            unsigned* ctr = barw + XCD_BAR_WORDS + 16;
            f32x4 va[16], vb[16];
            bf16_t* aWT = nullptr; int aK = 0, ak0 = 0, an0 = 0; bf16_t* bWT = nullptr; int bK = 0, bk0 = 0, bn0 = 0; const float* aG = nullptr; const float* bG = nullptr;
            unsigned cbase = 0; int ci = CH; int ta, tb;
#define TR_NEXT(dst) do { if (ci == CH) { if (tid == 0) MISC[12] = __hip_atomic_fetch_add(ctr, (unsigned)CH, __ATOMIC_RELAXED, __HIP_MEMORY_SCOPE_AGENT); \
                __syncthreads(); cbase = MISC[12]; __syncthreads(); ci = 0; } \
            dst = (int)cbase + ci; ++ci; if (dst >= NT2) dst = -1; } while (0)
#define TR_DECODE_LOAD(tt, V, xWT, xK, xk0, xn0, xG) do { int r_ = (tt), nnb_, ldw_; const float* W_; xG = nullptr; \
            if (r_ < T_OUT) { W_ = args.in[I_WOUT]; ldw_ = DM; xK = DM; xWT = WoutT; nnb_ = 8; const int k0_ = 128 * (r_ / 8); xG = (k0_ < POOLW) ? args.in[I_GPOOLOUT] + k0_ : args.in[I_GATTNOUT] + (k0_ - POOLW); } \
            else if ((r_ -= T_OUT) < T_UP) { W_ = args.in[I_WUP]; ldw_ = DFF; xK = DM; xWT = WupT; nnb_ = 32; } \
            else if ((r_ -= T_UP) < T_DOWN) { W_ = args.in[I_WDOWN]; ldw_ = DM; xK = DFF; xWT = WdownT; nnb_ = 8; } \
            else { r_ -= T_DOWN; W_ = args.in[I_WGATE]; ldw_ = DM; xK = DM; xWT = WgateT; nnb_ = 8; } \
            xk0 = 128 * (r_ / nnb_); xn0 = 256 * (r_ % nnb_); \
            const float* src_ = W_ + (size_t)(xk0 + 16 * wave) * ldw_ + xn0 + 4 * lane; \
            _Pragma("unroll") for (int r = 0; r < 16; ++r) V[r] = __builtin_nontemporal_load((const f32x4*)(src_ + (size_t)r * ldw_)); } while (0)
#define TR_PROCESS(V, xWT, xK, xk0, xn0, xG, tcur) do { \
                bf16_t* const sWT_ = xWT; const int sK_ = xK, sk0_ = xk0, sn0_ = xn0; \
                if (xG) { _Pragma("unroll") for (int r = 0; r < 16; ++r) V[r] = V[r] * xG[16 * wave + r]; } \
                _Pragma("unroll") for (int rp = 0; rp < 8; ++rp) _Pragma("unroll") for (int j = 0; j < 4; ++j) T[(4 * lane + j) * 65 + 8 * wave + rp] = cvt_pk_bf16(V[2 * rp][j], V[2 * rp + 1][j]); \
                TR_NEXT(tcur); \
                __syncthreads(); \
                if (tcur >= 0) TR_DECODE_LOAD(tcur, V, xWT, xK, xk0, xn0, xG); \
                {   const int c = lane & 15, nn = lane >> 4; \
                    _Pragma("unroll") for (int i = 0; i < 8; ++i) { const int n = 4 * (wave + 8 * i) + nn; const LAS unsigned* sp = T + n * 65 + 4 * c; \
                        u32x4 o; o.x = sp[0]; o.y = sp[1]; o.z = sp[2]; o.w = sp[3]; \
                        *(u32x4*)(sWT_ + (size_t)(sn0_ + n) * sK_ + sk0_ + 8 * c) = o; } } \
                __syncthreads(); } while (0)
            TR_NEXT(ta); TR_NEXT(tb);
            if (ta >= 0) TR_DECODE_LOAD(ta, va, aWT, aK, ak0, an0, aG);
            if (tb >= 0) TR_DECODE_LOAD(tb, vb, bWT, bK, bk0, bn0, bG);
            while (ta >= 0) {
                TR_PROCESS(va, aWT, aK, ak0, an0, aG, ta);
                if (tb < 0) break;
                TR_PROCESS(vb, bWT, bK, bk0, bn0, bG, tb);
            }
#undef TR_PROCESS
#undef TR_NEXT
#undef TR_DECODE_LOAD
        }
    }
    xcd_barrier(bar, fresh_tid(wave_s));
    }
    STAMP(4);

    PH(5) {
    {
        pg8::StaticOrder S; S.init(M, DM, G, bid);
        LAS float* rho = (LAS float*)(ldsl + 131072);
        { const int t = fresh_tid(wave_s); pg8::Unit u0; if (S.next(0, u0) && t < 256) { const size_t row = (size_t)u0.pm * 256 + t;
            const f32x4* pa = (const f32x4*)(STA + row * 8); const f32x4* pp = (const f32x4*)(STP + row * 16);
            const f32x4 a0 = pa[0], a1 = pa[1], p0 = pp[0], p1 = pp[1], p2 = pp[2], p3 = pp[3];
            const float sa = (a0.x + a0.y + a0.z + a0.w) + (a1.x + a1.y + a1.z + a1.w);
            const float sp = ((p0.x + p0.y + p0.z + p0.w) + (p1.x + p1.y + p1.z + p1.w)) + ((p2.x + p2.y + p2.z + p2.w) + (p3.x + p3.y + p3.z + p3.w));
            rho[t] = sqrtf((sa * (1.f / 1024.f) + EPS) / (sp * (1.f / 1024.f) + EPS)); }
          __syncthreads(); }
        pg8::Gemm g{Y, WoutT, DM, DM, DM, 0};
        pg8::EpiG<0> E{RAW1, DM, 0, 0, nullptr, nullptr, nullptr};
        pg8::gemm_phase<true>(ldsl, g, S, E, wave_s, rho);
    }
    xcd_barrier(bar, fresh_tid(wave_s));
    }
    STAMP(6);

    PH(6) {
    { PHASE_IDS();
    resnorm_phase<false, true>(XIN, RAW1, args.in[I_GPOSTMIX], H1, args.in[I_GPREMLP], HN, gw, NGW, lane); }
    xcd_barrier(bar, fresh_tid(wave_s));
    }
    STAMP(7);

    PH(7) {
    {
        pg8::Gemm g{HN, WupT, DM, DM, DM, 0}; pg8::StaticOrder S; S.init(M, DFF, G, bid);
        pg8::EpiG<2> E{HID, DFF, 0, 0, nullptr, nullptr, nullptr};
        pg8::gemm_phase(ldsl, g, S, E, wave_s);
    }
    xcd_barrier(bar, fresh_tid(wave_s));
    }
    STAMP(8);

    PH(8) {
    {
        pg8::Gemm g{HID, WdownT, DFF, DFF, DFF, 0}; pg8::StaticOrder S; S.init(M, DM, G, bid);
        pg8::EpiG<0> E{RAW2, DM, 0, 0, nullptr, nullptr, nullptr};
        pg8::gemm_phase(ldsl, g, S, E, wave_s);
    }
    xcd_barrier(bar, fresh_tid(wave_s));
    }
    STAMP(9);

    PH(9) {
    { PHASE_IDS();
    resnorm_phase<true, true>(H1, RAW2, args.in[I_GPOSTMLP], H2, args.in[I_GPLEGATE], HN, gw, NGW, lane); }
    xcd_barrier(bar, fresh_tid(wave_s));
    }
    STAMP(10);

    PH(10) {
    {
        pg8::StaticOrder S; S.init(M, DM, G, bid);
        { pg8::Gemm g{HN, WgateT, DM, DM, DM, 0}; pg8::EpiG<3> E{RAW2, DM, 0, 0, nullptr, Eb, nullptr}; pg8::gemm_phase(ldsl, g, S, E, wave_s); }
    }
    xcd_barrier(bar, fresh_tid(wave_s));
    }
    STAMP(11);

    PH(11) {
    { PHASE_IDS();
    resnorm_phase<true, false>(H2, RAW2, args.in[I_GPOSTPLE], OUTP, nullptr, nullptr, gw, NGW, lane); }
    }
#if PROBE_TS >= 0
    STAMP(12);
    if (bid == 0 && fresh_tid(wave_s) == 0) { asm volatile("s_waitcnt vmcnt(0)" ::: "memory");
        const unsigned long long a_ = ((unsigned long long)MISC[17 + 2 * PROBE_TS] << 32) | MISC[16 + 2 * PROBE_TS], b_ = ((unsigned long long)MISC[17 + 2 * (PROBE_TSB)] << 32) | MISC[16 + 2 * (PROBE_TSB)];
        OUTP[0] += (float)(b_ - a_) * 0.01f - (float)PROBE_OFF; }
#endif
}

#undef WSP
#undef XIN
#undef OUTP
#undef flog
#undef fb
#undef WinT
#undef WoutT
#undef WupT
#undef WdownT
#undef WgateT
#undef WpleT
#undef WpoolT
#undef HN
#undef U
#undef Qb
#undef Kb
#undef Vb
#undef YP
#undef YA
#undef DP
#undef Y
#undef RAW1
#undef HID
#undef Eb
#undef RAW2
#undef PBF
#undef STA
#undef STP
#undef H1
#undef H2

extern "C" void kernel_launch(void* const* d_in, const int* in_sizes, int n_in, void* d_out, int out_size, void* d_ws, size_t ws_size, hipStream_t stream) {
    static int grid = 0;
    if (grid == 0) {
        if (n_in != 19 || in_sizes[0] != M * DM || out_size != M * DM || ws_size < WS_END) {
            fprintf(stderr, "kernel_launch: unexpected shapes (n_in %d in0 %d out %d ws %zu)\n", n_in, n_in > 0 ? in_sizes[0] : -1, out_size, ws_size); grid = -1; return; }
        int dev = 0, cus = 0, per_cu = 0;
        hipGetDevice(&dev); hipDeviceGetAttribute(&cus, hipDeviceAttributeMultiprocessorCount, dev);
        if (hipFuncSetAttribute((const void*)mega_fwd, hipFuncAttributeMaxDynamicSharedMemorySize, LDS_BYTES) != hipSuccess) { fprintf(stderr, "kernel_launch: hipFuncSetAttribute failed\n"); grid = -1; return; }
        if (hipOccupancyMaxActiveBlocksPerMultiprocessor(&per_cu, (const void*)mega_fwd, NTHREADS, LDS_BYTES) != hipSuccess || per_cu < 1) {
            fprintf(stderr, "kernel_launch: occupancy query says %d\n", per_cu); per_cu = 1; }
        (void)hipGetLastError();
        grid = cus * 1;
        if (grid != 256) fprintf(stderr, "kernel_launch: grid %d (expected 256)\n", grid);
    }
    if (grid < 0) return;
    if (hipMemsetAsync(d_ws, 0, (XCD_BAR_WORDS + 64) * sizeof(unsigned), stream) != hipSuccess) { fprintf(stderr, "kernel_launch: hipMemsetAsync failed\n"); return; }
    Args a{};
    for (int i = 0; i < 19; ++i) a.in[i] = (const float*)d_in[i];
    a.out = (float*)d_out; a.ws = (unsigned char*)d_ws;
    void* kargs[] = {&a};
    hipError_t e = hipLaunchCooperativeKernel((const void*)mega_fwd, dim3(grid), dim3(NTHREADS), kargs, LDS_BYTES, stream);
    if (e != hipSuccess) fprintf(stderr, "kernel_launch: cooperative launch failed: %s (grid %d)\n", hipGetErrorString(e), grid);
}
```

```cpp
#include <hip/hip_runtime.h>
#include <hip/hip_bf16.h>
#include <hip/hip_cooperative_groups.h>
#include <cstdio>
#include <cstdint>
namespace cg = cooperative_groups;

#define LAS __attribute__((address_space(3)))
typedef unsigned short bf16_t;
typedef short bf16x8 __attribute__((ext_vector_type(8)));
typedef short s16x4 __attribute__((ext_vector_type(4)));
typedef float f32x4 __attribute__((ext_vector_type(4)));
typedef float f32x2 __attribute__((ext_vector_type(2)));
typedef float f32x16 __attribute__((ext_vector_type(16)));
typedef unsigned u32x4 __attribute__((ext_vector_type(4)));
typedef unsigned u32x2 __attribute__((ext_vector_type(2)));

constexpr int DM = 2048, SEQ = 2048, NB = 4, M = NB * SEQ, POOLW = 1024, ATTW = 1024, NH = 8, HD = 128, DFF = 8192, PLE = 256, INW = 4104;
constexpr float EPS = 1e-6f;

constexpr size_t MiB = 1u << 20;
constexpr size_t WS_FLOG = 1 * MiB;
constexpr size_t WS_FB = 1 * MiB + 512 * 1024;
constexpr size_t WS_WIN = 2 * MiB, WS_WOUT = 18 * MiB, WS_WUP = 26 * MiB, WS_WDOWN = 58 * MiB, WS_WGATE = 90 * MiB, WS_WPLE = 98 * MiB, WS_WPOOL = 99 * MiB;
constexpr size_t WS_HN = 100 * MiB;
constexpr size_t WS_ARENA = 132 * MiB;
constexpr size_t AR_U = WS_ARENA, AR_Q = WS_ARENA + 16 * MiB, AR_K = WS_ARENA + 32 * MiB, AR_V = WS_ARENA + 48 * MiB;
constexpr size_t AR_YP = WS_ARENA + 64 * MiB, AR_YA = WS_ARENA + 80 * MiB, AR_DP = WS_ARENA + 96 * MiB;
constexpr size_t AR_Y = AR_YP;
constexpr size_t AR_RAW1 = WS_ARENA + 32 * MiB;
constexpr size_t AR_HID = WS_ARENA;
constexpr size_t AR_E = WS_ARENA;
constexpr size_t WS_RAW2 = WS_WUP;
constexpr size_t WS_PBF = 260 * MiB;
constexpr size_t WS_STA = 1 * MiB + 256 * 1024;
constexpr size_t WS_RS0 = 1 * MiB + 768 * 1024, WS_MSA = WS_RS0 + 32768, WS_MS2 = WS_MSA + 32768, WS_RS3 = WS_MS2 + 32768;
constexpr size_t WS_STP = 264 * MiB;
constexpr size_t WS_END = 265 * MiB;

__device__ __forceinline__ unsigned cvt_pk_bf16(float lo, float hi) { unsigned r; asm volatile("v_cvt_pk_bf16_f32 %0, %1, %2" : "=v"(r) : "v"(lo), "v"(hi)); return r; }
__device__ __forceinline__ int fresh_tid(int wv) { int l; asm volatile("v_mbcnt_lo_u32_b32 %0, -1, 0\n\tv_mbcnt_hi_u32_b32 %0, -1, %0" : "=v"(l)); return (wv << 6) | l; }
__device__ __forceinline__ float bf_lo(unsigned w) { return __uint_as_float(w << 16); }
__device__ __forceinline__ float bf_hi(unsigned w) { return __uint_as_float(w & 0xffff0000u); }
__device__ __forceinline__ float wave_sum(float v) {
#define WS_SWZ(o) v += __int_as_float(__builtin_amdgcn_ds_swizzle(__float_as_int(v), 0x1f | ((o) << 10)))
    WS_SWZ(1); WS_SWZ(2); WS_SWZ(4); WS_SWZ(8); WS_SWZ(16);
#undef WS_SWZ
    const auto rr = __builtin_amdgcn_permlane32_swap(__float_as_uint(v), __float_as_uint(v), false, false);
    return __uint_as_float(rr[0]) + __uint_as_float(rr[1]);
}

namespace pg8 {
constexpr int BM = 256, BK = 64, HALF = 128, HTB = HALF * BK * 2, STAGE_BYTES = 8 * HTB, NXCD = 8, WGM = 8;
__host__ __device__ __forceinline__ int lds_byte(int r, int c) { const int st = (r >> 4) * 2 + (c >> 5), rr = r & 15, cc = c & 31, ob = rr * 64 + cc * 2; return st * 1024 + (ob ^ (((ob >> 9) & 1) << 5)); }
__host__ __device__ __forceinline__ void stage_rc(int b, int& R, int& C) { const int st = b / 1024, sb = b % 1024, swz = sb ^ (((sb >> 9) & 1) << 5); R = (st >> 1) * 16 + swz / 64; C = (st & 1) * 32 + (swz % 64) / 2; }
__host__ __device__ __forceinline__ int perm32(int rho) { const int n = rho >> 4, i = rho & 15; return 8 * (i >> 2) + 4 * n + (i & 3); }

struct Unit { int pm, pn; };
struct Gemm { const bf16_t* A; const bf16_t* Bt; int lda, ldb, K, a_pn_koff; };

struct StaticOrder {
    int nM, nN, nwg, G, c;
    __device__ void init(int M_, int N_, int G_, int c_) { nM = M_ / BM; nN = N_ / BM; nwg = nM * nN; G = G_; c = c_; }
    __device__ bool next(int i, Unit& u) const {
        const long L = (long)i * G + c; if (L >= nwg) return false;
        int wgid = (int)L; { const int q = nwg / NXCD, r = nwg % NXCD, xcd = wgid % NXCD, off = wgid / NXCD; wgid = (xcd < r ? xcd * (q + 1) : r * (q + 1) + (xcd - r) * q) + off; }
        const int nig = WGM * nN, gid = wgid / nig, fm = gid * WGM, gsz = (nM - fm) < WGM ? (nM - fm) : WGM;
        u.pm = fm + ((wgid % nig) % gsz); u.pn = (wgid % nig) / gsz; return true;
    }
};
struct ListSched {
    int id0, n, nN;
    __device__ bool next(int i, Unit& u) const { if (i >= n) return false; const int id = id0 + i; u.pm = id / nN; u.pn = id % nN; return true; }
};
struct SingleUnit {
    int pm, pn, valid;
    __device__ bool next(int i, Unit& u) const { if (i != 0 || !valid) return false; u.pm = pm; u.pn = pn; return true; }
};

template <int ACT> struct EpiG {
    static constexpr bool PERM = true;
    bf16_t* O; int ldc; int split_cols; size_t split_stride; const float* colscale; const bf16_t* aux; float* stats; const float* rowscale;
    __device__ __forceinline__ void operator()(const f32x4 (&acc)[2][2][4][2], const Unit& u, int wr, int wc, int fr, int fq) const {
        const int row0 = u.pm * BM + wr * 64 + fr; int colt = u.pn * BM; bf16_t* base = O;
        if (split_cols) { const int t = colt / split_cols; base += (size_t)t * split_stride; colt -= t * split_cols; }
        const int col0 = colt + wc * 32 + 8 * fq, gcol0 = u.pn * BM + wc * 32 + 8 * fq;
        f32x4 cs[2][2];
        if (ACT == 4) {
#pragma unroll
            for (int bj = 0; bj < 2; ++bj)
#pragma unroll
                for (int n = 0; n < 2; ++n) cs[bj][n] = *(const f32x4*)(colscale + gcol0 + bj * HALF + 4 * n);
        }
        u32x4 evs[2][4][2];
        if (ACT == 3) {
#pragma unroll
            for (int ai = 0; ai < 2; ++ai)
#pragma unroll
                for (int m = 0; m < 4; ++m)
#pragma unroll
                    for (int bj = 0; bj < 2; ++bj) evs[ai][m][bj] = *(const u32x4*)(aux + (size_t)(row0 + ai * HALF + m * 16) * ldc + col0 + bj * HALF);
        }
#pragma unroll
        for (int ai = 0; ai < 2; ++ai)
#pragma unroll
            for (int m = 0; m < 4; ++m) { const size_t roff = (size_t)(row0 + ai * HALF + m * 16) * ldc + col0; float ssq = 0.f; (void)ssq;
                const float rsc = rowscale ? rowscale[row0 + ai * HALF + m * 16] : 1.f;
#pragma unroll
                for (int bj = 0; bj < 2; ++bj) { f32x4 v0 = acc[ai][bj][m][0] * rsc, v1 = acc[ai][bj][m][1] * rsc;
                    if (ACT == 2) {
#pragma unroll
                        for (int e = 0; e < 4; ++e) { float a = fmaxf(v0[e], 0.f), b = fmaxf(v1[e], 0.f); v0[e] = a * a; v1[e] = b * b; }
                    }
                    if (ACT == 3) { const u32x4 ev = evs[ai][m][bj];
                        const float e0[4] = {bf_lo(ev.x), bf_hi(ev.x), bf_lo(ev.y), bf_hi(ev.y)}, e1[4] = {bf_lo(ev.z), bf_hi(ev.z), bf_lo(ev.w), bf_hi(ev.w)};
#pragma unroll
                        for (int e = 0; e < 4; ++e) { v0[e] = __builtin_amdgcn_rcpf(1.f + __builtin_amdgcn_exp2f(-1.4426950408889634f * v0[e])) * e0[e];
                                                      v1[e] = __builtin_amdgcn_rcpf(1.f + __builtin_amdgcn_exp2f(-1.4426950408889634f * v1[e])) * e1[e]; }
                    }
                    if (ACT == 4) { v0 = v0 * cs[bj][0]; v1 = v1 * cs[bj][1];
                        ssq += (v0[0] * v0[0] + v0[1] * v0[1]) + (v0[2] * v0[2] + v0[3] * v0[3]) + (v1[0] * v1[0] + v1[1] * v1[1]) + (v1[2] * v1[2] + v1[3] * v1[3]); }
                    u32x4 w; w.x = cvt_pk_bf16(v0[0], v0[1]); w.y = cvt_pk_bf16(v0[2], v0[3]); w.z = cvt_pk_bf16(v1[0], v1[1]); w.w = cvt_pk_bf16(v1[2], v1[3]);
                    *(u32x4*)(base + roff + bj * HALF) = w; }
                if (ACT == 4) {
                    ssq += __int_as_float(__builtin_amdgcn_ds_swizzle(__float_as_int(ssq), 0x1f | (16 << 10)));
                    const auto rr = __builtin_amdgcn_permlane32_swap(__float_as_uint(ssq), __float_as_uint(ssq), false, false);
                    ssq = __uint_as_float(rr[0]) + __uint_as_float(rr[1]);
                    if (fq == 0) stats[(size_t)(row0 + ai * HALF + m * 16) * 16 + u.pn * 4 + wc] = ssq; } }
    }
};

template <bool MID = false, class Epi, class Sched>
__device__ __forceinline__ void gemm_phase(LAS unsigned char* lds, const Gemm g, const Sched& S, const Epi& E, int wv, const LAS float* rho = nullptr) {
    constexpr bool ALIGN_EPI = true;
    const int tid = fresh_tid(wv), wid = __builtin_amdgcn_readfirstlane(tid >> 6), lane = tid & 63, wr = wid >> 2, wc = wid & 3, fr = lane & 15, fq = lane >> 4;
    const int K = g.K, nt = K / BK;
    unsigned voffA[2], voffB[2];
#pragma unroll
    for (int i = 0; i < 2; ++i) { int R, C; stage_rc(tid * 16 + i * 8192, R, C); const int Rb = Epi::PERM ? ((R & ~31) + perm32(R & 31)) : R;
        voffA[i] = (unsigned)(R * g.lda + C) * 2u; voffB[i] = (unsigned)(Rb * g.ldb + C) * 2u; }
    const size_t kstep = (size_t)(BK * 2);
    const size_t hstepA = (size_t)HALF * g.lda * 2, hstepB = (size_t)HALF * g.ldb * 2;
    const size_t tstepA = 2 * hstepA, tstepB = 2 * hstepB;
    const unsigned ldsw = (unsigned)wid * 1024u;
    const int aoff = lds_byte(wr * 64 + fr, fq * 8), boff = lds_byte(wc * 32 + fr, fq * 8);
#define PG8_SA(b, h) (((b) * 2 + (h)) * HTB)
#define PG8_SB(b, h) ((4 + (b) * 2 + (h)) * HTB)
#define PG8_STAGE(bufoff, gbase, voff) do { _Pragma("unroll") for (int _i = 0; _i < 2; ++_i) \
        __builtin_amdgcn_global_load_lds((const unsigned*)((const char*)(gbase) + (voff)[_i]), (LAS unsigned*)(lds + (bufoff) + ldsw + _i * 8192), 16, 0, 0); } while (0)
#define PG8_LDA(dst, b, h) do { _Pragma("unroll") for (int m = 0; m < 4; ++m) _Pragma("unroll") for (int k = 0; k < 2; ++k) dst[m][k] = *(const LAS bf16x8*)(lds + PG8_SA(b, h) + aoff + m * 2048 + k * 1024); } while (0)
#define PG8_LDB(dst, b, h) do { _Pragma("unroll") for (int n = 0; n < 2; ++n) _Pragma("unroll") for (int k = 0; k < 2; ++k) dst[n][k] = *(const LAS bf16x8*)(lds + PG8_SB(b, h) + boff + n * 2048 + k * 1024); } while (0)
#define PG8_MMA(ai, bj, At, Bt) do { __builtin_amdgcn_s_setprio(1); _Pragma("unroll") for (int m = 0; m < 4; ++m) _Pragma("unroll") for (int n = 0; n < 2; ++n) _Pragma("unroll") for (int k = 0; k < 2; ++k) \
        acc[ai][bj][m][n] = __builtin_amdgcn_mfma_f32_16x16x32_bf16(Bt[n][k], At[m][k], acc[ai][bj][m][n], 0, 0, 0); __builtin_amdgcn_s_setprio(0); } while (0)
#define PG8_WAIT_V(n) asm volatile("s_waitcnt vmcnt(" #n ")" ::: "memory")
#define PG8_WAIT_L(n) asm volatile("s_waitcnt lgkmcnt(" #n ")" ::: "memory")
#define PG8_BAR __builtin_amdgcn_s_barrier()
#define PG8_SCHED __builtin_amdgcn_sched_barrier(0)
    Unit cur, nxt; int ui = 0;
    if (!S.next(0, cur)) return;
    f32x4 acc[2][2][4][2];
#pragma unroll
    for (int a = 0; a < 2; ++a)
#pragma unroll
        for (int b = 0; b < 2; ++b)
#pragma unroll
            for (int m = 0; m < 4; ++m)
#pragma unroll
                for (int n = 0; n < 2; ++n) acc[a][b][m][n] = (f32x4){0.f, 0.f, 0.f, 0.f};
    bf16x8 At[4][2], B0[2][2], B1[2][2];
    const char* cA = (const char*)g.A + (size_t)cur.pm * tstepA + (size_t)cur.pn * g.a_pn_koff * 2; const char* cB = (const char*)g.Bt + (size_t)cur.pn * tstepB;
    PG8_STAGE(PG8_SB(0, 0), cB, voffB); PG8_STAGE(PG8_SB(0, 1), cB + hstepB, voffB); PG8_STAGE(PG8_SA(0, 0), cA, voffA); PG8_STAGE(PG8_SA(0, 1), cA + hstepA, voffA);
    if (wr == 1) PG8_BAR;
    PG8_WAIT_V(2); PG8_BAR;
    PG8_STAGE(PG8_SB(1, 0), cB + kstep, voffB); PG8_STAGE(PG8_SA(1, 0), cA + kstep, voffA); PG8_STAGE(PG8_SB(1, 1), cB + hstepB + kstep, voffB);
    PG8_WAIT_V(6); PG8_BAR;
    for (;;) {
        const bool has_next = S.next(ui + 1, nxt);
        const char* nA = has_next ? (const char*)g.A + (size_t)nxt.pm * tstepA + (size_t)nxt.pn * g.a_pn_koff * 2 : cA; const char* nB = has_next ? (const char*)g.Bt + (size_t)nxt.pn * tstepB : cB;
        asm volatile("" : "+s"(nA), "+s"(nB));
        for (int t = 0; t < nt; t += 2) {
            const bool last = (t == nt - 2);
            if (MID && t == (nt >> 1)) {
#pragma unroll
                for (int a = 0; a < 2; ++a)
#pragma unroll
                    for (int m = 0; m < 4; ++m) { const float rh = rho[a * HALF + wr * 64 + m * 16 + fr];
#pragma unroll
                        for (int b = 0; b < 2; ++b)
#pragma unroll
                            for (int n = 0; n < 2; ++n) acc[a][b][m][n] = acc[a][b][m][n] * rh; }
            }
            const char* a1 = cA + (size_t)(t + 1) * kstep;
            const char* a2 = last ? nA : cA + (size_t)(t + 2) * kstep; const char* b2 = last ? nB : cB + (size_t)(t + 2) * kstep;
            const char* a3 = a2 + kstep; const char* b3 = b2 + kstep;
            PG8_LDB(B0, 0, 0); PG8_LDB(B1, 0, 1); PG8_SCHED; PG8_LDA(At, 0, 0); PG8_STAGE(PG8_SA(1, 1), a1 + hstepA, voffA);
            PG8_WAIT_V(8); PG8_WAIT_L(0); PG8_BAR; PG8_MMA(0, 0, At, B0); PG8_MMA(0, 1, At, B1); PG8_BAR; PG8_SCHED;
            PG8_LDA(At, 0, 1); PG8_STAGE(PG8_SB(0, 0), b2, voffB); PG8_STAGE(PG8_SB(0, 1), b2 + hstepB, voffB); PG8_STAGE(PG8_SA(0, 0), a2, voffA);
            PG8_WAIT_V(8); PG8_WAIT_L(0); PG8_BAR; PG8_MMA(1, 0, At, B0); PG8_MMA(1, 1, At, B1); PG8_BAR; PG8_SCHED;
            PG8_LDB(B0, 1, 0); PG8_LDB(B1, 1, 1); PG8_SCHED; PG8_LDA(At, 1, 0); PG8_STAGE(PG8_SA(0, 1), a2 + hstepA, voffA);
            PG8_WAIT_V(8); PG8_WAIT_L(0); PG8_BAR; PG8_MMA(0, 0, At, B0); PG8_MMA(0, 1, At, B1); PG8_BAR; PG8_SCHED;
            PG8_LDA(At, 1, 1); PG8_STAGE(PG8_SB(1, 0), b3, voffB); PG8_STAGE(PG8_SB(1, 1), b3 + hstepB, voffB); PG8_STAGE(PG8_SA(1, 0), a3, voffA);
            PG8_WAIT_V(8); PG8_WAIT_L(0); PG8_BAR; PG8_MMA(1, 0, At, B0); PG8_MMA(1, 1, At, B1); PG8_BAR; PG8_SCHED;
        }
        if constexpr (ALIGN_EPI) { if (wr == 0) PG8_BAR; }
        { const int t2 = fresh_tid(wv), w2 = __builtin_amdgcn_readfirstlane(t2 >> 6), l2 = t2 & 63; E(acc, cur, w2 >> 2, w2 & 3, l2 & 15, l2 >> 4); }
        if (!has_next) break;
#pragma unroll
        for (int a = 0; a < 2; ++a)
#pragma unroll
            for (int b = 0; b < 2; ++b)
#pragma unroll
                for (int m = 0; m < 4; ++m)
#pragma unroll
                    for (int n = 0; n < 2; ++n) acc[a][b][m][n] = (f32x4){0.f, 0.f, 0.f, 0.f};
        cur = nxt; cA = nA; cB = nB; ++ui;
        if constexpr (ALIGN_EPI) { if (wr == 1) PG8_BAR; }
    }
    PG8_WAIT_V(0);
    if constexpr (!ALIGN_EPI) { if (wr == 0) PG8_BAR; }
    PG8_BAR;
#undef PG8_SA
#undef PG8_SB
#undef PG8_STAGE
#undef PG8_LDA
#undef PG8_LDB
#undef PG8_MMA
#undef PG8_WAIT_V
#undef PG8_WAIT_L
#undef PG8_BAR
#undef PG8_SCHED
}
}

namespace att {
constexpr int D = 128, LD = 1024, LDO = 2048;
constexpr float SCALE = 0.08838834764831845f;
constexpr float THR = 8.f;
constexpr int NW = 8, QBLK = 32, KVBLK = 64, QB = NW * QBLK;
constexpr int SHM_V = KVBLK * D * 2, SHM_K = KVBLK * D * 2;
constexpr int OFF_WS = 2 * SHM_V + 2 * SHM_K, OFF_BIAS = OFF_WS + NW * 64 * 4, LDS_BYTES = OFF_BIAS + 512;
typedef bf16_t bf16;
#define KSWZ(row, colB) ((row) * 256 + ((colB) ^ (((row) & 7) << 4)))
#define SBAR() __builtin_amdgcn_sched_barrier(0)
__device__ __forceinline__ int v_st(int k, int c) { const int kk = (k & ~0xC) | ((k & 4) << 1) | ((k & 8) >> 1); return ((kk >> 3) * 4 + (c >> 5)) * 512 + ((kk & 7) * 32 + (c & 31)) * 2; }
__device__ __forceinline__ int v_rd_base(int lane) { return ((lane & 3) << 3) | (((lane >> 2) & 3) << 6) | (((lane >> 4) & 1) << 5) | (((lane >> 5) & 1) << 8); }
constexpr int v_rd_off(int d0, int ks, int half) { return d0 * 512 + ks * 4096 + half * 2048; }
__device__ __forceinline__ int crow(int r, int hi) { return (r & 3) + 8 * (r >> 2) + 4 * hi; }
__device__ __forceinline__ unsigned cvtpk(float lo, float hi) { unsigned r; asm volatile("v_cvt_pk_bf16_f32 %0, %1, %2" : "=v"(r) : "v"(lo), "v"(hi)); return r; }
__device__ __forceinline__ bf16x8 load8(const bf16* p) { return *reinterpret_cast<const bf16x8*>(p); }
__device__ __forceinline__ void mask_tile(f32x16& p0, f32x16& p1, int dq, unsigned W) {
    const float NEG = -__builtin_inff();
#pragma unroll
    for (int r = 0; r < 16; ++r) {
        const int c = (r & 3) + 8 * (r >> 2);
        if ((unsigned)(dq - c) >= W) p0[r] = NEG;
        if ((unsigned)(dq - c - 32) >= W) p1[r] = NEG;
    }
}
__device__ __forceinline__ void partialSM(f32x16& p0, f32x16& p1, float& m_reg, float& mn, float& alpha) {
    float pmax = p0[0]; for (int r = 1; r < 16; ++r) pmax = fmaxf(pmax, p0[r]); for (int r = 0; r < 16; ++r) pmax = fmaxf(pmax, p1[r]);
    { auto rr = __builtin_amdgcn_permlane32_swap(__float_as_uint(pmax), __float_as_uint(pmax), false, false);
      pmax = fmaxf(__uint_as_float(rr[0]), __uint_as_float(rr[1])); }
    constexpr float C2 = 1.4426950408889634f * SCALE;
    if (__builtin_expect(__all((pmax - m_reg) * SCALE <= THR), 1)) { mn = m_reg; alpha = 1.f; }
    else { mn = fmaxf(m_reg, pmax); alpha = __builtin_amdgcn_exp2f((m_reg - mn) * C2); m_reg = mn; }
    const float mnL = -mn * C2;
    for (int r = 0; r < 16; ++r) p0[r] = fmaf(p0[r], C2, mnL); for (int r = 0; r < 16; ++r) p1[r] = fmaf(p1[r], C2, mnL);
    for (int r = 0; r < 16; ++r) p0[r] = __builtin_amdgcn_exp2f(p0[r]);
}
__device__ __forceinline__ void finishSM(f32x16& p0, f32x16& p1, float alpha, float& l_reg, bf16x8& pa0, bf16x8& pa1, bf16x8& pa2, bf16x8& pa3) {
    for (int r = 0; r < 16; ++r) p1[r] = __builtin_amdgcn_exp2f(p1[r]);
    float ps = 0; for (int r = 0; r < 16; ++r) ps += p0[r]; for (int r = 0; r < 16; ++r) ps += p1[r];
    { auto rr = __builtin_amdgcn_permlane32_swap(__float_as_uint(ps), __float_as_uint(ps), false, false);
      ps = __uint_as_float(rr[0]) + __uint_as_float(rr[1]); }
    l_reg = l_reg * alpha + ps;
#define PK4(P, B_, OUT) do { unsigned a0 = cvtpk(P[B_+0], P[B_+1]), a1 = cvtpk(P[B_+2], P[B_+3]);                          \
        unsigned b0 = cvtpk(P[B_+4], P[B_+5]), b1 = cvtpk(P[B_+6], P[B_+7]);                                             \
        auto r0 = __builtin_amdgcn_permlane32_swap(a0, b0, false, false); auto r1 = __builtin_amdgcn_permlane32_swap(a1, b1, false, false); \
        u32x4 w = {r0[0], r1[0], r0[1], r1[1]}; OUT = *reinterpret_cast<bf16x8*>(&w); } while (0)
    PK4(p0, 0, pa0); PK4(p0, 8, pa1); PK4(p1, 0, pa2); PK4(p1, 8, pa3);
#undef PK4
}
template <int KB>
__device__ __forceinline__ void qkt(f32x16& p0, f32x16& p1, const char* K_lds, const char* B_lds, int r32, int hi, const bf16x8* qr) {
    const f32x4* bp = (const f32x4*)(B_lds + KB * 256 + hi * 16);
#pragma unroll
    for (int i = 0; i < 4; ++i) { const f32x4 a = bp[2 * i], b = bp[8 + 2 * i];
        p0[4 * i] = a[0]; p0[4 * i + 1] = a[1]; p0[4 * i + 2] = a[2]; p0[4 * i + 3] = a[3];
        p1[4 * i] = b[0]; p1[4 * i + 1] = b[1]; p1[4 * i + 2] = b[2]; p1[4 * i + 3] = b[3]; }
    const char* kb[4];
#pragma unroll
    for (int dd = 0; dd < 4; ++dd) kb[dd] = K_lds + KB * SHM_K + KSWZ(r32, (dd * 16 + hi * 8) * 2);
#pragma unroll
    for (int d0 = 0; d0 < 8; ++d0) { const char* a = kb[d0 & 3] + (d0 >> 2) * 128;
        bf16x8 b0 = *reinterpret_cast<const bf16x8*>(a);
        bf16x8 b1 = *reinterpret_cast<const bf16x8*>(a + 32 * 256);
        p0 = __builtin_amdgcn_mfma_f32_32x32x16_bf16(b0, qr[d0], p0, 0, 0, 0);
        p1 = __builtin_amdgcn_mfma_f32_32x32x16_bf16(b1, qr[d0], p1, 0, 0, 0); }
}
template <int VB>
__device__ __forceinline__ void pv_tile(f32x16* o, int vb0, bf16x8 pa0, bf16x8 pa1, bf16x8 pa2, bf16x8 pa3) {
#define TRRD(dst, off) asm volatile("ds_read_b64_tr_b16 %0, %1 offset:%2" : "=&v"(dst) : "v"(vb0), "i"(off) : "memory")
#define PV_D0(d0) do { s16x4 l0, l1, l2, l3, h0, h1, h2, h3; constexpr int b_ = VB * SHM_V + v_rd_off(d0, 0, 0); \
        TRRD(l0, b_); TRRD(h0, b_ + 2048); TRRD(l1, b_ + 4096); TRRD(h1, b_ + 6144); TRRD(l2, b_ + 8192); TRRD(h2, b_ + 10240); TRRD(l3, b_ + 12288); TRRD(h3, b_ + 14336); \
        asm volatile("s_waitcnt lgkmcnt(0)" ::: "memory"); SBAR();   \
        o[d0] = __builtin_amdgcn_mfma_f32_32x32x16_bf16(pa0, (bf16x8){l0[0], l0[1], l0[2], l0[3], h0[0], h0[1], h0[2], h0[3]}, o[d0], 0, 0, 0);   \
        o[d0] = __builtin_amdgcn_mfma_f32_32x32x16_bf16(pa1, (bf16x8){l1[0], l1[1], l1[2], l1[3], h1[0], h1[1], h1[2], h1[3]}, o[d0], 0, 0, 0);   \
        o[d0] = __builtin_amdgcn_mfma_f32_32x32x16_bf16(pa2, (bf16x8){l2[0], l2[1], l2[2], l2[3], h2[0], h2[1], h2[2], h2[3]}, o[d0], 0, 0, 0);   \
        o[d0] = __builtin_amdgcn_mfma_f32_32x32x16_bf16(pa3, (bf16x8){l3[0], l3[1], l3[2], l3[3], h3[0], h3[1], h3[2], h3[3]}, o[d0], 0, 0, 0); } while (0)
    PV_D0(0); PV_D0(1); PV_D0(2); PV_D0(3);
#undef PV_D0
#undef TRRD
}
struct BlockRef { const bf16* Q; const bf16* K; const bf16* V; const float* FB; bf16* O; float* ST; int P0; };
struct Seam { bf16x8 qr[8]; bf16x8 st_v0, st_v1, st_k0, st_k1; float st_b; };
#define ROW(p, k0, rr) ((p) + (size_t)((k0) + (rr)) * LD + sc)
#define VMW() asm volatile("s_waitcnt vmcnt(0)" ::: "memory")
#define VMWN(n) asm volatile("s_waitcnt vmcnt(%0)" :: "i"(n) : "memory")
#define SLOAD_H(Kp, Vp, Fp, k0) do { S.st_v0 = load8(ROW(Vp, k0, sr)); S.st_v1 = load8(ROW(Vp, k0, 32 + sr));              \
                         S.st_k0 = load8(ROW(Kp, k0, sr)); S.st_k1 = load8(ROW(Kp, k0, 32 + sr)); S.st_b = (Fp)[(k0) + (tid & 63)]; } while (0)
#define SWRITE_HK(bf) do { *(bf16x8*)(K_lds + (bf) * SHM_K + kws) = S.st_k0; *(bf16x8*)(K_lds + (bf) * SHM_K + kws + 32 * 256) = S.st_k1; \
                           if (tid < 64) ((float*)B_lds)[(bf) * 64 + tid] = S.st_b; } while (0)
#define SWRITE_HV(bf) do { *(bf16x8*)(V_lds + (bf) * SHM_V + vst0) = S.st_v0; *(bf16x8*)(V_lds + (bf) * SHM_V + vst1) = S.st_v1; } while (0)
#define SWRITE_H(bf) do { SWRITE_HV(bf); SWRITE_HK(bf); } while (0)
__device__ __forceinline__ void prime(const BlockRef& cur, char* lds, Seam& S, int wv) {
    const int tid = fresh_tid(wv), wid = __builtin_amdgcn_readfirstlane(tid >> 6), lane = tid & 63, r32 = lane & 31, hi = lane >> 5;
    const int sr = tid >> 4, sc = (tid & 15) * 8, kws = KSWZ(sr, sc * 2); char* K_lds = lds + 2 * SHM_V; char* B_lds = lds + OFF_BIAS;
    for (int d0 = 0; d0 < 8; ++d0) S.qr[d0] = load8(cur.Q + (size_t)(wid * QBLK + r32) * LD + d0 * 16 + hi * 8);
    SLOAD_H(cur.K, cur.V, cur.FB, 0); VMW(); SWRITE_HK(0);
    __syncthreads();
}
__device__ __forceinline__ void block(const BlockRef& cur, const BlockRef& nxt, char* lds, Seam& S, int wv) {
    const int tid = fresh_tid(wv), wid = __builtin_amdgcn_readfirstlane(tid >> 6), lane = tid & 63, r32 = lane & 31, hi = lane >> 5;
    constexpr unsigned W = 1u << 30;
    const int NT = (cur.P0 + QB - 1) / KVBLK + 1;
    const int qlo = cur.P0 + wid * QBLK, qm = qlo + r32 - 4 * hi;
    char* V_lds = lds; char* K_lds = lds + 2 * SHM_V; char* B_lds = lds + OFF_BIAS;
    float* ws = (float*)(lds + OFF_WS) + wid * 64; float* li_l = ws, * al_l = ws + 32;
    float m_reg = -1e30f, l_reg = 0; f32x16 o[4] = {};
    const int sr = tid >> 4, sc = (tid & 15) * 8, vst0 = v_st(sr, sc), vst1 = v_st(32 + sr, sc), kws = KSWZ(sr, sc * 2);
    const int vb0 = (int)(uintptr_t)V_lds + v_rd_base(lane);
    const bf16* Kh = cur.K; const bf16* Vh = cur.V; const float* Fh = cur.FB;
#define RESC(a) do { if (__any((a) < 1.f)) { if (hi == 0) al_l[r32] = (a); asm volatile("s_waitcnt lgkmcnt(0)" ::: "memory");              \
                     for (int d_ = 0; d_ < 4; ++d_) for (int r = 0; r < 16; ++r) o[d_][r] *= al_l[crow(r, hi)]; } } while (0)
#define KBASE(t) ((t) * KVBLK)
#define MASKT(P0_, P1_, t) do { const int kb_ = KBASE(t); if (kb_ + KVBLK - 1 > qlo) mask_tile(P0_, P1_, qm - kb_, W); } while (0)
    constexpr int NQL = 8;
#define SEAM_K0() do { VMWN(NQL); SWRITE_HK(0); SBAR(); } while (0)
    f32x16 pA0, pA1, pB0, pB1; float mnA, mnB, alA, alB; bf16x8 pa0, pa1, pa2, pa3;
    SWRITE_HV(0); SBAR();
    if (NT > 1) SLOAD_H(Kh, Vh, Fh, KBASE(1));
    SBAR(); qkt<0>(pA0, pA1, K_lds, B_lds, r32, hi, S.qr);
    MASKT(pA0, pA1, 0); partialSM(pA0, pA1, m_reg, mnA, alA);
    if (NT > 1) { VMW(); SWRITE_H(1); }
    __syncthreads();
#define HALF_STEP(PX0, PX1, mnX, alX, PY0, PY1, alY, t, KB, VB, SB) do {                                                      \
        SBAR(); qkt<KB>(PX0, PX1, K_lds, B_lds, r32, hi, S.qr);                                                               \
        finishSM(PY0, PY1, alY, l_reg, pa0, pa1, pa2, pa3); SBAR();                                                           \
        if ((t) + 1 < NT) { SLOAD_H(Kh, Vh, Fh, KBASE((t) + 1)); SBAR(); }                                                    \
        pv_tile<VB>(o, vb0, pa0, pa1, pa2, pa3); MASKT(PX0, PX1, (t)); partialSM(PX0, PX1, m_reg, mnX, alX);                  \
        __syncthreads();                                                                                                      \
        if ((t) + 1 < NT) { VMW(); SWRITE_H(SB); }                                                                            \
        RESC(alX); __syncthreads(); } while (0)
    for (int t = 1; t + 1 < NT; t += 2) {
        HALF_STEP(pB0, pB1, mnB, alB, pA0, pA1, alA, t, 1, 0, 0);
        HALF_STEP(pA0, pA1, mnA, alA, pB0, pB1, alB, t + 1, 0, 1, 1);
    }
    const bool even = (NT & 1) == 0;
    if (even) { SBAR(); qkt<1>(pB0, pB1, K_lds, B_lds, r32, hi, S.qr); SBAR(); }
    SLOAD_H(nxt.K, nxt.V, nxt.FB, 0); SBAR();
#pragma unroll
    for (int d0 = 0; d0 < 8; ++d0) S.qr[d0] = load8(nxt.Q + (size_t)(wid * QBLK + r32) * LD + d0 * 16 + hi * 8);
    SBAR();
    finishSM(pA0, pA1, alA, l_reg, pa0, pa1, pa2, pa3); SBAR();
    pv_tile<0>(o, vb0, pa0, pa1, pa2, pa3);
    if (even) { MASKT(pB0, pB1, NT - 1); partialSM(pB0, pB1, m_reg, mnB, alB); __syncthreads(); RESC(alB);
        finishSM(pB0, pB1, alB, l_reg, pa0, pa1, pa2, pa3); SBAR(); pv_tile<1>(o, vb0, pa0, pa1, pa2, pa3); }
    SBAR(); SEAM_K0();
    if (hi == 0) li_l[r32] = l_reg; asm volatile("s_waitcnt lgkmcnt(0)" ::: "memory");
    float rli[16];
#pragma unroll
    for (int r = 0; r < 16; ++r) rli[r] = __builtin_amdgcn_rcpf(li_l[crow(r, hi)]);
    bf16* Ow = cur.O + (size_t)(wid * QBLK) * LDO;
    float sq[16];
#pragma unroll
    for (int r = 0; r < 16; ++r) { const int orow = crow(r, hi); float s_ = 0.f;
#pragma unroll
        for (int d0 = 0; d0 < 4; ++d0) { const float v = o[d0][r] * rli[r]; s_ += v * v;
            const float vn = __shfl_xor(v, 1);
            if ((r32 & 1) == 0) *(unsigned*)(Ow + (size_t)orow * LDO + d0 * 32 + r32) = cvtpk(v, vn); }
        sq[r] = s_; }
#pragma unroll
    for (int r = 0; r < 16; ++r) {
#define SQ_SWZ(o_) sq[r] += __int_as_float(__builtin_amdgcn_ds_swizzle(__float_as_int(sq[r]), 0x1f | ((o_) << 10)))
        SQ_SWZ(1); SQ_SWZ(2); SQ_SWZ(4); SQ_SWZ(8); SQ_SWZ(16);
#undef SQ_SWZ
    }
    if (r32 == 0) {
#pragma unroll
        for (int r = 0; r < 16; ++r) cur.ST[(size_t)(wid * QBLK + crow(r, hi)) * 8] = sq[r]; }
    __syncthreads();
#undef RESC
#undef KBASE
#undef MASKT
#undef SEAM_K0
#undef HALF_STEP
}
#undef ROW
#undef VMW
#undef VMWN
#undef SLOAD_H
#undef SWRITE_HK
#undef SWRITE_HV
#undef SWRITE_H
#undef SBAR
#undef KSWZ
}

#define XB_TMO      128
#define XB_XCNT(j)  (256  + 64 * (j))
#define XB_XSUB(j)  (1280 + 64 * (j))
#define XB_XGEN(j)  (2304 + 64 * (j))
#define XB_TOP      3328
#define XB_TOPGEN   3392
#define XCD_BAR_WORDS 3456
#define XB_SPIN_CAP (1u << 18)
__device__ __forceinline__ unsigned xb_ld(unsigned* p)              { return __hip_atomic_load(p, __ATOMIC_RELAXED, __HIP_MEMORY_SCOPE_AGENT); }
__device__ __forceinline__ unsigned xb_add(unsigned* p, unsigned v) { return __hip_atomic_fetch_add(p, v, __ATOMIC_RELAXED, __HIP_MEMORY_SCOPE_AGENT); }
__device__ __forceinline__ unsigned xb_xcc_id() { return (unsigned)__builtin_amdgcn_s_getreg((3 << 11) | 20) & 0xFu; }
#define XB_SPIN(cond, bar) do { unsigned _sp = 0; while (cond) { __builtin_amdgcn_s_sleep(1); \
    if ((++_sp & 255u) == 0u) { if (xb_ld(&(bar)[XB_TMO])) break; if (_sp > XB_SPIN_CAP) { atomicAdd(&(bar)[XB_TMO], 1u); break; } } } } while (0)
struct XcdBarrier { unsigned* bar; unsigned x; volatile LAS unsigned* st; };
__device__ __forceinline__ XcdBarrier xcd_barrier_post(unsigned* bar, volatile LAS unsigned* st, int tid) {
    XcdBarrier b; b.bar = bar; b.x = xb_xcc_id(); b.st = st;
    if (tid == 0) (void)xb_add(&bar[XB_XCNT(b.x)], 1u);
    return b;
}
__device__ __forceinline__ void xcd_barrier_complete(unsigned* bar, unsigned x, unsigned& nloc, unsigned& nx) {
    const unsigned G = gridDim.x * gridDim.y * gridDim.z;
    unsigned sum, cnt, mine, sp = 0u;
    for (;;) {
        sum = 0u; cnt = 0u; mine = 0u;
#pragma unroll
        for (unsigned j = 0; j < 16; ++j) { const unsigned c = xb_ld(&bar[XB_XCNT(j)]); sum += c; cnt += (c > 0u) ? 1u : 0u; mine = (j == x) ? c : mine; }
        if (sum == G) break;
        __builtin_amdgcn_s_sleep(1);
        if ((++sp & 255u) == 0u) { if (xb_ld(&bar[XB_TMO])) break; if (sp > XB_SPIN_CAP) { atomicAdd(&bar[XB_TMO], 1u); break; } }
    }
    nloc = mine > 0u ? mine : 1u; nx = cnt > 0u ? cnt : 1u;
}
__device__ __forceinline__ void xcd_barrier(const XcdBarrier& b, int tid) {
    asm volatile("s_waitcnt vmcnt(0)" ::: "memory");
    __syncthreads();
    if (tid == 0) {
        unsigned* bar = b.bar;
        __builtin_amdgcn_s_waitcnt(0);
        unsigned nloc = b.st[0], nx = b.st[1];
        if (nloc == 0u) { xcd_barrier_complete(bar, b.x, nloc, nx); b.st[0] = nloc; b.st[1] = nx; }
        const unsigned old = xb_add(&bar[XB_XSUB(b.x)], 1u);
        const unsigned gen = old / nloc;
        if (old + 1u == (gen + 1u) * nloc) {
            __builtin_amdgcn_fence(__ATOMIC_RELEASE, "agent");
            asm volatile("s_waitcnt vmcnt(0)" ::: "memory");
            const unsigned og = xb_add(&bar[XB_TOP], 1u);
            const unsigned tg = og / nx;
            if (og + 1u == (tg + 1u) * nx) xb_add(&bar[XB_TOPGEN], 1u);
            else XB_SPIN(xb_ld(&bar[XB_TOPGEN]) == tg, bar);
            __builtin_amdgcn_fence(__ATOMIC_ACQUIRE, "agent");
            xb_add(&bar[XB_XGEN(b.x)], 1u);
            asm volatile("s_waitcnt vmcnt(0)" ::: "memory");
        } else {
            XB_SPIN(xb_ld(&bar[XB_XGEN(b.x)]) == gen, bar);
            __builtin_amdgcn_fence(__ATOMIC_ACQUIRE, "agent");
            asm volatile("s_waitcnt vmcnt(0)" ::: "memory");
        }
    }
    __syncthreads();
}

#ifndef PROBE_PHASE
#define PROBE_PHASE -1
#endif
#ifndef PROBE_TS
#define PROBE_TS -1
#endif
#ifndef PROBE_OFF
#define PROBE_OFF 0
#endif
#ifndef PROBE_TSB
#define PROBE_TSB (PROBE_TS + 1)
#endif
#define PH(id) for (int rep_ = 0; rep_ < ((PROBE_PHASE == (id)) ? 2 : 1); ++rep_)
constexpr int NWAVES = 8, NTHREADS = 512;
constexpr int LDS_BYTES = 147456;
struct Args { const float* in[19]; float* out; unsigned char* ws; unsigned long long cg_rounds; };
enum { I_X = 0, I_P, I_GPREMIX, I_WIN, I_BF, I_WPOOL, I_POOLSCALE, I_GPOOLOUT, I_GATTNOUT, I_WOUT, I_GPOSTMIX, I_GPREMLP, I_WUP, I_WDOWN, I_GPOSTMLP, I_GPLEGATE, I_WGATE, I_WPLE, I_GPOSTPLE };

constexpr int TR_PITCH = 68, TR_BYTES = 64 * TR_PITCH * 4;
__device__ __forceinline__ void p0_transpose_item(const float* W, int K, int N, int ldw, bf16_t* WT, int row_off, LAS float* scr, int item, int lane, const float* gain = nullptr) {
    const int nkb = K / 64, kb = item % nkb, nb = item / nkb, k0 = 64 * kb, n0 = 64 * nb; (void)N;
    f32x4 v[16];
    const float* src = W + (size_t)(k0 + (lane >> 4)) * ldw + n0 + 4 * (lane & 15);
#pragma unroll
    for (int i = 0; i < 16; ++i) v[i] = __builtin_nontemporal_load((const f32x4*)(src + (size_t)(4 * i) * ldw));
#pragma unroll
    for (int i = 0; i < 16; ++i) { if (gain) v[i] = v[i] * gain[k0 + 4 * i + (lane >> 4)]; *(LAS f32x4*)(scr + (4 * i + (lane >> 4)) * TR_PITCH + 4 * (lane & 15)) = v[i]; }
    asm volatile("s_waitcnt lgkmcnt(0)" ::: "memory");
    const int c = lane >> 3;
#pragma unroll
    for (int j = 0; j < 8; ++j) { const int n = (lane & 7) + 8 * j; const LAS float* sp = scr + (8 * c) * TR_PITCH + n;
        u32x4 o; o.x = cvt_pk_bf16(sp[0 * TR_PITCH], sp[1 * TR_PITCH]); o.y = cvt_pk_bf16(sp[2 * TR_PITCH], sp[3 * TR_PITCH]);
        o.z = cvt_pk_bf16(sp[4 * TR_PITCH], sp[5 * TR_PITCH]); o.w = cvt_pk_bf16(sp[6 * TR_PITCH], sp[7 * TR_PITCH]);
        *(u32x4*)(WT + (size_t)(row_off + n0 + n) * K + k0 + 8 * c) = o; }
    asm volatile("s_waitcnt lgkmcnt(0)" ::: "memory");
}

template <int MODE>
__device__ __forceinline__ void resnorm_phase(const bf16_t* base, const bf16_t* raw, const float* g_post, void* outp, const float* epsin, float* sout, int gw, int NGW, int lane) {
    constexpr bool BOUT = (MODE != 10);
    u32x2 nraw[8]; u32x2 nbh[8];
#define RN_LOAD(mm) do { const u32x2* rp_ = (const u32x2*)(raw + (size_t)(mm) * DM) + lane; \
        _Pragma("unroll") for (int j = 0; j < 8; ++j) nraw[j] = rp_[64 * j]; \
        const u32x2* bp_ = (const u32x2*)(base + (size_t)(mm) * DM) + lane; _Pragma("unroll") for (int j = 0; j < 8; ++j) nbh[j] = bp_[64 * j]; } while (0)
    int m = gw; if (m < M) RN_LOAD(m);
    for (; m < M; m += NGW) {
        f32x4 r[8], b[8]; float ss = 0.f;
#pragma unroll
        for (int j = 0; j < 8; ++j) { r[j] = (f32x4){bf_lo(nraw[j].x), bf_hi(nraw[j].x), bf_lo(nraw[j].y), bf_hi(nraw[j].y)};
            b[j] = (f32x4){bf_lo(nbh[j].x), bf_hi(nbh[j].x), bf_lo(nbh[j].y), bf_hi(nbh[j].y)};
            ss += (r[j].x * r[j].x + r[j].y * r[j].y) + (r[j].z * r[j].z + r[j].w * r[j].w); }
        asm volatile("" ::: "memory");
        if (m + NGW < M) RN_LOAD(m + NGW);
        float epse = EPS;
        if (MODE == 5) epse = EPS * epsin[m];
        if (MODE == 8) { const float e_ = epsin[m]; epse = EPS * e_ * e_; }
        const float rs = 1.0f / sqrtf(wave_sum(ss) * (1.f / DM) + epse);
        float ss2 = 0.f;
#pragma unroll
        for (int j = 0; j < 8; ++j) { const f32x4 g = *((const f32x4*)g_post + lane + 64 * j);
            r[j] = b[j] + r[j] * rs * g;
            if (BOUT) { u32x2 w; w.x = cvt_pk_bf16(r[j].x, r[j].y); w.y = cvt_pk_bf16(r[j].z, r[j].w); *((u32x2*)((bf16_t*)outp + (size_t)m * DM) + lane + 64 * j) = w; }
            else *((f32x4*)((float*)outp + (size_t)m * DM) + lane + 64 * j) = r[j];
            ss2 += (r[j].x * r[j].x + r[j].y * r[j].y) + (r[j].z * r[j].z + r[j].w * r[j].w); }
        if (MODE != 10) { const float ms = wave_sum(ss2) * (1.f / DM) + EPS;
            if (lane == 0) sout[m] = (MODE == 5) ? ms : 1.0f / sqrtf(ms); }
    }
#undef RN_LOAD
}
__device__ __forceinline__ void ynorm_phase(const bf16_t* yp, const bf16_t* ya, const float* gp, const float* ga, bf16_t* y, int gw, int NGW, int lane) {
    u32x4 np[2], na[2];
#define YN_LOAD(mm) do { _Pragma("unroll") for (int j = 0; j < 2; ++j) { np[j] = *((const u32x4*)(yp + (size_t)(mm) * 1024) + lane + 64 * j); na[j] = *((const u32x4*)(ya + (size_t)(mm) * 1024) + lane + 64 * j); } } while (0)
    int m = gw; if (m < M) YN_LOAD(m);
    for (; m < M; m += NGW) {
        float v[2][2][8]; float ss0 = 0.f, ss1 = 0.f;
#pragma unroll
        for (int j = 0; j < 2; ++j) { const u32x4 w = np[j], q = na[j];
            v[0][j][0] = bf_lo(w.x); v[0][j][1] = bf_hi(w.x); v[0][j][2] = bf_lo(w.y); v[0][j][3] = bf_hi(w.y); v[0][j][4] = bf_lo(w.z); v[0][j][5] = bf_hi(w.z); v[0][j][6] = bf_lo(w.w); v[0][j][7] = bf_hi(w.w);
            v[1][j][0] = bf_lo(q.x); v[1][j][1] = bf_hi(q.x); v[1][j][2] = bf_lo(q.y); v[1][j][3] = bf_hi(q.y); v[1][j][4] = bf_lo(q.z); v[1][j][5] = bf_hi(q.z); v[1][j][6] = bf_lo(q.w); v[1][j][7] = bf_hi(q.w);
#pragma unroll
            for (int e = 0; e < 8; ++e) { ss0 += v[0][j][e] * v[0][j][e]; ss1 += v[1][j][e] * v[1][j][e]; } }
        asm volatile("" ::: "memory");
        if (m + NGW < M) YN_LOAD(m + NGW);
        ss0 = wave_sum(ss0); ss1 = wave_sum(ss1);
        const float rs[2] = {1.0f / sqrtf(ss0 * (1.f / 1024.f) + EPS), 1.0f / sqrtf(ss1 * (1.f / 1024.f) + EPS)};
#pragma unroll
        for (int h = 0; h < 2; ++h) { const float* g = h ? ga : gp;
#pragma unroll
            for (int j = 0; j < 2; ++j) { const f32x4 g0 = *((const f32x4*)g + 2 * (lane + 64 * j)), g1 = *((const f32x4*)g + 2 * (lane + 64 * j) + 1); const float r_ = rs[h];
                u32x4 w; w.x = cvt_pk_bf16(v[h][j][0] * r_ * g0.x, v[h][j][1] * r_ * g0.y); w.y = cvt_pk_bf16(v[h][j][2] * r_ * g0.z, v[h][j][3] * r_ * g0.w);
                w.z = cvt_pk_bf16(v[h][j][4] * r_ * g1.x, v[h][j][5] * r_ * g1.y); w.w = cvt_pk_bf16(v[h][j][6] * r_ * g1.z, v[h][j][7] * r_ * g1.w);
                *((u32x4*)(y + (size_t)m * DM + h * 1024) + lane + 64 * j) = w; } }
    }
#undef YN_LOAD
}
__device__ __forceinline__ float log_sigmoid(float x) { return x < 0.f ? x - log1pf(expf(x)) : -log1pf(expf(-x)); }

__global__ void __launch_bounds__(NTHREADS, 2) mega_fwd(Args args) {
    extern __shared__ __attribute__((aligned(16))) unsigned char lds[];
    cg::grid_group grid = cg::this_grid();
    for (unsigned long long i_ = 0; i_ < args.cg_rounds; ++i_) grid.sync();
    LAS unsigned char* ldsl = (LAS unsigned char*)lds;
    const int G = gridDim.x, bid = blockIdx.x, NGW = G * NWAVES;
    const int wave_s = __builtin_amdgcn_readfirstlane((int)(threadIdx.x >> 6));
#if PROBE_TS >= 0
#define STAMP(k) do { if (bid == 0 && fresh_tid(wave_s) == 0) { const unsigned long long t_ = __builtin_amdgcn_s_memrealtime(); MISC[16 + 2 * (k)] = (unsigned)t_; MISC[17 + 2 * (k)] = (unsigned)(t_ >> 32); } } while (0)
#else
#define STAMP(k) do {} while (0)
#endif
#define PHASE_IDS() const int tid = fresh_tid(wave_s), lane = tid & 63, wave = __builtin_amdgcn_readfirstlane(tid >> 6), gw = bid * NWAVES + wave; (void)lane; (void)gw
    unsigned char* ws = args.ws;
    unsigned* barw = (unsigned*)ws;
    volatile LAS unsigned* MISC = (volatile LAS unsigned*)(ldsl + LDS_BYTES - 256);
    { const int t0 = fresh_tid(wave_s); if (t0 < 64) MISC[t0] = 0u;
      __syncthreads(); }
    const XcdBarrier bar = xcd_barrier_post(barw, MISC + 8, fresh_tid(wave_s));
    STAMP(0);
#define WSP(off) ((bf16_t*)(args.ws + (off)))
#define XIN (args.in[I_X])
#define OUTP (args.out)
#define flog ((float*)(args.ws + WS_FLOG))
#define fb ((float*)(args.ws + WS_FB))
#define WinT WSP(WS_WIN)
#define WoutT WSP(WS_WOUT)
#define WupT WSP(WS_WUP)
#define WdownT WSP(WS_WDOWN)
#define WgateT WSP(WS_WGATE)
#define WpleT WSP(WS_WPLE)
#define WpoolT WSP(WS_WPOOL)
#define HN WSP(WS_HN)
#define U WSP(AR_U)
#define Qb WSP(AR_Q)
#define Kb WSP(AR_K)
#define Vb WSP(AR_V)
#define YP WSP(AR_YP)
#define YA WSP(AR_YA)
#define DP WSP(AR_DP)
#define Y WSP(AR_Y)
#define RAW1 WSP(AR_RAW1)
#define HID WSP(AR_HID)
#define Eb ((bf16_t*)((unsigned char*)args.out + 32 * MiB))
#define RAW2 WSP(WS_RAW2)
#define PBF WSP(WS_PBF)
#define STA ((float*)(args.ws + WS_STA))
#define STP ((float*)(args.ws + WS_STP))
#define RS0 ((float*)(args.ws + WS_RS0))
#define MSA ((float*)(args.ws + WS_MSA))
#define MS2 ((float*)(args.ws + WS_MS2))
#define RS3 ((float*)(args.ws + WS_RS3))
#define H1 ((bf16_t*)args.out)
#define H2 WSP(WS_ARENA + 32 * MiB)

    PH(0) {
    {
        PHASE_IDS();
        LAS float* wf = (LAS float*)ldsl;
        const float* w_in = args.in[I_WIN]; const float* gpm = args.in[I_GPREMIX];
        {
            f32x4 wa[4], wb[4]; float gk[4];
#pragma unroll
            for (int q = 0; q < 4; ++q) { const int k = tid + q * NTHREADS; const f32x4* wp = (const f32x4*)(w_in + (size_t)k * INW + 4096); wa[q] = wp[0]; wb[q] = wp[1]; gk[q] = gpm[k]; }
#pragma unroll
            for (int q = 0; q < 4; ++q) { const int k = tid + q * NTHREADS; const int l = (k & 255) >> 2, i = k & 3, j = k >> 8;
                LAS f32x4* dst = (LAS f32x4*)(wf + ((j * 4 + i) * 64 + l) * 8); dst[0] = wa[q] * gk[q]; dst[1] = wb[q] * gk[q]; }
        }
        __syncthreads();
        f32x4 nx[8];
        if (gw < M) {
#pragma unroll
            for (int j = 0; j < 8; ++j) nx[j] = __builtin_nontemporal_load((const f32x4*)(XIN + (size_t)gw * DM) + lane + 64 * j); }
        for (int m = gw; m < M; m += NGW) {
            f32x4 v[8]; float ss = 0.f;
#pragma unroll
            for (int j = 0; j < 8; ++j) { v[j] = nx[j]; ss += (v[j].x * v[j].x + v[j].y * v[j].y) + (v[j].z * v[j].z + v[j].w * v[j].w); }
            asm volatile("" ::: "memory");
            if (m + NGW < M) {
#pragma unroll
                for (int j = 0; j < 8; ++j) nx[j] = __builtin_nontemporal_load((const f32x4*)(XIN + (size_t)(m + NGW) * DM) + lane + 64 * j); }
            const float rs = 1.0f / sqrtf(wave_sum(ss) * (1.f / DM) + EPS);
            float fa[8] = {0.f, 0.f, 0.f, 0.f, 0.f, 0.f, 0.f, 0.f};
#pragma unroll
            for (int j = 0; j < 8; ++j)
#pragma unroll
                for (int i = 0; i < 4; ++i) { const LAS f32x4* wp = (const LAS f32x4*)(wf + ((j * 4 + i) * 64 + lane) * 8); const f32x4 w0 = wp[0], w1 = wp[1]; const float xv = v[j][i];
                    fa[0] += xv * w0.x; fa[1] += xv * w0.y; fa[2] += xv * w0.z; fa[3] += xv * w0.w; fa[4] += xv * w1.x; fa[5] += xv * w1.y; fa[6] += xv * w1.z; fa[7] += xv * w1.w; }
#pragma unroll
            for (int c = 0; c < 8; ++c) fa[c] = wave_sum(fa[c]) * rs;
            if (lane < 8) { float fv = fa[0];
#pragma unroll
                for (int c = 1; c < 8; ++c) fv = (lane == c) ? fa[c] : fv;
                flog[((size_t)(m >> 11) * NH + lane) * SEQ + (m & (SEQ - 1))] = log_sigmoid(fv + args.in[I_BF][lane]); }
            u32x2* o8 = (u32x2*)(HN + (size_t)m * DM) + lane;
#pragma unroll
            for (int j = 0; j < 8; ++j) { const f32x4 h = v[j];
                u32x2 w; w.x = cvt_pk_bf16(h.x, h.y); w.y = cvt_pk_bf16(h.z, h.w); o8[64 * j] = w; }
            if (lane == 0) RS0[m] = rs;
        }
        __syncthreads();
        LAS float* scr = (LAS float*)(ldsl + wave * TR_BYTES);
        constexpr int IT_IN = (DM / 64) * (4096 / 64), IT_POOL1 = (256 / 64) * (256 / 64);
        constexpr int IT_PLE = (PLE / 64) * (DM / 64);
        constexpr int NITEMS = IT_IN + 4 * IT_POOL1 + IT_PLE;
        for (int it = gw; it < NITEMS; it += NGW) {
            int r = it;
            if (r < IT_IN) { p0_transpose_item(args.in[I_WIN], DM, 4096, INW, WinT, 0, scr, r, lane, args.in[I_GPREMIX]); continue; } r -= IT_IN;
            if (r < IT_PLE) { p0_transpose_item(args.in[I_WPLE], PLE, DM, DM, WpleT, 0, scr, r, lane); continue; } r -= IT_PLE;
            { const int gi = r / IT_POOL1; p0_transpose_item(args.in[I_WPOOL] + (size_t)gi * 65536, 256, 256, 256, WpoolT, gi * 256, scr, r % IT_POOL1, lane); }
        }
        const float* p = args.in[I_P];
        for (int idx = bid * NTHREADS + tid; idx < M * PLE / 8; idx += G * NTHREADS) { const f32x4 a = __builtin_nontemporal_load((const f32x4*)p + 2 * idx), b = __builtin_nontemporal_load((const f32x4*)p + 2 * idx + 1);
            u32x4 w; w.x = cvt_pk_bf16(a.x, a.y); w.y = cvt_pk_bf16(a.z, a.w); w.z = cvt_pk_bf16(b.x, b.y); w.w = cvt_pk_bf16(b.z, b.w); *((u32x4*)PBF + idx) = w; }
    }
    xcd_barrier(bar, fresh_tid(wave_s));
    }
    STAMP(1);

#if PROBE_PHASE == 100
    for (int i_ = 0; i_ < 16; ++i_) xcd_barrier(bar, fresh_tid(wave_s));
#endif
    PH(1) {
    {
        { PHASE_IDS();
          if (bid < NB * NH && wave == 0) {
            const f32x4* fl = (const f32x4*)(flog + (size_t)bid * SEQ + 32 * lane); f32x4 v[8]; float run = 0.f;
#pragma unroll
            for (int j = 0; j < 8; ++j) v[j] = fl[j];
#pragma unroll
            for (int j = 0; j < 8; ++j) { v[j].x += run; v[j].y += v[j].x; v[j].z += v[j].y; v[j].w += v[j].z; run = v[j].w; }
            float incl = run;
#pragma unroll
            for (int o = 1; o < 64; o <<= 1) { const float t = __shfl_up(incl, o); if (lane >= o) incl += t; }
            const float excl = incl - run;
            f32x4* fo = (f32x4*)(fb + (size_t)bid * SEQ + 32 * lane);
#pragma unroll
            for (int j = 0; j < 8; ++j) fo[j] = (v[j] + excl) * -11.313708498984761f;
          } }
        pg8::Gemm g{HN, WinT, DM, DM, DM, 0}; pg8::StaticOrder S; S.init(M, 4096, G, bid);
        pg8::EpiG<0> E{U, 1024, 1024, (size_t)(AR_Q - AR_U) / 2, nullptr, nullptr, nullptr, RS0};
        pg8::gemm_phase(ldsl, g, S, E, wave_s);
    }
    xcd_barrier(bar, fresh_tid(wave_s));
    }
    STAMP(2); STAMP(3);

    PH(3) {
    {
        const int xcd = bid & 7, ix = bid >> 3;
        const int bh = (xcd * 4 + (ix >> 3)) & 31, qb = ix & 7, b = bh >> 3, h = bh & 7;
        if (bid < 256) {
            att::BlockRef cur;
            const size_t rowb = (size_t)b * SEQ;
            cur.Q = Qb + (rowb + (size_t)qb * 256) * 1024 + h * HD; cur.K = Kb + rowb * 1024 + h * HD; cur.V = Vb + rowb * 1024 + h * HD;
            cur.FB = fb + (size_t)bh * SEQ; cur.O = Y + (rowb + (size_t)qb * 256) * DM + POOLW + h * HD; cur.ST = STA + (rowb + (size_t)qb * 256) * 8 + h; cur.P0 = qb * 256;
            att::Seam S;
            att::prime(cur, (char*)lds, S, wave_s);
            att::block(cur, cur, (char*)lds, S, wave_s);
            asm volatile("s_waitcnt vmcnt(0)" ::: "memory");
            __syncthreads();
        }
        {
            pg8::SingleUnit S; const int id = bh * 4 + qb; S.valid = (bid < 256 && qb < 4) ? 1 : 0; S.pm = id >> 2; S.pn = id & 3;
            if (S.valid) {
                const int tid = fresh_tid(wave_s), cc = tid & 31, tg = tid >> 5, gi = S.pn, w = 2 << gi;
                const int t0 = S.pm * 256 + tg * 16, pos0 = t0 & (SEQ - 1), col = gi * 256 + cc * 8;
                const bf16_t* up = U + (size_t)t0 * POOLW + col; bf16_t* dp = DP + (size_t)t0 * POOLW + col;
                float sm[8] = {0.f, 0.f, 0.f, 0.f, 0.f, 0.f, 0.f, 0.f};
                for (int j = 1; j < w; ++j) if (pos0 - j >= 0) { const u32x4 v = *(const u32x4*)(up - (size_t)j * POOLW);
                    sm[0] += bf_lo(v.x); sm[1] += bf_hi(v.x); sm[2] += bf_lo(v.y); sm[3] += bf_hi(v.y); sm[4] += bf_lo(v.z); sm[5] += bf_hi(v.z); sm[6] += bf_lo(v.w); sm[7] += bf_hi(v.w); }
                for (int i = 0; i < 16; ++i) { const int pos = pos0 + i; const u32x4 v = *(const u32x4*)(up + (size_t)i * POOLW);
                    const float f[8] = {bf_lo(v.x), bf_hi(v.x), bf_lo(v.y), bf_hi(v.y), bf_lo(v.z), bf_hi(v.z), bf_lo(v.w), bf_hi(v.w)};
                    const float inv = 1.0f / (float)((pos + 1 < w) ? pos + 1 : w);
                    float d[8];
#pragma unroll
                    for (int e = 0; e < 8; ++e) { sm[e] += f[e]; d[e] = sm[e] * inv - f[e]; }
                    u32x4 o; o.x = cvt_pk_bf16(d[0], d[1]); o.y = cvt_pk_bf16(d[2], d[3]); o.z = cvt_pk_bf16(d[4], d[5]); o.w = cvt_pk_bf16(d[6], d[7]);
                    *(u32x4*)(dp + (size_t)i * POOLW) = o;
                    if (pos - w + 1 >= 0) { const u32x4 q = *(const u32x4*)(up + (size_t)(i - w + 1) * POOLW);
                        sm[0] -= bf_lo(q.x); sm[1] -= bf_hi(q.x); sm[2] -= bf_lo(q.y); sm[3] -= bf_hi(q.y); sm[4] -= bf_lo(q.z); sm[5] -= bf_hi(q.z); sm[6] -= bf_lo(q.w); sm[7] -= bf_hi(q.w); } }
                asm volatile("s_waitcnt vmcnt(0)" ::: "memory");
                __syncthreads();
            }
            pg8::Gemm g{DP, WpoolT, POOLW, 256, 256, 256};
            pg8::EpiG<4> E{Y, DM, 0, 0, args.in[I_POOLSCALE], nullptr, STP, nullptr};
            pg8::gemm_phase(ldsl, g, S, E, wave_s);
        }
        {
            pg8::ListSched S; S.id0 = __builtin_amdgcn_readfirstlane((bh * 4 + qb) * 2); S.n = __builtin_amdgcn_readfirstlane((bid < 256 && qb < 4) ? 2 : 0); S.nN = DM / 256;
            pg8::Gemm g{PBF, WpleT, PLE, PLE, PLE, 0}; pg8::EpiG<0> E{Eb, DM, 0, 0, nullptr, nullptr, nullptr, nullptr};
            pg8::gemm_phase(ldsl, g, S, E, wave_s);
        }
        __syncthreads();
        {
            const int tid = fresh_tid(wave_s), lane = tid & 63, wave = __builtin_amdgcn_readfirstlane(tid >> 6);
            LAS unsigned* T = (LAS unsigned*)ldsl;
            constexpr int T_OUT = 16 * 8, T_UP = 16 * 32, T_DOWN = 64 * 8, T_GATE = 16 * 8, NT2 = T_OUT + T_UP + T_DOWN + T_GATE, CH = 4;
            unsigned* ctr = barw + XCD_BAR_WORDS + 16;
            f32x4 va[16], vb[16];
            bf16_t* aWT = nullptr; int aK = 0, ak0 = 0, an0 = 0; bf16_t* bWT = nullptr; int bK = 0, bk0 = 0, bn0 = 0; const float* aG = nullptr; const float* bG = nullptr;
            unsigned cbase = 0; int ci = CH; int ta, tb;
#define TR_NEXT(dst) do { if (ci == CH) { if (tid == 0) MISC[12] = __hip_atomic_fetch_add(ctr, (unsigned)CH, __ATOMIC_RELAXED, __HIP_MEMORY_SCOPE_AGENT); \
                __syncthreads(); cbase = MISC[12]; __syncthreads(); ci = 0; } \
            dst = (int)cbase + ci; ++ci; if (dst >= NT2) dst = -1; } while (0)
#define TR_DECODE_LOAD(tt, V, xWT, xK, xk0, xn0, xG) do { int r_ = (tt), nnb_, ldw_; const float* W_; xG = nullptr; \
            if (r_ < T_OUT) { W_ = args.in[I_WOUT]; ldw_ = DM; xK = DM; xWT = WoutT; nnb_ = 8; const int k0_ = 128 * (r_ / 8); xG = (k0_ < POOLW) ? args.in[I_GPOOLOUT] + k0_ : args.in[I_GATTNOUT] + (k0_ - POOLW); } \
            else if ((r_ -= T_OUT) < T_UP) { W_ = args.in[I_WUP]; ldw_ = DFF; xK = DM; xWT = WupT; nnb_ = 32; xG = args.in[I_GPREMLP] + 128 * (r_ / 32); } \
            else if ((r_ -= T_UP) < T_DOWN) { W_ = args.in[I_WDOWN]; ldw_ = DM; xK = DFF; xWT = WdownT; nnb_ = 8; } \
            else { r_ -= T_DOWN; W_ = args.in[I_WGATE]; ldw_ = DM; xK = DM; xWT = WgateT; nnb_ = 8; xG = args.in[I_GPLEGATE] + 128 * (r_ / 8); } \
            xk0 = 128 * (r_ / nnb_); xn0 = 256 * (r_ % nnb_); \
            const float* src_ = W_ + (size_t)(xk0 + 16 * wave) * ldw_ + xn0 + 4 * lane; \
            _Pragma("unroll") for (int r = 0; r < 16; ++r) V[r] = __builtin_nontemporal_load((const f32x4*)(src_ + (size_t)r * ldw_)); } while (0)
#define TR_PROCESS(V, xWT, xK, xk0, xn0, xG, tcur) do { \
                bf16_t* const sWT_ = xWT; const int sK_ = xK, sk0_ = xk0, sn0_ = xn0; \
                if (xG) { _Pragma("unroll") for (int r = 0; r < 16; ++r) V[r] = V[r] * xG[16 * wave + r]; } \
                _Pragma("unroll") for (int rp = 0; rp < 8; ++rp) _Pragma("unroll") for (int j = 0; j < 4; ++j) T[(4 * lane + j) * 65 + 8 * wave + rp] = cvt_pk_bf16(V[2 * rp][j], V[2 * rp + 1][j]); \
                TR_NEXT(tcur); \
                __syncthreads(); \
                if (tcur >= 0) TR_DECODE_LOAD(tcur, V, xWT, xK, xk0, xn0, xG); \
                {   const int c = lane & 15, nn = lane >> 4; \
                    _Pragma("unroll") for (int i = 0; i < 8; ++i) { const int n = 4 * (wave + 8 * i) + nn; const LAS unsigned* sp = T + n * 65 + 4 * c; \
                        u32x4 o; o.x = sp[0]; o.y = sp[1]; o.z = sp[2]; o.w = sp[3]; \
                        *(u32x4*)(sWT_ + (size_t)(sn0_ + n) * sK_ + sk0_ + 8 * c) = o; } } \
                __syncthreads(); } while (0)
            TR_NEXT(ta); TR_NEXT(tb);
            if (ta >= 0) TR_DECODE_LOAD(ta, va, aWT, aK, ak0, an0, aG);
            if (tb >= 0) TR_DECODE_LOAD(tb, vb, bWT, bK, bk0, bn0, bG);
            while (ta >= 0) {
                TR_PROCESS(va, aWT, aK, ak0, an0, aG, ta);
                if (tb < 0) break;
                TR_PROCESS(vb, bWT, bK, bk0, bn0, bG, tb);
            }
#undef TR_PROCESS
#undef TR_NEXT
#undef TR_DECODE_LOAD
        }
    }
    xcd_barrier(bar, fresh_tid(wave_s));
    }
    STAMP(4);

    PH(5) {
    {
        pg8::StaticOrder S; S.init(M, DM, G, bid);
        LAS float* rho = (LAS float*)(ldsl + 131072);
        { const int t = fresh_tid(wave_s); pg8::Unit u0; if (S.next(0, u0) && t < 256) { const size_t row = (size_t)u0.pm * 256 + t;
            const f32x4* pa = (const f32x4*)(STA + row * 8); const f32x4* pp = (const f32x4*)(STP + row * 16);
            const f32x4 a0 = pa[0], a1 = pa[1], p0 = pp[0], p1 = pp[1], p2 = pp[2], p3 = pp[3];
            const float sa = (a0.x + a0.y + a0.z + a0.w) + (a1.x + a1.y + a1.z + a1.w);
            const float sp = ((p0.x + p0.y + p0.z + p0.w) + (p1.x + p1.y + p1.z + p1.w)) + ((p2.x + p2.y + p2.z + p2.w) + (p3.x + p3.y + p3.z + p3.w));
            rho[t] = sqrtf((sa * (1.f / 1024.f) + EPS) / (sp * (1.f / 1024.f) + EPS));
            if (u0.pn == 0) MSA[row] = sa * (1.f / 1024.f) + EPS; }
          __syncthreads(); }
        pg8::Gemm g{Y, WoutT, DM, DM, DM, 0};
        pg8::EpiG<0> E{RAW1, DM, 0, 0, nullptr, nullptr, nullptr, nullptr};
        pg8::gemm_phase<true>(ldsl, g, S, E, wave_s, rho);
    }
    xcd_barrier(bar, fresh_tid(wave_s));
    }
    STAMP(6);

    PH(6) {
    { PHASE_IDS();
    resnorm_phase<5>(HN, RAW1, args.in[I_GPOSTMIX], H1, MSA, MS2, gw, NGW, lane); }
    xcd_barrier(bar, fresh_tid(wave_s));
    }
    STAMP(7);

    PH(7) {
    {
        pg8::Gemm g{H1, WupT, DM, DM, DM, 0}; pg8::StaticOrder S; S.init(M, DFF, G, bid);
        pg8::EpiG<2> E{HID, DFF, 0, 0, nullptr, nullptr, nullptr, nullptr};
        pg8::gemm_phase(ldsl, g, S, E, wave_s);
    }
    xcd_barrier(bar, fresh_tid(wave_s));
    }
    STAMP(8);

    PH(8) {
    {
        pg8::Gemm g{HID, WdownT, DFF, DFF, DFF, 0}; pg8::StaticOrder S; S.init(M, DM, G, bid);
        pg8::EpiG<0> E{RAW2, DM, 0, 0, nullptr, nullptr, nullptr, nullptr};
        pg8::gemm_phase(ldsl, g, S, E, wave_s);
    }
    xcd_barrier(bar, fresh_tid(wave_s));
    }
    STAMP(9);

    PH(9) {
    { PHASE_IDS();
    resnorm_phase<8>(H1, RAW2, args.in[I_GPOSTMLP], H2, MS2, RS3, gw, NGW, lane); }
    xcd_barrier(bar, fresh_tid(wave_s));
    }
    STAMP(10);

    PH(10) {
    {
        pg8::StaticOrder S; S.init(M, DM, G, bid);
        { pg8::Gemm g{H2, WgateT, DM, DM, DM, 0}; pg8::EpiG<3> E{RAW2, DM, 0, 0, nullptr, Eb, nullptr, RS3}; pg8::gemm_phase(ldsl, g, S, E, wave_s); }
    }
    xcd_barrier(bar, fresh_tid(wave_s));
    }
    STAMP(11);

    PH(11) {
    { PHASE_IDS();
    resnorm_phase<10>(H2, RAW2, args.in[I_GPOSTPLE], OUTP, nullptr, nullptr, gw, NGW, lane); }
    }
#if PROBE_TS >= 0
    STAMP(12);
    if (bid == 0 && fresh_tid(wave_s) == 0) { asm volatile("s_waitcnt vmcnt(0)" ::: "memory");
        const unsigned long long a_ = ((unsigned long long)MISC[17 + 2 * PROBE_TS] << 32) | MISC[16 + 2 * PROBE_TS], b_ = ((unsigned long long)MISC[17 + 2 * (PROBE_TSB)] << 32) | MISC[16 + 2 * (PROBE_TSB)];
        OUTP[0] += (float)(b_ - a_) * 0.01f - (float)PROBE_OFF; }
#endif
}

#undef WSP
#undef XIN
#undef OUTP
#undef flog
#undef fb
#undef WinT
#undef WoutT
#undef WupT
#undef WdownT
#undef WgateT
#undef WpleT
#undef WpoolT
#undef HN
#undef U
#undef Qb
#undef Kb
#undef Vb
#undef YP
#undef YA
#undef DP
#undef Y
#undef RAW1
#undef HID
#undef Eb
#undef RAW2
#undef PBF
#undef STA
#undef STP
#undef RS0
#undef MSA
#undef MS2
#undef RS3
#undef H1
#undef H2

extern "C" void kernel_launch(void* const* d_in, const int* in_sizes, int n_in, void* d_out, int out_size, void* d_ws, size_t ws_size, hipStream_t stream) {
    static int grid = 0;
    if (grid == 0) {
        if (n_in != 19 || in_sizes[0] != M * DM || out_size != M * DM || ws_size < WS_END) {
            fprintf(stderr, "kernel_launch: unexpected shapes (n_in %d in0 %d out %d ws %zu)\n", n_in, n_in > 0 ? in_sizes[0] : -1, out_size, ws_size); grid = -1; return; }
        int dev = 0, cus = 0, per_cu = 0;
        hipGetDevice(&dev); hipDeviceGetAttribute(&cus, hipDeviceAttributeMultiprocessorCount, dev);
        if (hipFuncSetAttribute((const void*)mega_fwd, hipFuncAttributeMaxDynamicSharedMemorySize, LDS_BYTES) != hipSuccess) { fprintf(stderr, "kernel_launch: hipFuncSetAttribute failed\n"); grid = -1; return; }
        if (hipOccupancyMaxActiveBlocksPerMultiprocessor(&per_cu, (const void*)mega_fwd, NTHREADS, LDS_BYTES) != hipSuccess || per_cu < 1) {
            fprintf(stderr, "kernel_launch: occupancy query says %d\n", per_cu); per_cu = 1; }
        (void)hipGetLastError();
        grid = cus * 1;
        if (grid != 256) fprintf(stderr, "kernel_launch: grid %d (expected 256)\n", grid);
    }
    if (grid < 0) return;
    if (hipMemsetAsync(d_ws, 0, (XCD_BAR_WORDS + 64) * sizeof(unsigned), stream) != hipSuccess) { fprintf(stderr, "kernel_launch: hipMemsetAsync failed\n"); return; }
    Args a{};
    for (int i = 0; i < 19; ++i) a.in[i] = (const float*)d_in[i];
    a.out = (float*)d_out; a.ws = (unsigned char*)d_ws;
    void* kargs[] = {&a};
    hipError_t e = hipLaunchCooperativeKernel((const void*)mega_fwd, dim3(grid), dim3(NTHREADS), kargs, LDS_BYTES, stream);
    if (e != hipSuccess) fprintf(stderr, "kernel_launch: cooperative launch failed: %s (grid %d)\n", hipGetErrorString(e), grid);
}
```
